# Optimizing an MI355X kernel written in HIP

```python
import math
import jax, jax.numpy as jnp
from jax import lax
import numpy as np

D_MODEL = 1024
BATCH = 4
SEQ = 4096
DEPTH = 4

GRID_W = 64
CTX_LEN = 256
EPS = 1e-6
N_MOD = 6

HEAD_DIM = 64
N_Q_HEADS = 8
N_KV_HEADS = 2
Q_PER_KV = N_Q_HEADS // N_KV_HEADS
WINDOW = 128
ATTN_BLOCK = 128
BAND = 3 * ATTN_BLOCK
ROPE_BASE = 10000.0

FNET_GROUPS = 4
FNET_GROUP_DIM = 128
FNET_WIDTH = FNET_GROUPS * FNET_GROUP_DIM

HYENA_WIDTH = 512
HYENA_ORDER = 2
SHORT_CONV = 3
FILTER_EMB = 33
FILTER_BANDS = (FILTER_EMB - 1) // 2
FILTER_HIDDEN = 64
DECAY_TARGET = 1e-2
FAST_DECAY_PCT = 0.3
SLOW_DECAY_PCT = 1.5

ATTN_WIDTH = N_Q_HEADS * HEAD_DIM
KV_WIDTH = N_KV_HEADS * HEAD_DIM
N_BRANCHES = 3
Q_OFF = 0
K_OFF = Q_OFF + ATTN_WIDTH
V_OFF = K_OFF + KV_WIDTH
F_OFF = V_OFF + KV_WIDTH
H_OFF = F_OFF + FNET_WIDTH
G_OFF = H_OFF + (HYENA_ORDER + 1) * HYENA_WIDTH
IN_WIDTH = G_OFF + N_BRANCHES * D_MODEL

N_EXPERTS = 16
N_GROUPS = 4
EXPERTS_PER_GROUP = N_EXPERTS // N_GROUPS
TOP_K = 2
EXPERT_FF = 1024
EXPERT_BLOCK = 128

kernel_name = 'hybrid_gated_attn_fnet_hyena_moe_dit'


def rms_norm(x, g):
    xf = x.astype(jnp.float32)
    y = xf * lax.rsqrt(jnp.mean(xf * xf, axis=-1, keepdims=True) + EPS)
    return (y * g.astype(jnp.float32)).astype(x.dtype)


def modulate(h, shift, scale):
    return h * (1 + scale) + shift


def axial_rope(x, rows, cols):
    n_freq = HEAD_DIM // 4
    freqs = ROPE_BASE ** (-jnp.arange(n_freq, dtype=jnp.float32) / n_freq)

    def rotate(xa, pos):
        ang = pos.astype(jnp.float32)[:, None] * freqs
        cos = jnp.cos(ang)[None, :, None, :]
        sin = jnp.sin(ang)[None, :, None, :]
        x1, x2 = xa[..., :n_freq], xa[..., n_freq:]
        return jnp.concatenate([x1 * cos - x2 * sin, x1 * sin + x2 * cos], axis=-1)

    half = HEAD_DIM // 2
    out = jnp.concatenate([rotate(x[..., :half], rows), rotate(x[..., half:], cols)], axis=-1)
    return out.astype(x.dtype)


def banded_attention(q, k, v, kc, vc, sink):
    bsz, n = q.shape[:2]
    nb = n // ATTN_BLOCK
    scale = HEAD_DIM ** -0.5
    qb = q.reshape(bsz, nb, ATTN_BLOCK, N_KV_HEADS, Q_PER_KV, HEAD_DIM)
    pad = ((0, 0), (ATTN_BLOCK, ATTN_BLOCK), (0, 0), (0, 0))

    def band(t):
        tb = jnp.pad(t, pad).reshape(bsz, nb + 2, ATTN_BLOCK, N_KV_HEADS, HEAD_DIM)
        return jnp.concatenate([tb[:, :-2], tb[:, 1:-1], tb[:, 2:]], axis=2)

    kb, vb = band(k), band(v)
    s_band = jnp.einsum('bnqhgd,bnkhd->bnhgqk', qb, kb).astype(jnp.float32) * scale
    qpos = jnp.arange(n, dtype=jnp.int32).reshape(nb, ATTN_BLOCK)
    kpos = (jnp.arange(nb, dtype=jnp.int32)[:, None] - 1) * ATTN_BLOCK + jnp.arange(BAND, dtype=jnp.int32)[None, :]
    kp = kpos[:, None, :]
    valid = (kp >= 0) & (kp < n) & (jnp.abs(kp - qpos[:, :, None]) <= WINDOW)
    s_band = jnp.where(valid[None, :, None, None], s_band, jnp.finfo(jnp.float32).min)
    s_ctx = jnp.einsum('bnqhgd,bchd->bnhgqc', qb, kc).astype(jnp.float32) * scale
    s_sink = jnp.broadcast_to(sink.astype(jnp.float32).reshape(1, 1, N_KV_HEADS, Q_PER_KV, 1, 1),
                              s_band.shape[:-1] + (1,))
    p = jax.nn.softmax(jnp.concatenate([s_band, s_ctx, s_sink], axis=-1), axis=-1)
    n_ctx = kc.shape[1]
    p_band = p[..., :BAND].astype(v.dtype)
    p_ctx = p[..., BAND:BAND + n_ctx].astype(v.dtype)
    o = jnp.einsum('bnhgqk,bnkhd->bnqhgd', p_band, vb) + jnp.einsum('bnhgqc,bchd->bnqhgd', p_ctx, vc)
    return o.reshape(bsz, n, ATTN_WIDTH)


def context_attention(q, kc, vc, sink):
    bsz, n = q.shape[:2]
    scale = HEAD_DIM ** -0.5
    qg = q.reshape(bsz, n, N_KV_HEADS, Q_PER_KV, HEAD_DIM)
    s = jnp.einsum('bqhgd,bkhd->bhgqk', qg, kc).astype(jnp.float32) * scale
    s_sink = jnp.broadcast_to(sink.astype(jnp.float32).reshape(1, N_KV_HEADS, Q_PER_KV, 1, 1), s.shape[:-1] + (1,))
    p = jax.nn.softmax(jnp.concatenate([s, s_sink], axis=-1), axis=-1)[..., :-1]
    o = jnp.einsum('bhgqk,bkhd->bqhgd', p.astype(vc.dtype), vc)
    return o.reshape(bsz, n, ATTN_WIDTH)


def fourier_mix(u):
    bsz, n, _ = u.shape
    ug = u.astype(jnp.float32).reshape(bsz, n, FNET_GROUPS, FNET_GROUP_DIM)
    y = jnp.fft.fft2(ug, axes=(1, 3), norm='ortho').real
    return y.reshape(bsz, n, FNET_WIDTH).astype(u.dtype)


def short_conv(u, w, b):
    up = jnp.pad(u, ((0, 0), (1, 1), (0, 0)))
    return up[:, :-2] * w[0] + up[:, 1:-1] * w[1] + up[:, 2:] * w[2] + b


def hyena_filters(n, w1, b1, freq, w2, b2, w3):
    pos = jnp.arange(n, dtype=jnp.float32)
    t = pos / max(n - 1, 1)
    omega = 2.0 * math.pi * pos / n
    bands = jnp.linspace(1e-4, FILTER_BANDS - 1, FILTER_BANDS, dtype=jnp.float32)
    feats = jnp.concatenate([t[:, None], jnp.cos(omega[:, None] * bands), -jnp.sin(omega[:, None] * bands)], axis=-1)
    h = jnp.sin(freq * (feats @ w1 + b1))
    h = jnp.sin(freq * (h @ w2 + b2))
    h = (h @ w3).reshape(n, HYENA_ORDER, 2, HYENA_WIDTH)
    deltas = jnp.abs(jnp.linspace(math.log(DECAY_TARGET) / SLOW_DECAY_PCT, math.log(DECAY_TARGET) / FAST_DECAY_PCT,
                                  HYENA_WIDTH, dtype=jnp.float32))
    h = h * jnp.exp(-t[:, None] * deltas)[:, None, None, :]
    fwd, bwd = h[:, :, 0], h[:, :, 1]
    k = jnp.concatenate([fwd, jnp.zeros_like(fwd[:1]), bwd[:0:-1]], axis=0)
    return k / jnp.sum(jnp.abs(k), axis=0, keepdims=True)


def fft_long_conv(u, k):
    n = u.shape[1]
    uf = jnp.fft.rfft(u, n=2 * n, axis=1)
    kf = jnp.fft.rfft(k, n=2 * n, axis=0)
    return jnp.fft.irfft(uf * kf[None], n=2 * n, axis=1)[:, :n]


def hyena_mix(u, conv_w, conv_b, filt, hyena_bias):
    n = u.shape[1]
    z = short_conv(u, conv_w, conv_b).astype(jnp.float32)
    v, x1, x2 = jnp.split(z, HYENA_ORDER + 1, axis=-1)
    k = hyena_filters(n, *filt)
    bias = hyena_bias.astype(jnp.float32)
    y = v
    for o, gate in enumerate((x1, x2)):
        y = gate * (fft_long_conv(y, k[:, o]) + y * bias[o])
    return y.astype(u.dtype)


def mix_tokens(p, kc, vc, pos, sink, conv_w, conv_b, filt, hyena_bias, w_ba, w_bf, w_bh, w_out):
    bsz, n, _ = p.shape
    q = p[..., Q_OFF:K_OFF].reshape(bsz, n, N_Q_HEADS, HEAD_DIM)
    if pos is None:
        ya = context_attention(q, kc, vc, sink)
    else:
        rows, cols = pos
        k = p[..., K_OFF:V_OFF].reshape(bsz, n, N_KV_HEADS, HEAD_DIM)
        v = p[..., V_OFF:F_OFF].reshape(bsz, n, N_KV_HEADS, HEAD_DIM)
        ya = banded_attention(axial_rope(q, rows, cols), axial_rope(k, rows, cols), v, kc, vc, sink)
    yf = fourier_mix(p[..., F_OFF:H_OFF])
    yh = hyena_mix(p[..., H_OFF:G_OFF], conv_w, conv_b, filt, hyena_bias)
    ga, gf, gh = jnp.split(jax.nn.sigmoid(p[..., G_OFF:]), N_BRANCHES, axis=-1)
    merged = ga * (ya @ w_ba) + gf * (yf @ w_bf) + gh * (yh @ w_bh)
    return merged @ w_out


def moe_ffn(h, w_router, b_router, w_gate, w_up, w_down):
    shape = h.shape
    tok = h.reshape(-1, D_MODEL)
    n_tok = tok.shape[0]
    aff = jax.nn.sigmoid((tok @ w_router).astype(jnp.float32))
    biased = (aff + b_router.astype(jnp.float32)).reshape(n_tok, N_GROUPS, EXPERTS_PER_GROUP)
    group_score = lax.top_k(biased, TOP_K)[0].sum(axis=-1)
    g_sel = jnp.argmax(group_score, axis=-1).astype(jnp.int32)
    in_group = jnp.take_along_axis(biased, g_sel[:, None, None], axis=1)[:, 0]
    e_idx = g_sel[:, None] * EXPERTS_PER_GROUP + lax.top_k(in_group, TOP_K)[1]
    w_sel = jnp.take_along_axis(aff, e_idx, axis=1)
    w_sel = w_sel / jnp.sum(w_sel, axis=-1, keepdims=True)
    n_asg = n_tok * TOP_K
    flat_e = e_idx.reshape(-1)
    flat_tok = jnp.repeat(jnp.arange(n_tok, dtype=jnp.int32), TOP_K)
    order = jnp.argsort(flat_e)
    se = flat_e[order]
    counts = jnp.bincount(flat_e, length=N_EXPERTS)
    padded = (counts + EXPERT_BLOCK - 1) // EXPERT_BLOCK * EXPERT_BLOCK
    pad_end = jnp.cumsum(padded)
    pad_start = pad_end - padded
    start = jnp.cumsum(counts) - counts
    dest = pad_start[se] + jnp.arange(n_asg, dtype=jnp.int32) - start[se]
    n_rows = -(-n_asg // EXPERT_BLOCK) * EXPERT_BLOCK + N_EXPERTS * EXPERT_BLOCK
    n_blk = n_rows // EXPERT_BLOCK
    row_tok = jnp.full((n_rows,), n_tok, jnp.int32).at[dest].set(flat_tok[order])
    row_w = jnp.zeros((n_rows,), jnp.float32).at[dest].set(w_sel.reshape(-1)[order])
    blk_expert = jnp.minimum(
        jnp.searchsorted(pad_end, jnp.arange(n_blk, dtype=pad_end.dtype) * EXPERT_BLOCK, side='right'),
        N_EXPERTS - 1)
    tok_pad = jnp.concatenate([tok, jnp.zeros((1, D_MODEL), tok.dtype)], axis=0)
    xs = tok_pad[row_tok].reshape(n_blk, EXPERT_BLOCK, D_MODEL)

    def expert_block(args):
        xb, e = args
        hb = jax.nn.silu(xb @ w_gate[e]) * (xb @ w_up[e])
        return hb @ w_down[e]

    ys = lax.map(expert_block, (xs, blk_expert)).reshape(n_rows, D_MODEL)
    out = jnp.zeros((n_tok + 1, D_MODEL), ys.dtype).at[row_tok].add(ys * row_w[:, None].astype(ys.dtype))
    return out[:n_tok].reshape(shape)


def setup_inputs(seed: int = 0) -> dict:
    key = jax.random.key(seed)
    ks = jax.random.split(key, 32)
    D = D_MODEL
    L = DEPTH

    def nrm(k, shape, scale):
        return scale * jax.random.normal(k, shape, jnp.float32)

    return {
        'x': nrm(ks[0], (BATCH, SEQ, D), 1.0),
        'c': nrm(ks[1], (BATCH, D), 1.0),
        'ctx': nrm(ks[2], (BATCH, CTX_LEN, D), 1.0),
        'c_ctx': nrm(ks[3], (D,), 1.0),
        'w_mod': nrm(ks[4], (L, D, N_MOD * D), 0.5 * D ** -0.5),
        'b_mod': nrm(ks[5], (L, N_MOD * D), 0.02),
        'norm_mix': 1.0 + nrm(ks[6], (L, D), 0.02),
        'norm_ffn': 1.0 + nrm(ks[7], (L, D), 0.02),
        'w_in': nrm(ks[8], (L, D, IN_WIDTH), D ** -0.5),
        'attn_sink': nrm(ks[9], (L, N_Q_HEADS), 0.5),
        'conv_w': nrm(ks[10], (L, SHORT_CONV, (HYENA_ORDER + 1) * HYENA_WIDTH), SHORT_CONV ** -0.5),
        'conv_b': nrm(ks[11], (L, (HYENA_ORDER + 1) * HYENA_WIDTH), 0.02),
        'filt_w1': nrm(ks[12], (L, FILTER_EMB, FILTER_HIDDEN), FILTER_EMB ** -0.5),
        'filt_b1': nrm(ks[13], (L, FILTER_HIDDEN), 0.02),
        'filt_freq': 1.0 + nrm(ks[14], (L, FILTER_HIDDEN), 0.02),
        'filt_w2': nrm(ks[15], (L, FILTER_HIDDEN, FILTER_HIDDEN), FILTER_HIDDEN ** -0.5),
        'filt_b2': nrm(ks[16], (L, FILTER_HIDDEN), 0.02),
        'filt_w3': nrm(ks[17], (L, FILTER_HIDDEN, HYENA_ORDER * 2 * HYENA_WIDTH), FILTER_HIDDEN ** -0.5),
        'hyena_bias': nrm(ks[18], (L, HYENA_ORDER, HYENA_WIDTH), 0.5),
        'w_branch_attn': nrm(ks[19], (L, ATTN_WIDTH, D), ATTN_WIDTH ** -0.5),
        'w_branch_fnet': nrm(ks[20], (L, FNET_WIDTH, D), FNET_WIDTH ** -0.5),
        'w_branch_hyena': nrm(ks[21], (L, HYENA_WIDTH, D), HYENA_WIDTH ** -0.5),
        'w_out': nrm(ks[22], (L, D, D), D ** -0.5),
        'w_router': nrm(ks[23], (D, N_EXPERTS), D ** -0.5),
        'b_router': nrm(ks[24], (N_EXPERTS,), 0.01),
        'w_exp_gate': nrm(ks[25], (L, N_EXPERTS, D, EXPERT_FF), D ** -0.5),
        'w_exp_up': nrm(ks[26], (L, N_EXPERTS, D, EXPERT_FF), D ** -0.5),
        'w_exp_down': nrm(ks[27], (L, N_EXPERTS, EXPERT_FF, D), EXPERT_FF ** -0.5),
        'norm_final': 1.0 + nrm(ks[28], (D,), 0.02),
    }


def reference(x, c, ctx, c_ctx, w_mod, b_mod, norm_mix, norm_ffn, w_in, attn_sink, conv_w, conv_b,
              filt_w1, filt_b1, filt_freq, filt_w2, filt_b2, filt_w3, hyena_bias,
              w_branch_attn, w_branch_fnet, w_branch_hyena, w_out,
              w_router, b_router, w_exp_gate, w_exp_up, w_exp_down, norm_final):
    bsz, n_lat, _ = x.shape
    n_ctx = ctx.shape[1]
    ROWS = n_lat // GRID_W
    rows = jnp.repeat(jnp.arange(ROWS, dtype=jnp.int32), GRID_W)
    cols = jnp.tile(jnp.arange(GRID_W, dtype=jnp.int32), ROWS)
    xl, xc = x, ctx
    silu_c = jax.nn.silu(c)
    silu_cc = jax.nn.silu(c_ctx)
    for l in range(DEPTH):
        last = l == DEPTH - 1
        mod_l = jnp.split(silu_c @ w_mod[l] + b_mod[l], N_MOD, axis=-1)
        mod_c = jnp.split(silu_cc @ w_mod[l] + b_mod[l], N_MOD, axis=-1)
        sh1, sc1, g1, sh2, sc2, g2 = [m[:, None, :] for m in mod_l]
        csh1, csc1, cg1, csh2, csc2, cg2 = mod_c
        filt = (filt_w1[l], filt_b1[l], filt_freq[l], filt_w2[l], filt_b2[l], filt_w3[l])
        mixer_weights = (attn_sink[l], conv_w[l], conv_b[l], filt, hyena_bias[l],
                         w_branch_attn[l], w_branch_fnet[l], w_branch_hyena[l], w_out[l])
        hl = modulate(rms_norm(xl, norm_mix[l]), sh1, sc1)
        hc = modulate(rms_norm(xc, norm_mix[l]), csh1, csc1)
        if last:
            kv_c = hc @ w_in[l][:, K_OFF:F_OFF]
        else:
            pc = hc @ w_in[l]
            kv_c = pc[..., K_OFF:F_OFF]
        kc = kv_c[..., :KV_WIDTH].reshape(bsz, n_ctx, N_KV_HEADS, HEAD_DIM)
        vc = kv_c[..., KV_WIDTH:].reshape(bsz, n_ctx, N_KV_HEADS, HEAD_DIM)
        pl = hl @ w_in[l]
        xl = xl + g1 * mix_tokens(pl, kc, vc, (rows, cols), *mixer_weights)
        if not last:
            xc = xc + cg1 * mix_tokens(pc, kc, vc, None, *mixer_weights)
        experts = (w_exp_gate[l], w_exp_up[l], w_exp_down[l])
        h2l = modulate(rms_norm(xl, norm_ffn[l]), sh2, sc2)
        xl = xl + g2 * moe_ffn(h2l, w_router, b_router, *experts)
        if not last:
            h2c = modulate(rms_norm(xc, norm_ffn[l]), csh2, csc2)
            xc = xc + cg2 * moe_ffn(h2c, w_router, b_router, *experts)
    return rms_norm(xl, norm_final)
```

```cpp
#include <hip/hip_runtime.h>
#include <cstdio>
#include <cstdint>

#define GAS __attribute__((address_space(1)))
#define LAS __attribute__((address_space(3)))
typedef unsigned short bf16;
typedef float f32x4 __attribute__((ext_vector_type(4)));
typedef float f32x2 __attribute__((ext_vector_type(2)));
typedef short bf16x8 __attribute__((ext_vector_type(8)));
typedef unsigned u32x4 __attribute__((ext_vector_type(4)));
typedef unsigned u32x2 __attribute__((ext_vector_type(2)));

constexpr int D = 1024, NB = 4, SEQ = 4096, DEPTH = 4, CTXL = 256, GRIDW = 64;
constexpr int ML = NB * SEQ, MC = NB * CTXL, MT = ML + MC;
constexpr int HD = 64, NQH = 8, NKVH = 2;
constexpr int K_OFF = 512, V_OFF = 640, F_OFF = 768, H_OFF = 1280, G_OFF = 2816, INW = 5888;
constexpr int NEXP = 16, FF = 1024;
constexpr int NMOD = 6;
constexpr int NWAVES = 8, NTHR = 512;
constexpr float EPS = 1e-6f;
constexpr int QKVW = 768;
constexpr int GW = 3072;
constexpr int NQKVG = QKVW + GW;
constexpr int HYW = 1536;
constexpr int XS_ROWS = 39168;

constexpr size_t MiB = 1u << 20;
constexpr size_t WS_CTL = 0, CTL_ZERO_BYTES = 1 * MiB;
constexpr size_t WS_MODS = 1 * MiB;
constexpr size_t WS_ROPE = WS_MODS + 512 * 1024;
constexpr size_t WS_ROUTE = 2 * MiB;
constexpr size_t WS_SLOT = WS_ROUTE + 320 * 1024;
constexpr size_t WS_WGCNT = WS_SLOT + 192 * 1024;
constexpr size_t WS_TILEINFO = WS_WGCNT + 64 * 1024;
constexpr size_t WS_TC = 3 * MiB;
constexpr size_t WS_FT1 = WS_TC + 256 * 1024;
constexpr size_t WS_FT1F = WS_FT1 + 65536, WS_FT2 = WS_FT1F + 65536, WS_FT3 = WS_FT2 + 32768, WS_FT4 = WS_FT3 + 32768;
static_assert(WS_FT4 + 65536 <= 4 * MiB, "tables");
constexpr size_t WS_W = 4 * MiB;
constexpr size_t WL_QKVG = 0;
constexpr size_t WL_G8 = (size_t)QKVW * D * 2;
constexpr size_t WL_F = WL_QKVG + (size_t)NQKVG * D * 2;
constexpr size_t WL_H = WL_F + (size_t)1024 * D * 2;
constexpr size_t WL_BA = WL_H + (size_t)HYW * D * 2;
constexpr size_t WL_BF = WL_BA + (size_t)D * 512 * 2;
constexpr size_t WL_BH = WL_BF + (size_t)D * 512 * 2;
constexpr size_t WL_OUT = WL_BH + (size_t)D * 512 * 2;
constexpr size_t WL_SIZE = WL_OUT + (size_t)D * D * 2;
constexpr size_t WS_WEXP = WS_W + DEPTH * WL_SIZE;
constexpr size_t WE_GU = 0;
constexpr size_t WE_D = (size_t)NEXP * 2048 * D;
constexpr size_t WE_BUF = WE_D + (size_t)NEXP * D * FF;
constexpr size_t WE_SIZE = 2 * WE_BUF;
constexpr size_t WS_TDFT = WS_WEXP + WE_SIZE;
constexpr size_t WS_HID = WS_TDFT;
constexpr size_t WS_W3T = WS_HID + 4 * MiB;
constexpr size_t WS_HFILT = WS_TDFT + (size_t)4096 * 8192 * 2;
constexpr size_t HF_LAYER = (size_t)4352 * 2048 * 4;
constexpr size_t WS_X = WS_HFILT + DEPTH * HF_LAYER;
constexpr size_t WS_HN = WS_X + (size_t)MT * D * 4;
constexpr size_t WS_U = WS_HN + (size_t)MT * D * 2;
constexpr size_t WS_QKV = WS_U;
constexpr size_t WS_G = WS_QKV + (size_t)MT * QKVW * 2;
constexpr size_t WS_FT = WS_G + (size_t)MT * GW * 2;
constexpr size_t WS_FTC = WS_FT + (size_t)NB * 512 * 8192 * 2;
constexpr size_t WS_UT = WS_FTC + (size_t)NB * 512 * 512 * 2;
constexpr size_t WS_YA = WS_UT + (size_t)HYW * MT * 2;
constexpr size_t WS_YM = WS_YA; constexpr int YMW = 1536;
constexpr size_t WS_YF = WS_YA + (size_t)MT * 512 * 2;
constexpr size_t WS_YH = WS_YF + (size_t)MT * 512 * 2;
constexpr size_t WS_MF = WS_YH + (size_t)MT * 512 * 2;
constexpr size_t WS_MB = WS_MF + (size_t)MT * D * 4;
constexpr size_t WS_MIX_END = WS_MB + (size_t)MT * D * 2;
constexpr size_t WS_XS = WS_U;
constexpr size_t WS_HM = WS_XS + (size_t)XS_ROWS * D * 2;
constexpr size_t WS_Y = WS_HM + (size_t)XS_ROWS * D * 2;
constexpr size_t WS_MOE_END = WS_Y + (size_t)XS_ROWS * D * 2;
constexpr size_t WS_KF = WS_MIX_END > WS_MOE_END ? WS_MIX_END : WS_MOE_END;
constexpr size_t WS_SSQ = WS_KF + (size_t)512 * 2 * 8192 * 8;
constexpr size_t WS_HN8 = WS_SSQ + (size_t)MT * 16 * 4;
constexpr size_t WS_YB = WS_HN8 + (size_t)MT * D;
constexpr size_t WS_END = WS_YB + (size_t)128 * MT * 16;

constexpr int CW_BAR = 4096;

constexpr int RING_BYTES = 131072;
constexpr int LDS_BYTES = 147456;
constexpr int MISC_OFF = LDS_BYTES - 256;

__device__ __forceinline__ unsigned pk2(float lo, float hi) { unsigned r; asm("v_cvt_pk_bf16_f32 %0, %1, %2" : "=v"(r) : "v"(lo), "v"(hi)); return r; }
__device__ __forceinline__ float bflo(unsigned u) { return __uint_as_float(u << 16); }
__device__ __forceinline__ float bfhi(unsigned u) { return __uint_as_float(u & 0xffff0000u); }
__device__ __forceinline__ float bf2f(bf16 b) { return __uint_as_float(((unsigned)b) << 16); }
__device__ __forceinline__ bf16 f2bf(float f) { return (bf16)(pk2(f, 0.f) & 0xffffu); }
__device__ __forceinline__ float shx(float v, int o, int lane) {
    const unsigned u = __float_as_uint(v);
    if (o == 16) { const auto r = __builtin_amdgcn_permlane16_swap(u, u, false, false); return __uint_as_float((lane & 16) ? r[0] : r[1]); }
    const auto r = __builtin_amdgcn_permlane32_swap(u, u, false, false); return __uint_as_float((lane & 32) ? r[0] : r[1]);
}
__device__ __forceinline__ float rdlane(float v, int i) { return __int_as_float(__builtin_amdgcn_readlane(__float_as_int(v), i)); }
#define DPP_ADD(v, ctrl) ((v) + __int_as_float(__builtin_amdgcn_update_dpp(0, __float_as_int(v), (ctrl), 0xF, 0xF, false)))
__device__ __forceinline__ float wave_sum(float v, int lane) {
    v = DPP_ADD(v, 0xB1); v = DPP_ADD(v, 0x4E); v = DPP_ADD(v, 0x141); v = DPP_ADD(v, 0x140);
    v += shx(v, 16, lane); v += shx(v, 32, lane);
    return v;
}
#define LDS_WAIT() asm volatile("s_waitcnt lgkmcnt(0)" ::: "memory")
#define VM_WAIT() asm volatile("s_waitcnt vmcnt(0)" ::: "memory")
__device__ __forceinline__ unsigned pk4_fp8(float a, float b, float c, float d) { int w = 0; w = __builtin_amdgcn_cvt_pk_fp8_f32(a, b, w, false); w = __builtin_amdgcn_cvt_pk_fp8_f32(c, d, w, true); return (unsigned)w; }
constexpr float FP8_ACT_SCALE = 8.0f, FP8_HM_SCALE = 8.0f, FP8_W_SCALE = 32.0f;
constexpr int E8_ACT = 0x7B7B7B7B, E8_HM = 0x7B7B7B7B, E8_W = 0x7B7B7B7B;
__device__ __forceinline__ float sigmoidf_(float x) { return __builtin_amdgcn_rcpf(1.0f + __expf(-x)); }

#define XB_TMO      128
#define XB_XCNT(j)  (256  + 64 * (j))
#define XB_XSUB(j)  (1280 + 64 * (j))
#define XB_XGEN(j)  (2304 + 64 * (j))
#define XB_TOP      3328
#define XB_TOPGEN   3392
#define XCD_BAR_WORDS 3456
#define XB_SPIN_CAP (1u << 23)

__device__ __forceinline__ unsigned xb_ld(unsigned* p)              { return __hip_atomic_load(p, __ATOMIC_RELAXED, __HIP_MEMORY_SCOPE_AGENT); }
__device__ __forceinline__ unsigned xb_add(unsigned* p, unsigned v) { return __hip_atomic_fetch_add(p, v, __ATOMIC_RELAXED, __HIP_MEMORY_SCOPE_AGENT); }
__device__ __forceinline__ unsigned xb_xcc_id() { return (unsigned)__builtin_amdgcn_s_getreg((3 << 11) | 20) & 0xFu; }
#define XB_SPIN(cond, bar) do { unsigned _sp = 0; while (cond) { __builtin_amdgcn_s_sleep(1); \
    if ((++_sp & 255u) == 0u) { if (xb_ld(&(bar)[XB_TMO])) break; if (_sp > XB_SPIN_CAP) { atomicAdd(&(bar)[XB_TMO], 1u); break; } } } } while (0)

struct XcdBarrier {
    unsigned* bar; unsigned x;
    volatile LAS unsigned* st;
};

__device__ __forceinline__ XcdBarrier xcd_barrier_post(unsigned* bar, volatile LAS unsigned* st) {
    XcdBarrier b; b.bar = bar; b.x = xb_xcc_id(); b.st = st;
    if (threadIdx.x == 0) (void)xb_add(&bar[XB_XCNT(b.x)], 1u);
    return b;
}
__device__ __forceinline__ void xcd_barrier_complete(unsigned* bar, unsigned x, unsigned& nloc, unsigned& nx) {
    const unsigned G = gridDim.x * gridDim.y * gridDim.z;
    unsigned sum, cnt, mine, sp = 0u;
    for (;;) {
        sum = 0u; cnt = 0u; mine = 0u;
#pragma unroll
        for (unsigned j = 0; j < 16; ++j) { const unsigned c = xb_ld(&bar[XB_XCNT(j)]); sum += c; cnt += (c > 0u) ? 1u : 0u; mine = (j == x) ? c : mine; }
        if (sum == G) break;
        __builtin_amdgcn_s_sleep(1);
        if ((++sp & 255u) == 0u) { if (xb_ld(&bar[XB_TMO])) break; if (sp > XB_SPIN_CAP) { atomicAdd(&bar[XB_TMO], 1u); break; } }
    }
    nloc = mine > 0u ? mine : 1u; nx = cnt > 0u ? cnt : 1u;
}

__device__ __forceinline__ void xcd_barrier(const XcdBarrier& b) {
    asm volatile("s_waitcnt vmcnt(0)" ::: "memory");
    __syncthreads();
    if (threadIdx.x == 0) {
        unsigned* bar = b.bar;
        __builtin_amdgcn_s_waitcnt(0);
        unsigned nloc = b.st[0], nx = b.st[1];
        if (nloc == 0u) { xcd_barrier_complete(bar, b.x, nloc, nx); b.st[0] = nloc; b.st[1] = nx; }
        const unsigned old = xb_add(&bar[XB_XSUB(b.x)], 1u);
        const unsigned gen = old / nloc;
        if (old + 1u == (gen + 1u) * nloc) {
            __builtin_amdgcn_fence(__ATOMIC_RELEASE, "agent");
            asm volatile("s_waitcnt vmcnt(0)" ::: "memory");
            const unsigned og = xb_add(&bar[XB_TOP], 1u);
            const unsigned tg = og / nx;
            if (og + 1u == (tg + 1u) * nx) xb_add(&bar[XB_TOPGEN], 1u);
            else XB_SPIN(xb_ld(&bar[XB_TOPGEN]) == tg, bar);
            __builtin_amdgcn_fence(__ATOMIC_ACQUIRE, "agent");
            xb_add(&bar[XB_XGEN(b.x)], 1u);
            asm volatile("s_waitcnt vmcnt(0)" ::: "memory");
        } else {
            XB_SPIN(xb_ld(&bar[XB_XGEN(b.x)]) == gen, bar);
            __builtin_amdgcn_fence(__ATOMIC_ACQUIRE, "agent");
            asm volatile("s_waitcnt vmcnt(0)" ::: "memory");
        }
    }
    __syncthreads();
}

namespace pg8 {
constexpr int BM = 256, BK = 64, HALF = 128, HTB = HALF * BK * 2, STAGE_BYTES = 8 * HTB;
__host__ __device__ __forceinline__ int lds_byte(int r, int c) { const int st = (r >> 4) * 2 + (c >> 5), rr = r & 15, cc = c & 31, ob = rr * 64 + cc * 2; return st * 1024 + (ob ^ (((ob >> 9) & 1) << 5)); }
__host__ __device__ __forceinline__ void stage_rc(int b, int& R, int& C) { const int st = b / 1024, sb = b % 1024, swz = sb ^ (((sb >> 9) & 1) << 5); R = (st >> 1) * 16 + swz / 64; C = (st & 1) * 32 + (swz % 64) / 2; }

struct Unit { const char* a; const char* b; int p0, p1, p2, p3; };
__device__ __forceinline__ const char* uni_ptr(const char* p) { const unsigned long long v = (unsigned long long)p; const unsigned lo = (unsigned)__builtin_amdgcn_readfirstlane((int)(unsigned)v), hi = (unsigned)__builtin_amdgcn_readfirstlane((int)(unsigned)(v >> 32)); return (const char*)(((unsigned long long)hi << 32) | lo); }
__device__ __forceinline__ void uni_unit(Unit& u) { u.a = uni_ptr(u.a); u.b = uni_ptr(u.b); u.p0 = __builtin_amdgcn_readfirstlane(u.p0); u.p1 = __builtin_amdgcn_readfirstlane(u.p1); u.p2 = __builtin_amdgcn_readfirstlane(u.p2); u.p3 = __builtin_amdgcn_readfirstlane(u.p3); }
struct Shape { int K; int lda, ldb; int sa, sb; const void* abase; const void* bbase; unsigned hbase; };
typedef int v8i __attribute__((ext_vector_type(8)));

struct FragH { bf16x8 hx[2]; }; struct FragW { v8i wx; };
template <bool F8> struct FragSel { typedef FragH type; }; template <> struct FragSel<true> { typedef FragW type; };
__device__ __forceinline__ void ld_h(FragH& f, int k, const LAS unsigned char* p) { f.hx[k] = *(const LAS bf16x8*)p; }
__device__ __forceinline__ void ld_h(FragW&, int, const LAS unsigned char*) {}
__device__ __forceinline__ void ld_w(FragW& f, const LAS unsigned char* p) { const u32x4 lo = *(const LAS u32x4*)p, hi = *(const LAS u32x4*)(p + 16); f.wx = __builtin_bit_cast(v8i, __builtin_shufflevector(lo, hi, 0, 1, 2, 3, 4, 5, 6, 7)); }
__device__ __forceinline__ void ld_w(FragH&, const LAS unsigned char*) {}
__device__ __forceinline__ f32x4 mma_frag(const FragH& b, const FragH& a, f32x4 c, int, int) { c = __builtin_amdgcn_mfma_f32_16x16x32_bf16(b.hx[0], a.hx[0], c, 0, 0, 0); return __builtin_amdgcn_mfma_f32_16x16x32_bf16(b.hx[1], a.hx[1], c, 0, 0, 0); }
__device__ __forceinline__ f32x4 mma_frag(const FragW& b, const FragW& a, f32x4 c, int sB, int sA) { return __builtin_amdgcn_mfma_scale_f32_16x16x128_f8f6f4(b.wx, a.wx, c, 0, 0, 0, sB, 0, sA); }
__host__ __device__ __forceinline__ int perm32(int rho) { const int n = rho >> 4, i = rho & 15; return 8 * (i >> 2) + 4 * n + (i & 3); }
template <class Epi, class Sched, bool FP8 = false, bool PERMB = false, int HSEG = 0>
__device__ __forceinline__ void gemm_phase(const int tid, LAS unsigned char* lds, const Shape g, const Sched& S, const Epi& E) {
    const int wid = __builtin_amdgcn_readfirstlane(tid >> 6), lane = tid & 63, wr = wid >> 2, wc = wid & 3, fr = lane & 15, fq = lane >> 4;
    int K = g.K, lda = g.lda, ldb = g.ldb; asm volatile("" : "+s"(K), "+s"(lda), "+s"(ldb));
    const int nt = FP8 ? K / 128 : K / BK;
    const int sA = g.sa, sB = g.sb;
    unsigned voffA[2], voffBp[2];
#pragma unroll
    for (int i = 0; i < 2; ++i) { int R, C; stage_rc(tid * 16 + i * 8192, R, C);
        voffA[i] = FP8 ? (unsigned)(R * lda + 2 * C) : (unsigned)(R * lda + C) * 2u;
        const int Rb = (R & ~31) + perm32(R & 31); voffBp[i] = PERMB ? (FP8 ? (unsigned)(Rb * ldb + 2 * C) : (unsigned)(Rb * ldb + C) * 2u) : voffA[i]; }
#define voffB voffBp
    unsigned voffH[2] = {0u, 0u};
    if constexpr (HSEG > 0) {
#pragma unroll
        for (int i = 0; i < 2; ++i) { int R, C; stage_rc(tid * 16 + i * 8192, R, C); voffH[i] = (unsigned)(((C >> 3) * MT + R) * 16); }
    }
    constexpr unsigned hkstep = 8u * (unsigned)MT * 16u, hhstep = (unsigned)HALF * 16u;
    const unsigned kstep = (unsigned)(BK * 2);
    const unsigned hstepA = (unsigned)HALF * lda * (FP8 ? 1 : 2), hstepB = (unsigned)HALF * ldb * (FP8 ? 1 : 2);
    const __amdgpu_buffer_rsrc_t rsA = __builtin_amdgcn_make_buffer_rsrc((void*)g.abase, 0, 0xffffffff, 0x00020000), rsB = __builtin_amdgcn_make_buffer_rsrc((void*)g.bbase, 0, 0xffffffff, 0x00020000);
    const unsigned ldsw = (unsigned)wid * 1024u;
    const int aoff = lds_byte(wr * 64 + fr, FP8 ? fq * 16 : fq * 8), boff = lds_byte(wc * 32 + fr, FP8 ? fq * 16 : fq * 8);
#define PG8_SA(b, h) (((b) * 2 + (h)) * HTB)
#define PG8_SB(b, h) ((4 + (b) * 2 + (h)) * HTB)
#define PG8_STAGE(bufoff, rs_soff, voff) do { _Pragma("unroll") for (int _i = 0; _i < 2; ++_i) \
        __builtin_amdgcn_raw_ptr_buffer_load_lds(PG8_RS rs_soff, (LAS unsigned*)(lds + (bufoff) + ldsw + _i * 8192), 16, (voff)[_i], PG8_SO rs_soff, 0, 0); } while (0)
#define PG8_RS(r, s) r
#define PG8_SO(r, s) (int)(s)
#define PG8_LDA(dst, b, h) do { _Pragma("unroll") for (int m = 0; m < 4; ++m) { if constexpr (FP8) ld_w(dst[m], lds + PG8_SA(b, h) + aoff + m * 2048); else { _Pragma("unroll") for (int k = 0; k < 2; ++k) ld_h(dst[m], k, lds + PG8_SA(b, h) + aoff + m * 2048 + k * 1024); } } } while (0)
#define PG8_LDB(dst, b, h) do { _Pragma("unroll") for (int n = 0; n < 2; ++n) { if constexpr (FP8) ld_w(dst[n], lds + PG8_SB(b, h) + boff + n * 2048); else { _Pragma("unroll") for (int k = 0; k < 2; ++k) ld_h(dst[n], k, lds + PG8_SB(b, h) + boff + n * 2048 + k * 1024); } } } while (0)
#define PG8_MMA(ai, bj, At, Bt) do { __builtin_amdgcn_s_setprio(1); _Pragma("unroll") for (int m = 0; m < 4; ++m) _Pragma("unroll") for (int n = 0; n < 2; ++n) { \
        acc[ai][bj][m][n] = mma_frag(Bt[n], At[m], acc[ai][bj][m][n], sB, sA); } \
        __builtin_amdgcn_s_setprio(0); } while (0)
#define PG8_WAIT_V(n) asm volatile("s_waitcnt vmcnt(" #n ")" ::: "memory")
#define PG8_WAIT_L(n) asm volatile("s_waitcnt lgkmcnt(" #n ")" ::: "memory")
#define PG8_BAR __builtin_amdgcn_s_barrier()
#define PG8_SCHED __builtin_amdgcn_sched_barrier(0)
    Unit cur, nxt; int ui = 0;
    if (!S.next(0, cur)) return;
    uni_unit(cur);
    f32x4 acc[2][2][4][2];
#pragma unroll
    for (int a = 0; a < 2; ++a)
#pragma unroll
        for (int b = 0; b < 2; ++b)
#pragma unroll
            for (int m = 0; m < 4; ++m)
#pragma unroll
                for (int n = 0; n < 2; ++n) acc[a][b][m][n] = (f32x4){0.f, 0.f, 0.f, 0.f};
    typename FragSel<FP8>::type At[4], B0[2], B1[2];
    unsigned cA = (unsigned)(cur.a - (const char*)g.abase), cB = (unsigned)(cur.b - (const char*)g.bbase);
    PG8_STAGE(PG8_SB(0, 0), (rsB, cB), voffB); PG8_STAGE(PG8_SB(0, 1), (rsB, cB + hstepB), voffB); PG8_STAGE(PG8_SA(0, 0), (rsA, cA), voffA); PG8_STAGE(PG8_SA(0, 1), (rsA, cA + hstepA), voffA);
    if (wr == 1) PG8_BAR;
    PG8_WAIT_V(2); PG8_BAR;
    PG8_STAGE(PG8_SB(1, 0), (rsB, cB + kstep), voffB); PG8_STAGE(PG8_SA(1, 0), (rsA, cA + kstep), voffA); PG8_STAGE(PG8_SB(1, 1), (rsB, cB + hstepB + kstep), voffB);
    PG8_WAIT_V(6); PG8_BAR;
    for (;;) {
        const bool has_next = __builtin_amdgcn_readfirstlane((int)S.next(ui + 1, nxt)) != 0;
        uni_unit(nxt);
        const unsigned nA = has_next ? (unsigned)(nxt.a - (const char*)g.abase) : cA, nB = has_next ? (unsigned)(nxt.b - (const char*)g.bbase) : cB;
        for (int t = 0; t < nt; t += 2) {
            const bool last = (t == nt - 2);
            if constexpr (Epi::MID > 0) { if (t != 0 && (t % Epi::MID) == 0) E.mid(acc, cur, t / Epi::MID, wr, wc, fr, fq); }
            unsigned a1 = cA + (unsigned)(t + 1) * kstep;
            unsigned a2 = last ? nA : cA + (unsigned)(t + 2) * kstep; const unsigned b2 = last ? nB : cB + (unsigned)(t + 2) * kstep;
            unsigned a3 = a2 + kstep; const unsigned b3 = b2 + kstep;
            unsigned hs1 = hstepA, hs2 = hstepA; unsigned vA1[2] = {voffA[0], voffA[1]}, vA2[2] = {voffA[0], voffA[1]}, vA3[2] = {voffA[0], voffA[1]};
            if constexpr (HSEG > 0) {
                const unsigned hb = g.hbase + (unsigned)cur.p0 * (256u * 16u);
                if (t + 1 >= HSEG) { a1 = hb + (unsigned)(t + 1 - HSEG) * hkstep; hs1 = hhstep; vA1[0] = voffH[0]; vA1[1] = voffH[1]; }
                if (!last && t + 2 >= HSEG) { a2 = hb + (unsigned)(t + 2 - HSEG) * hkstep; hs2 = hhstep; vA2[0] = voffH[0]; vA2[1] = voffH[1]; }
                if (!last && t + 3 >= HSEG) { a3 = hb + (unsigned)(t + 3 - HSEG) * hkstep; vA3[0] = voffH[0]; vA3[1] = voffH[1]; }
            }
            PG8_LDB(B0, 0, 0); PG8_LDB(B1, 0, 1); PG8_SCHED; PG8_LDA(At, 0, 0); PG8_STAGE(PG8_SA(1, 1), (rsA, a1 + hs1), vA1);
            PG8_WAIT_V(8); PG8_WAIT_L(0); PG8_BAR; PG8_MMA(0, 0, At, B0); PG8_MMA(0, 1, At, B1); PG8_BAR; PG8_SCHED;
            PG8_LDA(At, 0, 1); PG8_STAGE(PG8_SB(0, 0), (rsB, b2), voffB); PG8_STAGE(PG8_SB(0, 1), (rsB, b2 + hstepB), voffB); PG8_STAGE(PG8_SA(0, 0), (rsA, a2), vA2);
            PG8_WAIT_V(8); PG8_WAIT_L(0); PG8_BAR; PG8_MMA(1, 0, At, B0); PG8_MMA(1, 1, At, B1); PG8_BAR; PG8_SCHED;
            PG8_LDB(B0, 1, 0); PG8_LDB(B1, 1, 1); PG8_SCHED; PG8_LDA(At, 1, 0); PG8_STAGE(PG8_SA(0, 1), (rsA, a2 + hs2), vA2);
            PG8_WAIT_V(8); PG8_WAIT_L(0); PG8_BAR; PG8_MMA(0, 0, At, B0); PG8_MMA(0, 1, At, B1); PG8_BAR; PG8_SCHED;
            PG8_LDA(At, 1, 1); PG8_STAGE(PG8_SB(1, 0), (rsB, b3), voffB); PG8_STAGE(PG8_SB(1, 1), (rsB, b3 + hstepB), voffB); PG8_STAGE(PG8_SA(1, 0), (rsA, a3), vA3);
            PG8_WAIT_V(8); PG8_WAIT_L(0); PG8_BAR; PG8_MMA(1, 0, At, B0); PG8_MMA(1, 1, At, B1); PG8_BAR; PG8_SCHED;
        }
        if (wr == 0) PG8_BAR;
        E(acc, cur, wr, wc, fr, fq);
        if (!has_next) break;
#pragma unroll
        for (int a = 0; a < 2; ++a)
#pragma unroll
            for (int b = 0; b < 2; ++b)
#pragma unroll
                for (int m = 0; m < 4; ++m)
#pragma unroll
                    for (int n = 0; n < 2; ++n) acc[a][b][m][n] = (f32x4){0.f, 0.f, 0.f, 0.f};
        cur = nxt; cA = nA; cB = nB; ++ui;
        if (wr == 1) PG8_BAR;
    }
    PG8_WAIT_V(0);
    PG8_BAR;
#undef voffB
#undef PG8_SA
#undef PG8_SB
#undef PG8_STAGE
#undef PG8_RS
#undef PG8_SO
#undef PG8_LDA
#undef PG8_LDB
#undef PG8_MMA
#undef PG8_WAIT_V
#undef PG8_WAIT_L
#undef PG8_BAR
#undef PG8_SCHED
}

template <int PMUL = 1>
struct GridOrder {
    const char* aBase; const char* bBase; size_t aTile, bTile; int nM, nN, nwg, G, c, nextra, epm, epn;
    __device__ void init(const void* a, const void* b, size_t at, size_t bt, int nM_, int nN_, int G_, int c_, int nextra_ = 0, int epm_ = 0, int epn_ = 0) { aBase = (const char*)a; bBase = (const char*)b; aTile = at; bTile = bt; nM = nM_; nN = nN_; nwg = nM * nN; G = G_; c = c_; nextra = nextra_; epm = epm_; epn = epn_; }
    __device__ __forceinline__ bool next(int i, Unit& u) const {
        const long L = (long)i * G + c; if (L >= nwg + nextra) return false;
        if (L >= nwg) { const int pm = epm + (int)(L - nwg), pn = epn; u.a = aBase + (size_t)pm * aTile; u.b = bBase + (size_t)pn * bTile; u.p0 = pm * PMUL; u.p1 = pn * PMUL; u.p2 = 0; u.p3 = 0; return true; }
        int wgid = (int)L; { const int q = nwg / 8, r = nwg % 8, xcd = wgid % 8, off = wgid / 8; wgid = (xcd < r ? xcd * (q + 1) : r * (q + 1) + (xcd - r) * q) + off; }
        const int nig = 8 * nN, gid = wgid / nig, fm = gid * 8, gsz = (nM - fm) < 8 ? (nM - fm) : 8;
        const int pm = fm + ((wgid % nig) % gsz), pn = (wgid % nig) / gsz;
        u.a = aBase + (size_t)pm * aTile; u.b = bBase + (size_t)pn * bTile; u.p0 = pm * PMUL; u.p1 = pn * PMUL; u.p2 = 0; u.p3 = 0; return true;
    }
};
}

using pg8::Unit;
#define EPI_ARGS const f32x4 (&acc)[2][2][4][2], const Unit& u, int wr, int wc, int fr, int fq

struct EpiStore {
    static constexpr int MID = 0;
    bf16* dst0; bf16* dst1; int ld0, ld1;
    __device__ __forceinline__ void operator()(EPI_ARGS) const {
        bf16* dst = u.p2 ? dst1 : dst0; const int ld = u.p2 ? ld1 : ld0;
        const size_t base = (size_t)(u.p0 + wr * 64 + fr) * ld + u.p1 + wc * 32 + 8 * fq;
#pragma unroll
        for (int ai = 0; ai < 2; ++ai)
#pragma unroll
            for (int m = 0; m < 4; ++m) { bf16* rowp = dst + base + (size_t)(ai * 128 + m * 16) * ld;
#pragma unroll
                for (int bj = 0; bj < 2; ++bj) { const f32x4 v0 = acc[ai][bj][m][0], v1 = acc[ai][bj][m][1];
                    u32x4 w; w.x = pk2(v0[0], v0[1]); w.y = pk2(v0[2], v0[3]); w.z = pk2(v1[0], v1[1]); w.w = pk2(v1[2], v1[3]); *(u32x4*)(rowp + bj * 128) = w; }
                asm volatile("" ::: "memory"); }
    }
};

struct EpiStoreBlk {
    static constexpr int MID = 0;
    bf16* dst;
    __device__ __forceinline__ void operator()(EPI_ARGS) const {
        const size_t base = ((size_t)((u.p1 + wc * 32 + 8 * fq) >> 3) * MT + (u.p0 + wr * 64 + fr)) * 8;
#pragma unroll
        for (int ai = 0; ai < 2; ++ai)
#pragma unroll
            for (int m = 0; m < 4; ++m) { bf16* rowp = dst + base + (size_t)(ai * 128 + m * 16) * 8;
#pragma unroll
                for (int bj = 0; bj < 2; ++bj) { const f32x4 v0 = acc[ai][bj][m][0], v1 = acc[ai][bj][m][1];
                    u32x4 w; w.x = pk2(v0[0], v0[1]); w.y = pk2(v0[2], v0[3]); w.z = pk2(v1[0], v1[1]); w.w = pk2(v1[2], v1[3]); *(u32x4*)(rowp + (size_t)bj * 16 * MT * 8) = w; }
                asm volatile("" ::: "memory"); }
    }
};
struct EpiQKVG {
    static constexpr int MID = 0;
    bf16* qkv; const float* rope;
    __device__ __forceinline__ void operator()(EPI_ARGS) const {
        const int pm = u.p0, pn = u.p1;
        const int row0 = pm * 256 + wr * 64 + fr;
        {
            const bool latent = pm < (ML / 256);
#pragma unroll
            for (int ai = 0; ai < 2; ++ai)
#pragma unroll
                for (int m = 0; m < 4; ++m) {
                    const int row = row0 + ai * 128 + m * 16; const int t = row & (SEQ - 1);
                    const int pos = (wc & 1) ? (t & 63) : (t >> 6);
                    bf16* rowp = qkv + (size_t)row * QKVW + pn * 256 + wc * 32 + 4 * fq;
                    const f32x4* rp = (const f32x4*)(rope + (size_t)pos * 32 + 8 * fq);
                    const f32x4 r0 = rp[0], r1 = rp[1];
#pragma unroll
                    for (int bj = 0; bj < 2; ++bj) {
                        const bool dorope = latent && (pn < 2 || bj == 0);
                        const float sc = (pn < 2) ? 0.125f * 1.44269504f : 1.0f;
                        f32x4 v0 = acc[ai][bj][m][0] * sc, v1 = acc[ai][bj][m][1] * sc;
                        if (dorope) {
                            const f32x4 cs = (f32x4){r0[0], r0[2], r1[0], r1[2]}, sn = (f32x4){r0[1], r0[3], r1[1], r1[3]};
                            const f32x4 o0 = v0 * cs - v1 * sn, o1 = v0 * sn + v1 * cs; v0 = o0; v1 = o1;
                        }
                        u32x2 w0, w1; w0.x = pk2(v0[0], v0[1]); w0.y = pk2(v0[2], v0[3]); w1.x = pk2(v1[0], v1[1]); w1.y = pk2(v1[2], v1[3]);
                        *(u32x2*)(rowp + bj * 128) = w0; *(u32x2*)(rowp + bj * 128 + 16) = w1;
                    }
                    asm volatile("" ::: "memory");
                }
        }
    }
};
__device__ __forceinline__ unsigned pk4_gate(float a, float b, float c, float d) {
    unsigned r = 0; r = __builtin_amdgcn_cvt_pk_u8_f32(a * 256.0f - 0.5f, 0, r); r = __builtin_amdgcn_cvt_pk_u8_f32(b * 256.0f - 0.5f, 1, r);
    r = __builtin_amdgcn_cvt_pk_u8_f32(c * 256.0f - 0.5f, 2, r); r = __builtin_amdgcn_cvt_pk_u8_f32(d * 256.0f - 0.5f, 3, r); return r; }
__device__ __forceinline__ f32x4 gate4(unsigned w) { return (f32x4){(float)(w & 0xffu) + 0.5f, (float)((w >> 8) & 0xffu) + 0.5f, (float)((w >> 16) & 0xffu) + 0.5f, (float)(w >> 24) + 0.5f}; }
struct EpiGates {
    static constexpr int MID = 0;
    unsigned char* gates;
    __device__ __forceinline__ void operator()(EPI_ARGS) const {
        const int row0 = u.p0 * 256 + wr * 64 + fr;
#pragma unroll
        for (int ai = 0; ai < 2; ++ai)
#pragma unroll
            for (int m = 0; m < 4; ++m) { unsigned char* rowp = gates + (unsigned)((row0 + ai * 128 + m * 16) * GW + u.p1 * 256 + wc * 32 + 8 * fq);
#pragma unroll
                for (int bj = 0; bj < 2; ++bj) { const f32x4 v0 = acc[ai][bj][m][0], v1 = acc[ai][bj][m][1];
                    u32x2 w; w.x = pk4_gate(sigmoidf_(v0[0]), sigmoidf_(v0[1]), sigmoidf_(v0[2]), sigmoidf_(v0[3])); w.y = pk4_gate(sigmoidf_(v1[0]), sigmoidf_(v1[1]), sigmoidf_(v1[2]), sigmoidf_(v1[3]));
                    *(u32x2*)(rowp + bj * 128) = w; }
                asm volatile("" ::: "memory"); }
    }
};

struct EpiBranch {
    static constexpr int MID = 8;
    const unsigned char* gates; bf16* mb;
    __device__ __forceinline__ static f32x4 ratio4(unsigned a, unsigned b) {
        const f32x4 x = gate4(a), y = gate4(b);
        return (f32x4){x[0] * __builtin_amdgcn_rcpf(y[0]), x[1] * __builtin_amdgcn_rcpf(y[1]), x[2] * __builtin_amdgcn_rcpf(y[2]), x[3] * __builtin_amdgcn_rcpf(y[3])}; }
    __device__ __forceinline__ void mid(f32x4 (&acc)[2][2][4][2], const Unit& u, int seg, int wr, int wc, int fr, int fq) const {
        const int row0 = u.p0 * 256 + wr * 64 + fr, col0 = u.p1 * 256 + wc * 32 + 8 * fq;
        const unsigned char* gbase = gates + (size_t)row0 * GW + (seg - 1) * 1024 + col0;
        u32x2 ga[2][2], gb[2][2];
#define EB_LD(grp, buf) do { const unsigned char* gp_ = gbase + (size_t)(((grp) >> 2) * 128 + ((grp) & 3) * 16) * GW; _Pragma("unroll") for (int q_ = 0; q_ < 2; ++q_) { \
            ga[buf][q_] = *(const u32x2*)(gp_ + q_ * 128); gb[buf][q_] = *(const u32x2*)(gp_ + 1024 + q_ * 128); } } while (0)
        EB_LD(0, 0);
#pragma unroll
        for (int grp = 0; grp < 8; ++grp) {
            if (grp < 7) EB_LD(grp + 1, (grp + 1) & 1);
            const int ai = grp >> 2, m = grp & 3, buf = grp & 1;
#pragma unroll
            for (int bj = 0; bj < 2; ++bj) { const u32x2 a_ = ga[buf][bj], b_ = gb[buf][bj];
                acc[ai][bj][m][0] = acc[ai][bj][m][0] * ratio4(a_.x, b_.x); acc[ai][bj][m][1] = acc[ai][bj][m][1] * ratio4(a_.y, b_.y); }
            asm volatile("" ::: "memory");
        }
#undef EB_LD
    }
    __device__ __forceinline__ void operator()(EPI_ARGS) const {
        const int row0 = u.p0 * 256 + wr * 64 + fr, col0 = u.p1 * 256 + wc * 32 + 8 * fq;
        const unsigned char* gbase = gates + (size_t)row0 * GW + 2 * 1024 + col0; bf16* bbase = mb + (size_t)row0 * D + col0;
        u32x2 gg[2][2];
#define EB_LD(grp, buf) do { const unsigned char* gp_ = gbase + (size_t)(((grp) >> 2) * 128 + ((grp) & 3) * 16) * GW; _Pragma("unroll") for (int q_ = 0; q_ < 2; ++q_) gg[buf][q_] = *(const u32x2*)(gp_ + q_ * 128); } while (0)
        EB_LD(0, 0);
#pragma unroll
        for (int grp = 0; grp < 8; ++grp) {
            if (grp < 7) EB_LD(grp + 1, (grp + 1) & 1);
            const int ai = grp >> 2, m = grp & 3, buf = grp & 1; bf16* bp = bbase + (size_t)(ai * 128 + m * 16) * D;
#pragma unroll
            for (int bj = 0; bj < 2; ++bj) { const u32x2 gw = gg[buf][bj]; const f32x4 a0 = acc[ai][bj][m][0] * gate4(gw.x) * (1.0f / 256.0f), a1 = acc[ai][bj][m][1] * gate4(gw.y) * (1.0f / 256.0f);
                u32x4 w; w.x = pk2(a0[0], a0[1]); w.y = pk2(a0[2], a0[3]); w.z = pk2(a1[0], a1[1]); w.w = pk2(a1[2], a1[3]);
                *(u32x4*)(bp + bj * 128) = w; }
            asm volatile("" ::: "memory");
        }
#undef EB_LD
    }
};

struct EpiResid {
    static constexpr int MID = 0;
    bf16* x; const float* gvec; float* ssq;
    __device__ __forceinline__ void operator()(EPI_ARGS) const {
        const int pm = u.p0; const int v = pm < (ML / 256) ? (pm >> 4) : 4;
        const int row0 = pm * 256 + wr * 64 + fr, col0 = u.p1 * 256 + wc * 32 + 8 * fq;
        const float* gp = gvec + (size_t)v * (NMOD * D) + col0;
        f32x4 gv[4];
#pragma unroll
        for (int q = 0; q < 4; ++q) gv[q] = *(const f32x4*)(gp + (q >> 1) * 128 + (q & 1) * 4);
        bf16* xbase = x + (size_t)row0 * D + col0;
        u32x4 xv[2][2];
#define ER_LD(grp, buf) do { const bf16* xp_ = xbase + (size_t)(((grp) >> 2) * 128 + ((grp) & 3) * 16) * D; xv[buf][0] = *(const u32x4*)xp_; xv[buf][1] = *(const u32x4*)(xp_ + 128); } while (0)
        ER_LD(0, 0);
#pragma unroll
        for (int grp = 0; grp < 8; ++grp) {
            if (grp < 7) ER_LD(grp + 1, (grp + 1) & 1);
            const int ai = grp >> 2, m = grp & 3, buf = grp & 1; bf16* xp = xbase + (size_t)(ai * 128 + m * 16) * D;
            float s2 = 0.f;
#pragma unroll
            for (int bj = 0; bj < 2; ++bj) { const u32x4 w = xv[buf][bj];
                const f32x4 n0 = (f32x4){bflo(w.x), bfhi(w.x), bflo(w.y), bfhi(w.y)} + gv[bj * 2] * acc[ai][bj][m][0], n1 = (f32x4){bflo(w.z), bfhi(w.z), bflo(w.w), bfhi(w.w)} + gv[bj * 2 + 1] * acc[ai][bj][m][1];
                u32x4 o; o.x = pk2(n0[0], n0[1]); o.y = pk2(n0[2], n0[3]); o.z = pk2(n1[0], n1[1]); o.w = pk2(n1[2], n1[3]); *(u32x4*)(xp + bj * 128) = o;
                s2 += ((n0[0] * n0[0] + n0[1] * n0[1]) + (n0[2] * n0[2] + n0[3] * n0[3])) + ((n1[0] * n1[0] + n1[1] * n1[1]) + (n1[2] * n1[2] + n1[3] * n1[3])); }
            s2 += shx(s2, 16, fq * 16 + fr); s2 += shx(s2, 32, fq * 16 + fr);
            if (fq == 0) ssq[(size_t)(row0 + ai * 128 + m * 16) * 16 + u.p1 * 4 + wc] = s2;
            asm volatile("" ::: "memory");
        }
#undef ER_LD
    }
};

struct EpiGateUp {
    static constexpr int MID = 0;
    unsigned char* hm;
    __device__ __forceinline__ void operator()(EPI_ARGS) const {
        const size_t base = (size_t)(u.p0 + wr * 64 + fr) * FF + u.p1 * 128 + wc * 32 + 8 * fq;
#pragma unroll
        for (int ai = 0; ai < 2; ++ai)
#pragma unroll
            for (int m = 0; m < 4; ++m) { unsigned char* rowp = hm + base + (size_t)(ai * 128 + m * 16) * FF;
                u32x2 w;
#pragma unroll
                for (int n = 0; n < 2; ++n) { const f32x4 g = acc[ai][0][m][n], up = acc[ai][1][m][n]; f32x4 v;
#pragma unroll
                    for (int j = 0; j < 4; ++j) v[j] = g[j] * sigmoidf_(g[j]) * up[j] * FP8_HM_SCALE;
                    const unsigned pk = pk4_fp8(v[0], v[1], v[2], v[3]); if (n == 0) w.x = pk; else w.y = pk; }
                *(u32x2*)rowp = w;
                asm volatile("" ::: "memory"); }
    }
};

struct FourierCtxOrder {
    const char* tc; const char* ftc; int G, c;
    __device__ __forceinline__ bool next(int i, Unit& u) const {
        const int L = i * G + ((c + G - 100) % G); if (L >= 8) return false;
        const int b = L >> 1, pn = L & 1;
        u.a = tc; u.b = ftc + ((size_t)b * 512 + pn * 256) * 512 * 2; u.p0 = ML + b * CTXL; u.p1 = pn * 256; u.p2 = 0; u.p3 = 0; return true;
    }
};
struct FtOrder {
    const char* w; const char* hn; int G, c, ntok;
    __device__ __forceinline__ bool next(int i, Unit& u) const {
        const int L = i * G + c; if (L >= 4 * ntok) return false;
        const int pn = L >> 2, pm = L & 3;
        u.a = w + (size_t)pm * 256 * D * 2; u.b = hn + (size_t)pn * 256 * D * 2;
        const int part = pm >> 1, m0 = (pm & 1) * 256;
        if (pn < 64) { const int b = pn >> 4; u.p0 = b * 512 + m0; u.p1 = part * SEQ + (pn & 15) * 256; u.p2 = 0; }
        else { const int b = pn - 64; u.p0 = b * 512 + m0; u.p1 = part * CTXL; u.p2 = 1; }
        u.p3 = 0; return true;
    }
};
template <int NPN, int P1MUL, int ESZ>
struct MoeOrder {
    const volatile LAS int* tstart; const char* a; const char* w; size_t wexp; int G, c;
    __device__ __forceinline__ bool next(int i, Unit& u) const {
        const int nt = __builtin_amdgcn_readfirstlane(tstart[16]); const int L = i * G + c; if (L >= nt * NPN) return false;
        const int tile = L / NPN, pn = L - tile * NPN;
        int e = 0;
#pragma unroll
        for (int k = 1; k < 16; ++k) e += (tile >= __builtin_amdgcn_readfirstlane(tstart[k])) ? 1 : 0;
        u.a = a + (size_t)tile * 256 * D * ESZ; u.b = w + (size_t)e * wexp + (size_t)pn * 256 * D * ESZ;
        u.p0 = tile * 256; u.p1 = pn * P1MUL; u.p2 = 0; u.p3 = e; return true;
    }
};

struct Frame {
    LAS unsigned char* lds;
    int tid, lane, wave, G, bid;
    float* out;
    GAS unsigned char* ws;
};
#define WSP(T, off) ((T*)(F.ws + (off)))
enum { IN_X = 0, IN_C, IN_CTX, IN_CCTX, IN_WMOD, IN_BMOD, IN_NMIX, IN_NFFN, IN_WIN, IN_SINK, IN_CONVW, IN_CONVB, IN_FW1, IN_FB1, IN_FFREQ, IN_FW2, IN_FB2, IN_FW3, IN_HBIAS,
       IN_WBA, IN_WBF, IN_WBH, IN_WOUT, IN_WROUTER, IN_BROUTER, IN_WEG, IN_WEU, IN_WED, IN_NFINAL };

__device__ __forceinline__ int pslot(int n) { return 16 * ((n >> 2) & 1) + 4 * (n >> 3) + (n & 3); }
__device__ __forceinline__ void transpose_item(const float* W, int lds_, int k0, int n0, bf16* WT, int ldd, int drow0, LAS float* scr, int lane, bool perm = false) {
#pragma unroll
    for (int i = 0; i < 8; ++i) { const int kk = 8 * i + (lane >> 3), c4 = (lane & 7) * 4; const f32x4 v = *(const f32x4*)(W + (size_t)(k0 + kk) * lds_ + n0 + c4);
        LAS float* d = scr + kk * 33 + c4; d[0] = v[0]; d[1] = v[1]; d[2] = v[2]; d[3] = v[3]; }
    LDS_WAIT(); asm volatile("" ::: "memory");
    const int c = lane & 7;
#pragma unroll
    for (int j = 0; j < 4; ++j) { const int n = (lane >> 3) + 8 * j; const LAS float* s = scr + (8 * c) * 33 + n;
        u32x4 o; o.x = pk2(s[0 * 33], s[1 * 33]); o.y = pk2(s[2 * 33], s[3 * 33]); o.z = pk2(s[4 * 33], s[5 * 33]); o.w = pk2(s[6 * 33], s[7 * 33]);
        *(u32x4*)(WT + (size_t)(drow0 + (perm ? pslot(n) : n)) * ldd + k0 + 8 * c) = o; }
    LDS_WAIT(); asm volatile("" ::: "memory");
}

__device__ __forceinline__ void transpose_item8(const float* W, int lds_, int k0, int n0, unsigned char* WT, int ldd, int drow0, LAS float* scr, int lane, float scale) {
#pragma unroll
    for (int i = 0; i < 8; ++i) { const int kk = 8 * i + (lane >> 3), c4 = (lane & 7) * 4; const f32x4 v = *(const f32x4*)(W + (size_t)(k0 + kk) * lds_ + n0 + c4);
        LAS float* d = scr + kk * 33 + c4; d[0] = v[0]; d[1] = v[1]; d[2] = v[2]; d[3] = v[3]; }
    LDS_WAIT(); asm volatile("" ::: "memory");
    const int c = lane & 7;
#pragma unroll
    for (int j = 0; j < 4; ++j) { const int n = (lane >> 3) + 8 * j; const LAS float* s = scr + (8 * c) * 33 + n;
        u32x2 o; o.x = pk4_fp8(s[0 * 33] * scale, s[1 * 33] * scale, s[2 * 33] * scale, s[3 * 33] * scale); o.y = pk4_fp8(s[4 * 33] * scale, s[5 * 33] * scale, s[6 * 33] * scale, s[7 * 33] * scale);
        *(u32x2*)(WT + (size_t)(drow0 + pslot(n)) * ldd + k0 + 8 * c) = o; }
    LDS_WAIT(); asm volatile("" ::: "memory");
}

__device__ __forceinline__ void pro_weights(Frame& F, const float* w_in, const float* wba, const float* wbf, const float* wbh, const float* wout, const float* fw3) {
    LAS float* scr = (LAS float*)(F.lds + F.wave * 16384);
    const int gw = F.bid * NWAVES + F.wave, NGW = F.G * NWAVES;
    constexpr int I1 = 16 * 24, I2 = 16 * 96, I3 = 16 * 48, I4 = 8 * 32, I7 = 16 * 32;
    constexpr int I8 = 64;
    constexpr int NPER = I1 + I2 + I3 + 3 * I4 + I7 + I8;
    for (int it = gw; it < DEPTH * NPER; it += NGW) {
        const int l = it / NPER; int r = it - l * NPER;
        unsigned char* wl = (unsigned char*)(F.ws + WS_W + (size_t)l * WL_SIZE);
        const float* win = w_in + (size_t)l * D * INW;
        if (r < I1) { const int kb = r / 24, nb = r % 24; transpose_item(win, INW, kb * 64, nb * 32, (bf16*)(wl + WL_QKVG), D, nb * 32, scr, F.lane); continue; } r -= I1;
        if (r < I2) { const int kb = r / 96, nb = r % 96; transpose_item8(win, INW, kb * 64, G_OFF + nb * 32, wl + WL_G8, D, nb * 32, scr, F.lane, FP8_W_SCALE); continue; } r -= I2;
        if (r < I3) { const int kb = r / 48, nb = r % 48; transpose_item(win, INW, kb * 64, H_OFF + nb * 32, (bf16*)(wl + WL_H), D, nb * 32, scr, F.lane); continue; } r -= I3;
        if (r < 3 * I4) { const int br = r / I4; r -= br * I4; const int kb = r / 32, nb = r % 32;
            const float* w = (br == 0 ? wba : br == 1 ? wbf : wbh) + (size_t)l * 512 * D;
            transpose_item(w, D, kb * 64, nb * 32, (bf16*)(wl + WL_BA) + br * 512, 1536, nb * 32, scr, F.lane, true); continue; } r -= 3 * I4;
        if (r < I7) { const int kb = r / 32, nb = r % 32; transpose_item(wout + (size_t)l * D * D, D, kb * 64, nb * 32, (bf16*)(wl + WL_OUT), D, nb * 32, scr, F.lane, true); continue; } r -= I7;
        transpose_item(fw3 + (size_t)l * 64 * 2048, 2048, 0, r * 32, WSP(bf16, WS_W3T) + (size_t)l * 2048 * 64, 64, r * 32, scr, F.lane);
    }
}
__device__ __forceinline__ void conv_experts(Frame& F, int l, const float* weg, const float* weu, const float* wed, int lo, int hi, int bid0) {
    LAS float* scr = (LAS float*)(F.lds + F.wave * 16384);
    if (F.bid < bid0) return;
    const int gw = (F.bid - bid0) * NWAVES + F.wave, NGW = (F.G - bid0) * NWAVES;
    constexpr int IE = 16 * 32;
    unsigned char* wbuf = (unsigned char*)(F.ws + WS_WEXP + (size_t)(l & 1) * WE_BUF);
    for (int it = lo + gw; it < hi; it += NGW) {
        const int e = it / (3 * IE); int r = it - e * 3 * IE; const int which = r / IE; r -= which * IE;
        const int kb = r / 32, nb = r % 32, n0 = nb * 32;
        const size_t eoff = ((size_t)l * NEXP + e) * D * FF;
        if (which < 2) {
            const float* w = (which == 0 ? weg : weu) + eoff;
            unsigned char* dst = wbuf + WE_GU + (size_t)e * 2048 * D;
            const int drow = (n0 >> 7) * 256 + which * 128 + (n0 & 127);
            transpose_item8(w, FF, kb * 64, n0, dst, D, drow, scr, F.lane, FP8_W_SCALE);
        } else {
            unsigned char* dst = wbuf + WE_D + (size_t)e * D * FF;
            transpose_item8(wed + eoff, D, kb * 64, n0, dst, FF, n0, scr, F.lane, FP8_W_SCALE);
        }
    }
}
__device__ __forceinline__ void pro_fold(Frame& F, const float* w_in) {
    LAS unsigned char* wl_ = F.lds;
    LAS unsigned char* tl_ = F.lds + 64 * 272;
    const int lane = F.lane, fr = lane & 15, fq = lane >> 4, w = F.wave;
    for (int unit = F.bid; unit < DEPTH * 4 * 16; unit += F.G) {
        const int l = unit >> 6, g = (unit >> 4) & 3, kb = unit & 15;
        __syncthreads();
        for (int i = F.tid; i < 256 * 64; i += NTHR) { const int pm = i >> 6, c2 = (i & 63) * 2, m = pm & 127; const bool sn = pm >= 128;
        const float a0 = (float)((m * c2) & 127) / 64.0f, a1 = (float)((m * (c2 + 1)) & 127) / 64.0f;
        *(LAS unsigned*)(tl_ + pm * 272 + c2 * 2) = pk2(sn ? sinpif(a0) : cospif(a0), sn ? sinpif(a1) : cospif(a1)); }
        const float* win = w_in + (size_t)l * D * INW + (size_t)(kb * 64) * INW + F_OFF + g * 128;
        for (int i = F.tid; i < 64 * 32; i += NTHR) { const int k = i >> 5, c4 = (i & 31) * 4; const f32x4 v = *(const f32x4*)(win + (size_t)k * INW + c4);
            u32x2 o; o.x = pk2(v[0], v[1]); o.y = pk2(v[2], v[3]); *(LAS u32x2*)(wl_ + k * 272 + c4 * 2) = o; }
        __syncthreads();
        bf16* dstb = (bf16*)(F.ws + WS_W + (size_t)l * WL_SIZE + WL_F) + kb * 64;
#pragma unroll
        for (int pt = 0; pt < 2; ++pt) {
            const int pm = 32 * w + 16 * pt + fr, part = pm >> 7, m = pm & 127;
            bf16x8 tf[4];
#pragma unroll
            for (int ks = 0; ks < 4; ++ks) tf[ks] = *(const LAS bf16x8*)(tl_ + pm * 272 + ks * 64 + fq * 16);
#pragma unroll
            for (int kt = 0; kt < 4; ++kt) {
                f32x4 acc = (f32x4){0.f, 0.f, 0.f, 0.f};
#pragma unroll
                for (int ks = 0; ks < 4; ++ks) { const bf16x8 wf = *(const LAS bf16x8*)(wl_ + (kt * 16 + fr) * 272 + ks * 64 + fq * 16); acc = __builtin_amdgcn_mfma_f32_16x16x32_bf16(wf, tf[ks], acc, 0, 0, 0); }
                acc = acc * 0.08838834764831845f;
                u32x2 o; o.x = pk2(acc[0], acc[1]); o.y = pk2(acc[2], acc[3]);
                *(u32x2*)(dstb + (size_t)(part * 512 + g * 128 + m) * D + kt * 16 + 4 * fq) = o;
            }
        }
    }
    __syncthreads();
}
__device__ __forceinline__ void pro_mods(Frame& F, const float* cvec, const float* cctx, const float* wmod, const float* bmod) {
    LAS float* sc = (LAS float*)F.lds;
    LAS float* part = sc + 5 * 1024;
    __syncthreads();
    for (int i = F.tid; i < 5 * 1024; i += NTHR) { const int v = i >> 10, k = i & 1023; const float x = v < 4 ? cvec[v * D + k] : cctx[k]; sc[i] = x * sigmoidf_(x); }
    __syncthreads();
    float* mods = WSP(float, WS_MODS);
    const int krow = F.tid >> 3, col4 = (F.tid & 7) * 4;
    for (int unit = F.bid; unit < DEPTH * 192; unit += F.G) {
        const int l = unit / 192, jc = unit % 192;
        const float* w = wmod + (size_t)l * D * (NMOD * D) + (size_t)krow * (NMOD * D) + jc * 32 + col4;
        f32x4 a[5];
#pragma unroll
        for (int v = 0; v < 5; ++v) a[v] = (f32x4){0.f, 0.f, 0.f, 0.f};
#pragma unroll
        for (int i = 0; i < 16; ++i) { const f32x4 wv = *(const f32x4*)(w + (size_t)(64 * i) * (NMOD * D)); const int kk = krow + 64 * i;
#pragma unroll
            for (int v = 0; v < 5; ++v) a[v] += sc[v * 1024 + kk] * wv; }
#pragma unroll
        for (int v = 0; v < 5; ++v) *(LAS f32x4*)(part + (krow * 5 + v) * 32 + col4) = a[v];
        __syncthreads();
        if (F.tid < 160) { const int v = F.tid >> 5, c2 = F.tid & 31; float s = bmod[(size_t)l * (NMOD * D) + jc * 32 + c2];
#pragma unroll 8
            for (int k = 0; k < 64; ++k) s += part[(k * 5 + v) * 32 + c2];
            mods[((size_t)l * 5 + v) * (NMOD * D) + jc * 32 + c2] = s; }
        __syncthreads();
    }
}
__device__ __forceinline__ void pro_tables(Frame& F) {
    LAS float* lc = (LAS float*)F.lds;
    LAS float* lsn = lc + 4096;
    __syncthreads();
    for (int j = F.tid; j < 4096; j += NTHR) { lc[j] = cospif((float)j / 2048.0f) * 0.015625f; lsn[j] = sinpif((float)j / 2048.0f) * 0.015625f; }
    __syncthreads();
    if (F.bid == 0) {
        float* rope = WSP(float, WS_ROPE);
        for (int i = F.tid; i < 64 * 16; i += NTHR) { const int pos = i >> 4, d = i & 15; const float fr = powf(10000.0f, -(float)d / 16.0f); const float ang = (float)pos * fr; rope[2 * i] = cosf(ang); rope[2 * i + 1] = sinf(ang); }
    }
    bf16* TCp = WSP(bf16, WS_TC);
    for (int k = F.bid; k < 256; k += F.G) {
        if (F.tid < 64) { const int ch = F.tid; const int n0 = (ch * 8) & 255; const bool isS = ch >= 32;
            float v[8];
#pragma unroll
            for (int j = 0; j < 8; ++j) { const int idx = ((k * (n0 + j)) & 255) * 16; v[j] = 4.0f * (isS ? -lsn[idx] : lc[idx]); }
            u32x4 o; o.x = pk2(v[0], v[1]); o.y = pk2(v[2], v[3]); o.z = pk2(v[4], v[5]); o.w = pk2(v[6], v[7]);
            *(u32x4*)(TCp + (size_t)k * 512 + ch * 8) = o; }
    }
    { bf16* T1 = WSP(bf16, WS_FT1); bf16* T1F = WSP(bf16, WS_FT1F); bf16* T2 = WSP(bf16, WS_FT2); bf16* T3 = WSP(bf16, WS_FT3); bf16* T4 = WSP(bf16, WS_FT4);
      for (int i = F.bid * NTHR + F.tid; i < 32768; i += F.G * NTHR) {
          { const int row = i >> 7, col = i & 127, k1 = row & 127, im = row >> 7, kk = col & 63, part = col >> 6;
            const float a = (float)((kk * k1) & 127) / 64.0f; const float c = cospif(a), s = sinpif(a);
            T1[i] = f2bf(im == 0 ? (part == 0 ? c : s) : (part == 0 ? -s : c));
            const float af = (float)((col * k1) & 127) / 64.0f; T1F[i] = f2bf(im == 0 ? cospif(af) : -sinpif(af)); }
          { const int row = i >> 8, col = i & 255, n1 = row & 63, im = row >> 6, k1 = col & 127, part = col >> 7;
            const float a = (float)((k1 * n1) & 127) / 64.0f; const float c = cospif(a), s = sinpif(a);
            T4[((((n1 >> 4) * 2 + im) * 8 + (col >> 5)) * 64 + ((col >> 3) & 3) * 16 + (n1 & 15)) * 8 + (col & 7)] = f2bf(im == 0 ? (part == 0 ? c : -s) : (part == 0 ? s : c)); }
          if (i < 16384) { const int row = i >> 7, col = i & 127, kr = row & 63, im = row >> 6, kc = col & 63, part = col >> 6;
            const float a = (float)((kr * kc) & 63) / 32.0f; const float c = cospif(a), s = sinpif(a);
            T2[i] = f2bf(im == 0 ? (part == 0 ? c : s) : (part == 0 ? -s : c));
            T3[i] = f2bf(im == 0 ? (part == 0 ? c : -s) : (part == 0 ? s : c)); }
      } }
    __syncthreads();
}
__device__ __forceinline__ void pro_hid(Frame& F, const float* fw1, const float* fb1, const float* ffreq, const float* fw2, const float* fb2) {
    const int gw = F.bid * NWAVES + F.wave, NGW = F.G * NWAVES;
    bf16* HID = WSP(bf16, WS_HID);
    for (int it = gw; it < DEPTH * 4352; it += NGW) {
        const int l = it / 4352, p = it - l * 4352;
        const float* w1 = fw1 + (size_t)l * 33 * 64; const float* b1 = fb1 + l * 64; const float* fq = ffreq + l * 64;
        const float* w2 = fw2 + (size_t)l * 64 * 64; const float* b2 = fb2 + l * 64;
        const int n = p < 4096 ? 4096 : 256; const int pos = p < 4096 ? p : p - 4096;
        const float t = (float)pos / (float)(n - 1); const float omega = 6.283185307179586f * (float)pos / (float)n;
        float feat = 0.f;
        if (F.lane == 0) feat = t;
        else if (F.lane <= 16) { const float band = 1e-4f + (float)(F.lane - 1) * ((15.0f - 1e-4f) / 15.0f); feat = cosf(omega * band); }
        else if (F.lane <= 32) { const float band = 1e-4f + (float)(F.lane - 17) * ((15.0f - 1e-4f) / 15.0f); feat = -sinf(omega * band); }
        float a = b1[F.lane];
#pragma unroll
        for (int i = 0; i < 33; ++i) a += rdlane(feat, i) * w1[i * 64 + F.lane];
        const float h1 = sinf(fq[F.lane] * a);
        float a2 = b2[F.lane];
#pragma unroll 16
        for (int i = 0; i < 64; ++i) a2 += rdlane(h1, i) * w2[i * 64 + F.lane];
        HID[(size_t)it * 64 + F.lane] = f2bf(sinf(fq[F.lane] * a2));
    }
}
__device__ __forceinline__ void pro_filt2(Frame& F) {
    const bf16* HID = WSP(bf16, WS_HID); const bf16* W3T = WSP(bf16, WS_W3T); bf16* HFB = WSP(bf16, WS_HFILT);
    const int fr = F.lane & 15, fq = F.lane >> 4;
    constexpr int NITEM = DEPTH * 68 * 16;
    const int per = (NITEM + F.G - 1) / F.G, j0 = F.bid * per, j1 = (j0 + per < NITEM) ? j0 + per : NITEM;
    int cur_unit = -1;
    bf16x8 pf[4][2];
    for (int jb = j0; jb < j1; jb += 8) {
        bf16x8 qa[8], qb[8];
#pragma unroll
        for (int k = 0; k < 8; ++k) { const int j = (jb + k < j1) ? jb + k : j1 - 1; const int unit = j >> 4, ct = j & 15, l = unit / 68;
            const bf16* w3t = W3T + (size_t)l * 2048 * 64 + (size_t)(F.wave * 256 + ct * 16 + fr) * 64;
            qa[k] = *(const bf16x8*)(w3t + fq * 8); qb[k] = *(const bf16x8*)(w3t + 32 + fq * 8); }
#pragma unroll
        for (int k = 0; k < 8; ++k) {
            const int j = jb + k; if (j >= j1) break;
            const int unit = j >> 4, ct = j & 15, l = unit / 68, pb = unit % 68;
            if (unit != cur_unit) { cur_unit = unit; const bf16* hid = HID + ((size_t)l * 4352 + pb * 64) * 64;
#pragma unroll
                for (int it = 0; it < 4; ++it)
#pragma unroll
                    for (int ks = 0; ks < 2; ++ks) pf[it][ks] = *(const bf16x8*)(hid + (size_t)(8 * (fr >> 2) + 4 * (it & 1) + (fr & 3) + 32 * (it >> 1)) * 64 + ks * 32 + fq * 8); }
            bf16* hf = HFB + (size_t)l * 2048 * 4352;
            const bool ctxblk = pb >= 64;
            const int col = F.wave * 256 + ct * 16 + fr;
            const int c = col & 511; const bool bwd = (col & 512) != 0;
            const float delta = 3.0701134573253944f + (15.350567286626972f - 3.0701134573253944f) * (float)c / 511.0f;
#pragma unroll
            for (int h = 0; h < 2; ++h) {
                f32x4 a0 = (f32x4){0.f, 0.f, 0.f, 0.f}, a1 = a0;
                a0 = __builtin_amdgcn_mfma_f32_16x16x32_bf16(pf[2 * h][0], qa[k], a0, 0, 0, 0); a0 = __builtin_amdgcn_mfma_f32_16x16x32_bf16(pf[2 * h][1], qb[k], a0, 0, 0, 0);
                a1 = __builtin_amdgcn_mfma_f32_16x16x32_bf16(pf[2 * h + 1][0], qa[k], a1, 0, 0, 0); a1 = __builtin_amdgcn_mfma_f32_16x16x32_bf16(pf[2 * h + 1][1], qb[k], a1, 0, 0, 0);
                const int pos0 = (ctxblk ? (pb - 64) * 64 : pb * 64) + 32 * h + 8 * fq;
                const float tinv = ctxblk ? (1.0f / 255.0f) : (1.0f / 4095.0f);
                float v[8];
#pragma unroll
                for (int r = 0; r < 4; ++r) { v[r] = a0[r] * __expf(-(float)(pos0 + r) * tinv * delta); v[4 + r] = a1[r] * __expf(-(float)(pos0 + 4 + r) * tinv * delta); }
                u32x4 wv;
                if (!bwd) { wv.x = pk2(v[0], v[1]); wv.y = pk2(v[2], v[3]); wv.z = pk2(v[4], v[5]); wv.w = pk2(v[6], v[7]); *(u32x4*)(hf + (size_t)col * 4352 + (ctxblk ? 4096 : 0) + pos0) = wv; }
                else { wv.x = pk2(v[7], v[6]); wv.y = pk2(v[5], v[4]); wv.z = pk2(v[3], v[2]); wv.w = pk2(v[1], v[0]); *(u32x4*)(hf + (size_t)col * 4352 + (ctxblk ? 4096 + 248 - pos0 : 4088 - pos0)) = wv; }
            }
        }
    }
}
__device__ __forceinline__ void pro_copy_x(Frame& F, const float* xin, const float* ctxin) {
    u32x4* X = WSP(u32x4, WS_X);
    const f32x4* xl = (const f32x4*)xin; const f32x4* xc = (const f32x4*)ctxin;
    const size_t nl = (size_t)ML * D / 8, nc = (size_t)MC * D / 8;
    for (size_t i = (size_t)F.bid * NTHR + F.tid; i < nl + nc; i += (size_t)F.G * NTHR) { const f32x4* s = i < nl ? xl + 2 * i : xc + 2 * (i - nl); const f32x4 a = s[0], b = s[1];
        u32x4 w; w.x = pk2(a[0], a[1]); w.y = pk2(a[2], a[3]); w.z = pk2(b[0], b[1]); w.w = pk2(b[2], b[3]); X[i] = w; }
}

__device__ __forceinline__ void unpk8(const u32x4 w, f32x4& lo, f32x4& hi) { lo = (f32x4){bflo(w.x), bfhi(w.x), bflo(w.y), bfhi(w.y)}; hi = (f32x4){bflo(w.z), bfhi(w.z), bflo(w.w), bfhi(w.w)}; }
__device__ __forceinline__ u32x4 pk8(const f32x4 lo, const f32x4 hi) { u32x4 w; w.x = pk2(lo[0], lo[1]); w.y = pk2(lo[2], lo[3]); w.z = pk2(hi[0], hi[1]); w.w = pk2(hi[2], hi[3]); return w; }
template <bool COMBINE, int MODE>
__device__ __forceinline__ void norm_rows(Frame& F, const float* gamma, const float* modsL  , int sh_idx, const float* modsPrev  ) {
    const int gw = F.bid * NWAVES + F.wave, NGW = F.G * NWAVES;
    bf16* X = WSP(bf16, WS_X); bf16* HN = WSP(bf16, WS_HN);
    const int* slot = WSP(int, WS_SLOT); const f32x4* route = WSP(f32x4, WS_ROUTE); const bf16* Y = WSP(bf16, WS_Y);
    f32x4 gm[2][2];
#pragma unroll
    for (int j = 0; j < 2; ++j)
#pragma unroll
        for (int h = 0; h < 2; ++h) gm[j][h] = *(const f32x4*)(gamma + 8 * F.lane + 512 * j + 4 * h);
    const int nrows = MODE == 1 ? ML : MT;
    auto process = [&](int row, const u32x4 (&xraw)[2], const u32x4 (&y0raw)[2], const u32x4 (&y1raw)[2], float w0, float w1, bool st) {
        const int v = row < ML ? (row >> 12) : 4;
        bf16* xr = X + (size_t)row * D + 8 * F.lane;
        f32x4 x[2][2];
#pragma unroll
        for (int j = 0; j < 2; ++j) unpk8(xraw[j], x[j][0], x[j][1]);
        if (COMBINE) {
            const float* g2 = modsPrev + (size_t)v * (NMOD * D) + 5 * D + 8 * F.lane;
#pragma unroll
            for (int j = 0; j < 2; ++j) { f32x4 a[2], b[2]; unpk8(y0raw[j], a[0], a[1]); unpk8(y1raw[j], b[0], b[1]);
#pragma unroll
                for (int h = 0; h < 2; ++h) { const f32x4 g = *(const f32x4*)(g2 + 512 * j + 4 * h); x[j][h] += g * (w0 * a[h] + w1 * b[h]); }
                if (st) *(u32x4*)(xr + 512 * j) = pk8(x[j][0], x[j][1]); }
        }
        float ss = 0.f;
#pragma unroll
        for (int j = 0; j < 2; ++j)
#pragma unroll
            for (int h = 0; h < 2; ++h) ss += (x[j][h][0] * x[j][h][0] + x[j][h][1] * x[j][h][1]) + (x[j][h][2] * x[j][h][2] + x[j][h][3] * x[j][h][3]);
        const float rstd = 1.0f / sqrtf(wave_sum(ss, F.lane) * (1.0f / D) + EPS);
        if (MODE == 0) {
            const float* sh = modsL + (size_t)v * (NMOD * D) + sh_idx * D + 8 * F.lane; const float* sc = sh + D;
            bf16* hr = HN + (size_t)row * D + 8 * F.lane; unsigned char* h8 = WSP(unsigned char, WS_HN8) + (size_t)row * D + 8 * F.lane;
#pragma unroll
            for (int j = 0; j < 2; ++j) { f32x4 hh[2];
#pragma unroll
                for (int h = 0; h < 2; ++h) { const f32x4 s1 = *(const f32x4*)(sc + 512 * j + 4 * h), s0 = *(const f32x4*)(sh + 512 * j + 4 * h); hh[h] = x[j][h] * rstd * gm[j][h] * (1.0f + s1) + s0; }
                u32x2 q8; q8.x = pk4_fp8(hh[0][0] * FP8_ACT_SCALE, hh[0][1] * FP8_ACT_SCALE, hh[0][2] * FP8_ACT_SCALE, hh[0][3] * FP8_ACT_SCALE); q8.y = pk4_fp8(hh[1][0] * FP8_ACT_SCALE, hh[1][1] * FP8_ACT_SCALE, hh[1][2] * FP8_ACT_SCALE, hh[1][3] * FP8_ACT_SCALE);
                if (st) { *(u32x4*)(hr + 512 * j) = pk8(hh[0], hh[1]); *(u32x2*)(h8 + 512 * j) = q8; } }
        } else {
            float* orow = F.out + (size_t)row * D + 8 * F.lane;
#pragma unroll
            for (int j = 0; j < 2; ++j)
#pragma unroll
                for (int h = 0; h < 2; ++h) if (st) *(f32x4*)(orow + 512 * j + 4 * h) = x[j][h] * rstd * gm[j][h];
        }
    };
    constexpr int NR = 4;
    for (int row0 = gw; row0 < nrows; row0 += NR * NGW) {
        int rws[NR]; bool has[NR];
        u32x4 xr[NR][2], y0[NR][2], y1[NR][2]; float w0[NR], w1[NR];
#pragma unroll
        for (int q = 0; q < NR; ++q) { has[q] = row0 + q * NGW < nrows; rws[q] = has[q] ? row0 + q * NGW : row0; w0[q] = 0.f; w1[q] = 0.f;
#pragma unroll
            for (int j = 0; j < 2; ++j) xr[q][j] = *(const u32x4*)(X + (size_t)rws[q] * D + 8 * F.lane + 512 * j); }
        if (COMBINE) {
            int s0[NR], s1[NR];
#pragma unroll
            for (int q = 0; q < NR; ++q) { s0[q] = slot[2 * rws[q]]; s1[q] = slot[2 * rws[q] + 1]; const f32x4 rt = route[rws[q]]; w0[q] = rt[2]; w1[q] = rt[3]; }
#pragma unroll
            for (int q = 0; q < NR; ++q)
#pragma unroll
                for (int j = 0; j < 2; ++j) { y0[q][j] = *(const u32x4*)(Y + (size_t)s0[q] * D + 8 * F.lane + 512 * j); y1[q][j] = *(const u32x4*)(Y + (size_t)s1[q] * D + 8 * F.lane + 512 * j); }
        } else {
#pragma unroll
            for (int q = 0; q < NR; ++q)
#pragma unroll
                for (int j = 0; j < 2; ++j) { y0[q][j] = xr[q][j]; y1[q][j] = xr[q][j]; }
        }
        asm volatile("" ::: "memory");
#pragma unroll
        for (int q = 0; q < NR; ++q) process(rws[q], xr[q], y0[q], y1[q], w0[q], w1[q], has[q]);
    }
}

__device__ __forceinline__ void norm_route(Frame& F, const float* gamma, const float* modsL, const float* wrouter, const float* brouter, int nrows) {
    constexpr int WBLK = 256 * 16 + 16;
    LAS float* wl = (LAS float*)F.lds;
    LAS float* lgx = wl + 4 * WBLK;
    LAS int* lcnt = (LAS int*)(lgx + 8 * 16 * 17);
    LAS float* mA = (LAS float*)(lcnt + 16);
    LAS float* mB = mA + 5 * 1024;
    __syncthreads();
    for (int i = F.tid; i < 5 * 1024; i += NTHR) { const int v_ = i >> 10, c_ = i & 1023; mA[i] = gamma[c_] * (1.0f + modsL[(size_t)v_ * (NMOD * D) + 4 * D + c_]); mB[i] = modsL[(size_t)v_ * (NMOD * D) + 3 * D + c_]; }
    for (int i = F.tid; i < 16 * 1024; i += NTHR) { const int k = i >> 4; wl[((k >> 3) & 3) * WBLK + ((k >> 5) * 8 + (k & 7)) * 16 + (i & 15)] = wrouter[i]; }
    if (F.tid < 16) lcnt[F.tid] = 0;
    __syncthreads();
    const int gw = F.bid * NWAVES + F.wave, NGW = F.G * NWAVES;
    const bf16* X = WSP(bf16, WS_X); unsigned char* HN8 = WSP(unsigned char, WS_HN8); f32x4* route = WSP(f32x4, WS_ROUTE);
    const int r = F.lane & 15, kk = F.lane >> 4;
    LAS float* lgw = lgx + F.wave * (16 * 17);
    for (int pass = F.bid + F.wave * F.G; pass < nrows / 16; pass += NGW) {
        const int row = pass * 16 + r; const int v = row < ML ? (row >> 12) : 4;
        const u32x4* xp = (const u32x4*)(X + (size_t)row * D) + kk;
        const f32x4 sq = *((const f32x4*)(WSP(float, WS_SSQ) + (size_t)row * 16) + kk);
        float ss = (sq[0] + sq[1]) + (sq[2] + sq[3]);
        ss += shx(ss, 16, F.lane); ss += shx(ss, 32, F.lane);
        const float rstd = 1.0f / sqrtf(ss * (1.0f / D) + EPS);
        const LAS f32x4* ap = (const LAS f32x4*)(mA + v * 1024) + 2 * kk; const LAS f32x4* bp = (const LAS f32x4*)(mB + v * 1024) + 2 * kk;
        u32x2* hp = (u32x2*)(HN8 + (size_t)row * D) + kk;
        const LAS float* wk = wl + kk * WBLK + r;
        f32x4 acc = (f32x4){0.f, 0.f, 0.f, 0.f}, accB = acc;
        u32x4 xraw[32];
#pragma unroll
        for (int s4 = 0; s4 < 32; ++s4) xraw[s4] = xp[4 * s4];
#pragma unroll
        for (int s4 = 0; s4 < 32; ++s4) {
            f32x4 xl, xh; unpk8(xraw[s4], xl, xh);
            const f32x4 hl = xl * rstd * ap[8 * s4] + bp[8 * s4], hh = xh * rstd * ap[8 * s4 + 1] + bp[8 * s4 + 1];
            u32x2 w; w.x = pk4_fp8(hl[0] * FP8_ACT_SCALE, hl[1] * FP8_ACT_SCALE, hl[2] * FP8_ACT_SCALE, hl[3] * FP8_ACT_SCALE); w.y = pk4_fp8(hh[0] * FP8_ACT_SCALE, hh[1] * FP8_ACT_SCALE, hh[2] * FP8_ACT_SCALE, hh[3] * FP8_ACT_SCALE); hp[4 * s4] = w;
#pragma unroll
            for (int j = 0; j < 4; ++j) acc = __builtin_amdgcn_mfma_f32_16x16x4f32(hl[j], wk[(8 * s4 + j) * 16], acc, 0, 0, 0);
#pragma unroll
            for (int j = 0; j < 4; ++j) accB = __builtin_amdgcn_mfma_f32_16x16x4f32(hh[j], wk[(8 * s4 + 4 + j) * 16], accB, 0, 0, 0);
        }
        acc = acc + accB;
#pragma unroll
        for (int q = 0; q < 4; ++q) lgw[(4 * kk + q) * 17 + r] = acc[q];
        LDS_WAIT(); asm volatile("" ::: "memory");
        if (F.lane < 16) {
            float aff[16], bs[16];
#pragma unroll
            for (int e = 0; e < 16; ++e) { aff[e] = 1.0f / (1.0f + expf(-lgw[F.lane * 17 + e])); bs[e] = aff[e] + brouter[e]; }
            int gsel = 0; float gbest = -1e30f;
#pragma unroll
            for (int g = 0; g < 4; ++g) {
                float m1 = bs[4 * g]; int i1 = 0;
#pragma unroll
                for (int k = 1; k < 4; ++k) if (bs[4 * g + k] > m1) { m1 = bs[4 * g + k]; i1 = k; }
                float m2 = -1e30f;
#pragma unroll
                for (int k = 0; k < 4; ++k) if (k != i1 && bs[4 * g + k] > m2) m2 = bs[4 * g + k];
                const float s = m1 + m2; if (s > gbest) { gbest = s; gsel = g; }
            }
            float v4[4], a4[4];
#pragma unroll
            for (int k = 0; k < 4; ++k) { v4[k] = gsel == 0 ? bs[k] : gsel == 1 ? bs[4 + k] : gsel == 2 ? bs[8 + k] : bs[12 + k]; a4[k] = gsel == 0 ? aff[k] : gsel == 1 ? aff[4 + k] : gsel == 2 ? aff[8 + k] : aff[12 + k]; }
            int i1 = 0; float m1 = v4[0];
#pragma unroll
            for (int k = 1; k < 4; ++k) if (v4[k] > m1) { m1 = v4[k]; i1 = k; }
            int i2 = -1; float m2 = -1e30f;
#pragma unroll
            for (int k = 0; k < 4; ++k) if (k != i1 && v4[k] > m2) { m2 = v4[k]; i2 = k; }
            const float wa = i1 == 0 ? a4[0] : i1 == 1 ? a4[1] : i1 == 2 ? a4[2] : a4[3];
            const float wb = i2 == 0 ? a4[0] : i2 == 1 ? a4[1] : i2 == 2 ? a4[2] : a4[3];
            const float inv = 1.0f / (wa + wb);
            const int e0 = gsel * 4 + i1, e1 = gsel * 4 + i2;
            f32x4 rt; rt[0] = __int_as_float(e0); rt[1] = __int_as_float(e1); rt[2] = wa * inv; rt[3] = wb * inv; route[pass * 16 + F.lane] = rt;
            __hip_atomic_fetch_add(&lcnt[e0], 1, __ATOMIC_RELAXED, __HIP_MEMORY_SCOPE_WORKGROUP); __hip_atomic_fetch_add(&lcnt[e1], 1, __ATOMIC_RELAXED, __HIP_MEMORY_SCOPE_WORKGROUP);
        }
        asm volatile("" ::: "memory");
    }
    __syncthreads();
    if (F.tid < 16) WSP(int, WS_WGCNT)[F.bid * 16 + F.tid] = lcnt[F.tid];
}

__device__ __forceinline__ void moe_scatter(Frame& F, int nrows) {
    LAS int* ptot = (LAS int*)F.lds;
    LAS int* poff = ptot + 512;
    LAS int* ctr = poff + 512;
    __syncthreads();
    { const int e = F.tid & 15, seg = F.tid >> 4; const int per = (F.G + 31) / 32; int t = 0, o = 0; const int* wc = WSP(int, WS_WGCNT);
      for (int w = seg * per; w < (seg + 1) * per && w < F.G; ++w) { const int c = wc[w * 16 + e]; t += c; if (w < F.bid) o += c; }
      ptot[seg * 16 + e] = t; poff[seg * 16 + e] = o; }
    __syncthreads();
    if (F.tid == 0) {
        int base = 0; int* ti = WSP(int, WS_TILEINFO);
        for (int e = 0; e < 16; ++e) { int t = 0, o = 0; for (int s = 0; s < 32; ++s) { t += ptot[s * 16 + e]; o += poff[s * 16 + e]; }
            ctr[e] = base + o; if (F.bid == 0) ti[e] = base >> 8; base += (t + 255) & ~255; }
        if (F.bid == 0) ti[16] = base >> 8;
    }
    __syncthreads();
    const int gw = F.bid * NWAVES + F.wave, NGW = F.G * NWAVES;
    const unsigned char* HN8 = WSP(unsigned char, WS_HN8); unsigned char* XS = WSP(unsigned char, WS_XS); int* slot = WSP(int, WS_SLOT); const f32x4* route = WSP(f32x4, WS_ROUTE);
    const int npass = (nrows / 16 - F.bid + F.G - 1) / F.G;
#pragma unroll 2
    for (int idx = F.wave; idx < npass * 16; idx += NWAVES) {
        const int row = (F.bid + (idx >> 4) * F.G) * 16 + (idx & 15);
        int d0 = 0, d1 = 0;
        if (F.lane == 0) { const f32x4 rt = route[row]; const int e0 = __float_as_int(rt[0]), e1 = __float_as_int(rt[1]);
            d0 = __hip_atomic_fetch_add(&ctr[e0], 1, __ATOMIC_RELAXED, __HIP_MEMORY_SCOPE_WORKGROUP); d1 = __hip_atomic_fetch_add(&ctr[e1], 1, __ATOMIC_RELAXED, __HIP_MEMORY_SCOPE_WORKGROUP); slot[2 * row] = d0; slot[2 * row + 1] = d1; }
        d0 = __builtin_amdgcn_readfirstlane(d0); d1 = __builtin_amdgcn_readfirstlane(d1);
        const u32x4 a = *((const u32x4*)(HN8 + (size_t)row * D) + F.lane);
        *((u32x4*)(XS + (size_t)d0 * D) + F.lane) = a; *((u32x4*)(XS + (size_t)d1 * D) + F.lane) = a;
    }
}

__device__ __forceinline__ float sconv(const bf16* ut, int t, int n, float w0, float w1, float w2, float bb) {
    const float um = t > 0 ? bf2f(ut[t - 1]) : 0.f, u0 = bf2f(ut[t]), up = t < n - 1 ? bf2f(ut[t + 1]) : 0.f;
    return um * w0 + u0 * w1 + up * w2 + bb;
}
__device__ __forceinline__ float block_sum(Frame& F, float v, LAS float* red) {
    v = wave_sum(v, F.lane);
    __syncthreads();
    if (F.lane == 0) red[F.wave] = v;
    __syncthreads();
    float s = 0.f;
#pragma unroll
    for (int w = 0; w < NWAVES; ++w) s += red[w];
    return s;
}
__device__ __forceinline__ void sconv4(const bf16* ut, int t0, int n, float w0, float w1, float w2, float bb, float (&o)[4]) {
    const u32x2 w = *(const u32x2*)(ut + t0); const float xm = t0 > 0 ? bf2f(ut[t0 - 1]) : 0.f, xp = t0 + 4 < n ? bf2f(ut[t0 + 4]) : 0.f;
    const float x0 = bflo(w.x), x1 = bfhi(w.x), x2 = bflo(w.y), x3 = bfhi(w.y);
    o[0] = xm * w0 + x0 * w1 + x1 * w2 + bb; o[1] = x0 * w0 + x1 * w1 + x2 * w2 + bb; o[2] = x1 * w0 + x2 * w1 + x3 * w2 + bb; o[3] = x2 * w0 + x3 * w1 + xp * w2 + bb;
}
__device__ __forceinline__ void hyena_ctx_phase(Frame& F, int layer, const float* convw, const float* convb, const float* hbias) {
    LAS float* kk = (LAS float*)(F.lds + F.wave * 4096);
    LAS float* us = kk + 512;
    const bf16* UT = WSP(bf16, WS_UT); bf16* YH = WSP(bf16, WS_YB) + (size_t)64 * MT * 8;
    const bf16* HF = WSP(bf16, WS_HFILT) + (size_t)layer * (4352 * 2048);
    const float* cw = convw + (size_t)layer * 3 * HYW; const float* cb = convb + (size_t)layer * HYW;
    const float* hb = hbias + (size_t)layer * 2 * 512;
    const int l = F.lane;
    __syncthreads();
    if (F.wave < 4)
    for (int unit = F.bid * 4 + F.wave; unit < 1024; unit += F.G * 4) {
        const int c = unit >> 1, bp = unit & 1;
        float vz[2][4], xa[2][4], xb[2][4];
#pragma unroll
        for (int s = 0; s < 2; ++s) { const int row0 = ML + (2 * bp + s) * CTXL;
            sconv4(UT + (size_t)c * MT + row0, 4 * l, CTXL, cw[c], cw[HYW + c], cw[2 * HYW + c], cb[c], vz[s]);
            sconv4(UT + (size_t)(512 + c) * MT + row0, 4 * l, CTXL, cw[512 + c], cw[HYW + 512 + c], cw[2 * HYW + 512 + c], cb[512 + c], xa[s]);
            sconv4(UT + (size_t)(1024 + c) * MT + row0, 4 * l, CTXL, cw[1024 + c], cw[HYW + 1024 + c], cw[2 * HYW + 1024 + c], cb[1024 + c], xb[s]); }
#pragma unroll 1
        for (int ord = 0; ord < 2; ++ord) {
            float asum = 0.f;
#pragma unroll
            for (int j = 0; j < 4; ++j) { const int d = l + 64 * j;
                const float f = bf2f(HF[(size_t)(ord * 1024 + c) * 4352 + 4096 + d]), bw = bf2f(HF[(size_t)(ord * 1024 + 512 + c) * 4352 + 4096 + 255 - d]);
                kk[256 + d] = f; asum += fabsf(f); if (d > 0) { kk[256 - d] = bw; asum += fabsf(bw); } }
            if (l == 0) kk[0] = 0.f;
#pragma unroll
            for (int s = 0; s < 2; ++s) *(LAS f32x4*)(us + s * 256 + 4 * l) = (f32x4){vz[s][0], vz[s][1], vz[s][2], vz[s][3]};
            const float inv = 1.0f / wave_sum(asum, l);
            LDS_WAIT(); asm volatile("" ::: "memory");
            f32x2 acc[4];
#pragma unroll
            for (int i = 0; i < 4; ++i) acc[i] = (f32x2){0.f, 0.f};
            const LAS f32x4* kq = (const LAS f32x4*)kk + 64 + l;
            f32x4 hi = kq[0];
#pragma unroll 4
            for (int sp = 0; sp < CTXL; sp += 4) {
                const f32x4 lo = kq[-(sp >> 2) - 1];
                const f32x4 u0 = *(const LAS f32x4*)(us + sp), u1 = *(const LAS f32x4*)(us + 256 + sp);
                const float win[7] = {lo[1], lo[2], lo[3], hi[0], hi[1], hi[2], hi[3]};
#pragma unroll
                for (int i = 0; i < 4; ++i)
#pragma unroll
                    for (int jj = 0; jj < 4; ++jj) { const float k = win[3 + i - jj]; acc[i] += (f32x2){k, k} * (f32x2){u0[jj], u1[jj]}; }
                hi = lo;
            }
            const float bias = hb[ord * 512 + c];
#pragma unroll
            for (int s = 0; s < 2; ++s)
#pragma unroll
                for (int i = 0; i < 4; ++i) vz[s][i] = (ord == 0 ? xa[s][i] : xb[s][i]) * (acc[i][s] * inv + vz[s][i] * bias);
            asm volatile("" ::: "memory");
        }
#pragma unroll
        for (int s = 0; s < 2; ++s)
#pragma unroll
            for (int i = 0; i < 4; ++i) YH[((size_t)(c >> 3) * MT + (ML + (2 * bp + s) * CTXL + 4 * l + i)) * 8 + (c & 7)] = f2bf(vz[s][i]);
    }
    __syncthreads();
}

constexpr int HY_STR = 272, HY_STRD = 528;
constexpr int HY_IN = 0, HY_XG = 17408, HY_S1 = 34816, HY_S2 = 69632, HY_RED = 104448, HY_XG2 = 104512;
typedef float f32x4_ __attribute__((ext_vector_type(4)));

__device__ __forceinline__ bf16x8 ldfrag_lds(const LAS unsigned char* base, int row, int stride, int kbyte) { return *(const LAS bf16x8*)(base + row * stride + kbyte); }
__device__ __forceinline__ bf16x8 ldfrag_glb(const bf16* tab, int row, int ldk, int kel) { return *(const bf16x8*)(tab + (size_t)row * ldk + kel); }
__device__ __forceinline__ void st4_lds(LAS unsigned char* p, f32x4 v) { u32x2 w; w.x = pk2(v[0], v[1]); w.y = pk2(v[2], v[3]); *(LAS u32x2*)p = w; }
__device__ __forceinline__ f32x4 ld4_lds(const LAS unsigned char* p) { const u32x2 w = *(const LAS u32x2*)p; return (f32x4){bflo(w.x), bfhi(w.x), bflo(w.y), bfhi(w.y)}; }

template <int KS> struct TabFrag { bf16x8 re[KS], im[KS]; };
template <int KS>
__device__ __forceinline__ void load_tab(TabFrag<KS>& t, const bf16* tab, int trow_re, int trow_im, int ldk, int fr, int fq) {
#pragma unroll
    for (int ks = 0; ks < KS; ++ks) { t.re[ks] = ldfrag_glb(tab, trow_re + fr, ldk, ks * 32 + fq * 8); t.im[ks] = ldfrag_glb(tab, trow_im + fr, ldk, ks * 32 + fq * 8); }
}
template <int KS, int NIT, class Post>
__device__ __forceinline__ void stage_tq(const LAS unsigned char* pbase, int pstride, int prow0, const TabFrag<KS>& T, int fr, int fq, const Post& post) {
    const bf16x8 (&qre)[KS] = T.re; const bf16x8 (&qim)[KS] = T.im;
#pragma unroll 2
    for (int it = 0; it < NIT; ++it) {
        f32x4 are = (f32x4){0.f, 0.f, 0.f, 0.f}, aim = are;
#pragma unroll
        for (int ks = 0; ks < KS; ++ks) { const bf16x8 p = ldfrag_lds(pbase, prow0 + it * 16 + fr, pstride, ks * 64 + fq * 16);
            are = __builtin_amdgcn_mfma_f32_16x16x32_bf16(p, qre[ks], are, 0, 0, 0); aim = __builtin_amdgcn_mfma_f32_16x16x32_bf16(p, qim[ks], aim, 0, 0, 0); }
        post(it, are, aim);
    }
}
template <int KS, int NJT, class Post>
__device__ __forceinline__ void stage_tp(const LAS unsigned char* qbase, int qstride, int qrow0, const TabFrag<KS>& T, int fr, int fq, const Post& post) {
    const bf16x8 (&pre)[KS] = T.re; const bf16x8 (&pim)[KS] = T.im;
#pragma unroll 2
    for (int jt = 0; jt < NJT; ++jt) {
        f32x4 are = (f32x4){0.f, 0.f, 0.f, 0.f}, aim = are;
#pragma unroll
        for (int ks = 0; ks < KS; ++ks) { const bf16x8 q = ldfrag_lds(qbase, qrow0 + jt * 16 + fr, qstride, ks * 64 + fq * 16);
            are = __builtin_amdgcn_mfma_f32_16x16x32_bf16(pre[ks], q, are, 0, 0, 0); aim = __builtin_amdgcn_mfma_f32_16x16x32_bf16(pim[ks], q, aim, 0, 0, 0); }
        post(jt, are, aim);
    }
}
__device__ __forceinline__ void twid(int m, float& c, float& s) { const float fr_ = (float)(m & 8191) * (1.0f / 8192.0f); c = __builtin_amdgcn_cosf(fr_); s = __builtin_amdgcn_sinf(fr_); }

template <class PostB>
__device__ __forceinline__ void hy_forward(Frame& F, const TabFrag<4>& tabA, const TabFrag<4>& tabB, const PostB& post_b) {
    LAS unsigned char* lds = F.lds;
    const int w = F.wave, fr = F.lane & 15, fq = F.lane >> 4;
    {
        const int k1 = 16 * w + fr;
        auto post = [&](int it, f32x4 xr, f32x4 xi) {
            f32x4 orr, oi;
#pragma unroll
            for (int r = 0; r < 4; ++r) { const int n2 = it * 16 + 4 * fq + r; float c, s; twid(n2 * k1, c, s); orr[r] = xr[r] * c + xi[r] * s; oi[r] = xi[r] * c - xr[r] * s; }
            LAS unsigned char* o = lds + HY_S1 + k1 * HY_STR + (it * 16 + 4 * fq) * 2;
            st4_lds(o, orr); st4_lds(o + 128, oi);
        };
        stage_tq<4, 4>(lds + HY_IN, HY_STR, 0, tabA, fr, fq, post);
    }
    __syncthreads();
    {
        const int q = w & 3, h = w >> 2;
        stage_tp<4, 4>(lds + HY_S1, HY_STR, 64 * h, tabB, fr, fq, post_b);
    }
}
__device__ __forceinline__ bf16x8 negfrag(bf16x8 v, unsigned sgn) { u32x4 u = __builtin_bit_cast(u32x4, v); u.x ^= sgn; u.y ^= sgn; u.z ^= sgn; u.w ^= sgn; return __builtin_bit_cast(bf16x8, u); }
template <class PostD>
__device__ __forceinline__ void hy_inverse(Frame& F, const TabFrag<4>& tabB, const TabFrag<8>& tabD, const PostD& post_d) {
    LAS unsigned char* lds = F.lds;
    const int w = F.wave, fr = F.lane & 15, fq = F.lane >> 4, q = w & 3, h = w >> 2;
    {
        const int n2 = 16 * q + fr;
        auto post = [&](int it, f32x4 br, f32x4 bi) {
            f32x4 orr, oi; const int k10 = 64 * h + it * 16 + 4 * fq;
#pragma unroll
            for (int r = 0; r < 4; ++r) { float c, s; twid(n2 * (k10 + r), c, s); orr[r] = br[r] * c - bi[r] * s; oi[r] = br[r] * s + bi[r] * c; }
            LAS unsigned char* o = lds + HY_S1 + n2 * HY_STRD + k10 * 2;
            st4_lds(o, orr); st4_lds(o + 256, oi);
        };
        unsigned sgn = 0x80008000u; asm volatile("" : "+v"(sgn));
        TabFrag<4> tabC; tabC.re[0] = tabB.re[0]; tabC.re[1] = tabB.re[1]; tabC.re[2] = negfrag(tabB.re[2], sgn); tabC.re[3] = negfrag(tabB.re[3], sgn);
        tabC.im[0] = negfrag(tabB.im[0], sgn); tabC.im[1] = negfrag(tabB.im[1], sgn); tabC.im[2] = tabB.im[2]; tabC.im[3] = tabB.im[3];
        stage_tq<4, 4>(lds + HY_S2, HY_STR, 64 * h, tabC, fr, fq, post);
    }
    __syncthreads();
    stage_tp<8, 2>(lds + HY_S1, HY_STRD, 32 * h, tabD, fr, fq, post_d);
}

__device__ __forceinline__ void hy_kf_pass(Frame& F, int layer, int bid0) {
    if (F.bid < bid0) return;
    LAS unsigned char* lds = F.lds; LAS float* red = (LAS float*)(lds + HY_RED);
    const bf16* HF = WSP(bf16, WS_HFILT) + (size_t)layer * (4352 * 2048);
    TabFrag<4> tA, tB;
    { const int w_ = F.wave, fr_ = F.lane & 15, fq_ = F.lane >> 4; load_tab<4>(tA, WSP(bf16, WS_FT1F), 16 * w_, 128 + 16 * w_, 128, fr_, fq_); load_tab<4>(tB, WSP(bf16, WS_FT2), 16 * (w_ & 3), 64 + 16 * (w_ & 3), 128, fr_, fq_); }
    unsigned* KF = WSP(unsigned, WS_KF);
    for (int unit = F.bid - bid0; unit < 1024; unit += F.G - bid0) {
        const int c = unit >> 1, o = unit & 1;
        __syncthreads();
        float asum = 0.f;
        {
            const int t = F.tid;
            const u32x4 fw = *(const u32x4*)(HF + (size_t)(o * 1024 + c) * 4352 + 8 * t);
            const bf16* bcol = HF + (size_t)(o * 1024 + 512 + c) * 4352;
            const u32x4 b1 = *(const u32x4*)(bcol + 8 * t);
            const unsigned prev = t > 0 ? (unsigned)bcol[8 * t - 1] : 0u;
            u32x4 bw; bw.x = prev | (b1.x << 16); bw.y = (b1.x >> 16) | (b1.y << 16); bw.z = (b1.y >> 16) | (b1.z << 16); bw.w = (b1.z >> 16) | (b1.w << 16);
            const unsigned fwv[4] = {fw.x, fw.y, fw.z, fw.w}, bwv[4] = {bw.x, bw.y, bw.z, bw.w};
#pragma unroll
            for (int j = 0; j < 4; ++j) {
                const int n = 8 * t + 2 * j;
                asum += fabsf(bflo(fwv[j])) + fabsf(bfhi(fwv[j])) + fabsf(bflo(bwv[j])) + fabsf(bfhi(bwv[j]));
                *(LAS bf16*)(lds + HY_IN + (n & 63) * HY_STR + (n >> 6) * 2) = (bf16)(fwv[j] & 0xffffu); *(LAS bf16*)(lds + HY_IN + ((n + 1) & 63) * HY_STR + (n >> 6) * 2) = (bf16)(fwv[j] >> 16);
                *(LAS bf16*)(lds + HY_IN + (n & 63) * HY_STR + (64 + (n >> 6)) * 2) = (bf16)(bwv[j] & 0xffffu); *(LAS bf16*)(lds + HY_IN + ((n + 1) & 63) * HY_STR + (64 + (n >> 6)) * 2) = (bf16)(bwv[j] >> 16);
            }
        }
        const float inv = 1.0f / (block_sum(F, asum, red) * 8192.0f);
        unsigned* kfo = KF + (size_t)(c * 2 + o) * 8192;
        const int w = F.wave, lane = F.lane;
        auto post_b = [&](int jt, f32x4 zr, f32x4 zi) {
            u32x4 kw; kw.x = pk2(zr[0] * inv, zi[0] * inv); kw.y = pk2(zr[1] * inv, zi[1] * inv); kw.z = pk2(zr[2] * inv, zi[2] * inv); kw.w = pk2(zr[3] * inv, zi[3] * inv);
            *(u32x4*)(kfo + ((w * 4 + jt) * 64 + lane) * 4) = kw;
        };
        hy_forward(F, tA, tB, post_b);
    }
    __syncthreads();
}

__device__ __forceinline__ void hy_load_seq(Frame& F, const bf16* UT, int ch, int c3  , const float* cw, const float* cb, int b0, int dst_off) {
    const float w0 = cw[c3], w1 = cw[HYW + c3], w2 = cw[2 * HYW + c3], bb = cb[c3];
    const int t = F.tid, n1 = t >> 3, n2b = (8 * t) & 63;
#pragma unroll
    for (int s = 0; s < 2; ++s) {
        const bf16* u = UT + (size_t)ch * MT + (size_t)(b0 + s) * SEQ + 8 * t;
        const u32x4 wv = *(const u32x4*)u;
        float x[10];
        { const int ln = F.lane; const unsigned up = (unsigned)__builtin_amdgcn_ds_bpermute(((ln + 63) & 63) << 2, (int)(wv.w >> 16)), dn = (unsigned)__builtin_amdgcn_ds_bpermute(((ln + 1) & 63) << 2, (int)(wv.x & 0xffffu));
          x[0] = bflo(up); x[9] = bflo(dn);
          if (ln == 0) x[0] = t > 0 ? bf2f(u[-1]) : 0.f;
          if (ln == 63) x[9] = t < 511 ? bf2f(u[8]) : 0.f; }
        x[1] = bflo(wv.x); x[2] = bfhi(wv.x); x[3] = bflo(wv.y); x[4] = bfhi(wv.y); x[5] = bflo(wv.z); x[6] = bfhi(wv.z); x[7] = bflo(wv.w); x[8] = bfhi(wv.w);
#pragma unroll
        for (int j = 0; j < 8; ++j) { const float v = x[j] * w0 + x[j + 1] * w1 + x[j + 2] * w2 + bb;
            *(LAS bf16*)(F.lds + dst_off + (n2b + j) * HY_STR + (s * 64 + n1) * 2) = f2bf(v); }
    }
}
__device__ __forceinline__ void hyena_fft_phase(Frame& F, int layer, const float* convw, const float* convb, const float* hbias) {
    LAS unsigned char* lds = F.lds;
    const bf16* UT = WSP(bf16, WS_UT); bf16* YH = WSP(bf16, WS_YB) + (size_t)64 * MT * 8;
    TabFrag<4> tA, tB;
    const bf16* T4 = WSP(bf16, WS_FT4);
    { const int w_ = F.wave, fr_ = F.lane & 15, fq_ = F.lane >> 4, q_ = w_ & 3;
      load_tab<4>(tA, WSP(bf16, WS_FT1), 16 * w_, 128 + 16 * w_, 128, fr_, fq_); load_tab<4>(tB, WSP(bf16, WS_FT2), 16 * q_, 64 + 16 * q_, 128, fr_, fq_);
      }
    TabFrag<8> tabD;
    { const int q_ = F.wave & 3;
#pragma unroll
      for (int ks = 0; ks < 8; ++ks) { tabD.re[ks] = *(const bf16x8*)(T4 + ((size_t)((q_ * 2 + 0) * 8 + ks) * 64 + F.lane) * 8); tabD.im[ks] = *(const bf16x8*)(T4 + ((size_t)((q_ * 2 + 1) * 8 + ks) * 64 + F.lane) * 8); } }
    const unsigned* KF = WSP(unsigned, WS_KF);
    const float* cw = convw + (size_t)layer * 3 * HYW; const float* cb = convb + (size_t)layer * HYW;
    const float* hb = hbias + (size_t)layer * 2 * 512;
    for (int unit = F.bid; unit < 1024; unit += F.G) {
        const int c = unit >> 1, p = unit & 1, b0 = 2 * p;
        __syncthreads();
        hy_load_seq(F, UT, c, c, cw, cb, b0, HY_IN);
        hy_load_seq(F, UT, 512 + c, 512 + c, cw, cb, b0, HY_XG);
        hy_load_seq(F, UT, 1024 + c, 1024 + c, cw, cb, b0, HY_XG2);
        __syncthreads();
#pragma unroll 1
        for (int ord = 0; ord < 2; ++ord) {
            const unsigned* kf = KF + (size_t)(c * 2 + ord) * 8192;
            const int w = F.wave, lane = F.lane, fr = lane & 15, fq = lane >> 4, q = w & 3, h = w >> 2;
            u32x4 kfr[4];
#pragma unroll
            for (int jt = 0; jt < 4; ++jt) kfr[jt] = *(const u32x4*)(kf + ((w * 4 + jt) * 64 + lane) * 4);
            auto post_b = [&](int jt, f32x4 zr, f32x4 zi) {
                f32x4 yr, yi;
                const u32x4 kq = jt == 0 ? kfr[0] : jt == 1 ? kfr[1] : jt == 2 ? kfr[2] : kfr[3];
#pragma unroll
                for (int r = 0; r < 4; ++r) { const float kx = bflo(kq[r]), ky = bfhi(kq[r]); yr[r] = zr[r] * kx - zi[r] * ky; yi[r] = zr[r] * ky + zi[r] * kx; }
                LAS unsigned char* o = lds + HY_S2 + (64 * h + jt * 16 + fr) * HY_STR + (16 * q + 4 * fq) * 2;
                st4_lds(o, yr); st4_lds(o + 128, yi);
            };
            hy_forward(F, tA, tB, post_b);
            __syncthreads();
            const float bias = hb[ord * 512 + c];
            auto post_d = [&](int jt, f32x4 yr, f32x4 yi) {
                const int n2 = 32 * h + jt * 16 + fr, n10 = 16 * q + 4 * fq;
                LAS unsigned char* ip = lds + HY_IN + n2 * HY_STR + n10 * 2; const LAS unsigned char* xp = lds + (ord == 0 ? HY_XG : HY_XG2) + n2 * HY_STR + n10 * 2;
                const f32x4 vr = ld4_lds(ip), vi = ld4_lds(ip + 128), xr = ld4_lds(xp), xi = ld4_lds(xp + 128);
                const f32x4 orr = xr * (yr + vr * bias), oi = xi * (yi + vi * bias);
                if (ord == 0) { st4_lds(ip, orr); st4_lds(ip + 128, oi); }
                else {
#pragma unroll
                    for (int r = 0; r < 4; ++r) { const unsigned idx = ((unsigned)(c >> 3) * MT + b0 * SEQ + 64 * (n10 + r) + n2) * 8u + (c & 7);
                        YH[idx] = f2bf(orr[r]); YH[idx + SEQ * 8] = f2bf(oi[r]); }
                }
            };
            hy_inverse(F, tB, tabD, post_d);
            __syncthreads();
        }
    }
    __syncthreads();
}

constexpr int FO_SEQ = 34816, FO_S1 = 17408, FO_OUT = 69632;
template <int KS, int NJT, class Post>
__device__ __forceinline__ void stage_tp_re(const LAS unsigned char* qbase, int qstride, int qrow0, const bf16x8 (&pre)[KS], int fr, int fq, const Post& post) {
#pragma unroll 1
    for (int jt = 0; jt < NJT; ++jt) {
        f32x4 are = (f32x4){0.f, 0.f, 0.f, 0.f};
#pragma unroll
        for (int ks = 0; ks < KS; ++ks) { const bf16x8 q = ldfrag_lds(qbase, qrow0 + jt * 16 + fr, qstride, ks * 64 + fq * 16);
            are = __builtin_amdgcn_mfma_f32_16x16x32_bf16(pre[ks], q, are, 0, 0, 0); }
        post(jt, are);
    }
}
__device__ __forceinline__ void fourier_fft_phase(Frame& F) {
    LAS unsigned char* lds = F.lds;
    const bf16* FT = WSP(bf16, WS_FT); bf16* YM = WSP(bf16, WS_YM);
    const int w = F.wave, lane = F.lane, fr = lane & 15, fq = lane >> 4, wq = w & 3, s = w >> 2;
    TabFrag<4> tB; load_tab<4>(tB, WSP(bf16, WS_FT2), 16 * wq, 64 + 16 * wq, 128, fr, fq);
    LAS unsigned char* INs = lds + s * FO_SEQ; LAS unsigned char* S1s = INs + FO_S1;
    for (int unit = F.bid; unit < 256; unit += F.G) {
        const int b = unit >> 6, g = (unit >> 4) & 3, mb = unit & 15;
#pragma unroll 1
        for (int pass = 0; pass < 4; ++pass) {
            const int mloc = pass * 2 + s, mrow = g * 128 + mb * 8 + mloc;
            __syncthreads();
            {
                const int tp = F.tid & 255, n1 = tp >> 2, n2b = (16 * tp) & 63;
                const bf16* src = FT + ((size_t)b * 512 + mrow) * 8192 + 16 * tp;
#pragma unroll
                for (int part = 0; part < 2; ++part) {
                    const u32x4 v0 = *(const u32x4*)(src + part * 4096), v1 = *(const u32x4*)(src + part * 4096 + 8);
                    const unsigned sg = part ? 0x8000u : 0u;
                    LAS unsigned char* dst = INs + n2b * HY_STR + (part * 64 + n1) * 2;
                    const unsigned ww[8] = {v0.x, v0.y, v0.z, v0.w, v1.x, v1.y, v1.z, v1.w};
#pragma unroll
                    for (int j = 0; j < 8; ++j) { *(LAS bf16*)(dst + (2 * j) * HY_STR) = (bf16)((ww[j] & 0xffffu) ^ sg); *(LAS bf16*)(dst + (2 * j + 1) * HY_STR) = (bf16)((ww[j] >> 16) ^ sg); }
                }
            }
            __syncthreads();
            {
                const int k1 = 16 * wq + fr;
                auto post = [&](int it, f32x4 xr, f32x4 xi) {
                    f32x4 orr, oi;
#pragma unroll
                    for (int r = 0; r < 4; ++r) { const int n2 = it * 16 + 4 * fq + r; const float fr_ = (float)((n2 * k1) & 4095) * (1.0f / 4096.0f);
                        const float c = __builtin_amdgcn_cosf(fr_), sn = __builtin_amdgcn_sinf(fr_); orr[r] = xr[r] * c + xi[r] * sn; oi[r] = xi[r] * c - xr[r] * sn; }
                    LAS unsigned char* o = S1s + k1 * HY_STR + (it * 16 + 4 * fq) * 2;
                    st4_lds(o, orr); st4_lds(o + 128, oi);
                };
                stage_tq<4, 4>(INs, HY_STR, 0, tB, fr, fq, post);
            }
            __syncthreads();
            {
                auto post = [&](int jt, f32x4 zr) {
                    const int k1 = jt * 16 + fr;
#pragma unroll
                    for (int r = 0; r < 4; ++r) { const int k = k1 + 64 * (16 * wq + 4 * fq + r); *(LAS bf16*)(lds + FO_OUT + k * 16 + mloc * 2) = f2bf(zr[r] * 0.015625f); }
                };
                stage_tp_re<4, 4>(S1s, HY_STR, 0, tB.re, fr, fq, post);
            }
        }
        __syncthreads();
        bf16* dst = WSP(bf16, WS_YB) + ((size_t)(g * 16 + mb) * MT + (size_t)b * SEQ) * 8;
#pragma unroll
        for (int i = 0; i < 8; ++i) { const int k = F.tid + 512 * i; *(u32x4*)(dst + (size_t)k * 8) = *(const LAS u32x4*)(lds + FO_OUT + k * 16); }
    }
    __syncthreads();
}

constexpr int AT_STR = 144;
constexpr int AT_KS = 0, AT_VT = 64 * AT_STR, AT_QS = 2 * 64 * AT_STR;
__device__ __forceinline__ void attn_mfma_phase(Frame& F, const float* sink, int nunits) {
    LAS unsigned char* lds = F.lds;
    const bf16* QKV = WSP(bf16, WS_QKV); bf16* YA = WSP(bf16, WS_YM);
    const int w = F.wave, lane = F.lane, fr = lane & 15, fq = lane >> 4;
    const int g = w & 3, ph = w >> 2;
    const int nextra = nunits - 256;
    const int nlat = F.bid < 256 ? (256 - F.bid + F.G - 1) / F.G : 0;
    for (int kq = 0;; ++kq) {
        int unit;
        if (kq < nlat) unit = F.bid + kq * F.G;
        else { const int e = F.bid + (kq - nlat) * F.G; if (e >= nextra) break; unit = 256 + e; }
        int b, hkv, qb; const bool latent = unit < 256;
        if (latent) { b = unit >> 6; hkv = (unit >> 5) & 1; qb = unit & 31; } else { const int u2 = unit - 256; b = u2 >> 2; hkv = (u2 >> 1) & 1; qb = u2 & 1; }
        const int head = hkv * 4 + g;
        const int pos0 = qb * 128 + ph * 64;
        const int rowq0 = (latent ? b * SEQ : ML + b * CTXL) + pos0;
        __syncthreads();
        { LAS unsigned char* qs = lds + AT_QS + w * (64 * AT_STR) + lane * AT_STR; const u32x4* qp = (const u32x4*)(QKV + (size_t)(rowq0 + lane) * QKVW + head * 64);
#pragma unroll
          for (int i = 0; i < 8; ++i) *(LAS u32x4*)(qs + 16 * i) = qp[i]; }
        f32x4 oacc[4][4];
#pragma unroll
        for (int it = 0; it < 4; ++it)
#pragma unroll
            for (int dt = 0; dt < 4; ++dt) oacc[it][dt] = (f32x4){0.f, 0.f, 0.f, 0.f};
        float mrun[4], lrun[4];
#pragma unroll
        for (int it = 0; it < 4; ++it) { mrun[it] = -1e30f; lrun[it] = 0.f; }
        const int j0 = latent ? (qb * 128 - 128 < 0 ? 0 : qb * 128 - 128) : 0;
        const int j1 = latent ? (qb * 128 + 256 > SEQ ? SEQ : qb * 128 + 256) : 0;
        const int nband = (j1 - j0) >> 6;
        const int nblk = nband + 4;
        const int key = F.tid >> 3, d8 = (F.tid & 7) * 8, key2 = lane, dv = w * 8;
        const int vc = key2 >> 5, va = (key2 >> 4) & 1, vf_ = (key2 >> 2) & 3, vr = key2 & 3;
        u32x4 kreg, vreg;
        { const int krow0 = nband > 0 ? b * SEQ + j0 : ML + b * CTXL;
          kreg = *(const u32x4*)(QKV + (size_t)(krow0 + key) * QKVW + K_OFF + hkv * 64 + d8); vreg = *(const u32x4*)(QKV + (size_t)(krow0 + key2) * QKVW + V_OFF + hkv * 64 + dv); }
#pragma unroll 1
        for (int kb = 0; kb < nblk; ++kb) {
            const bool band = kb < nband;
            const int jbase = band ? j0 + kb * 64 : (kb - nband) * 64;
            __syncthreads();
            {
                *(LAS u32x4*)(lds + AT_KS + key * AT_STR + d8 * 2) = kreg;
                LAS unsigned char* vp = lds + AT_VT + dv * AT_STR + (32 * vc + 8 * vf_ + 4 * va + vr) * 2;
                *(LAS bf16*)(vp + 0 * AT_STR) = (bf16)(vreg.x & 0xffffu); *(LAS bf16*)(vp + 1 * AT_STR) = (bf16)(vreg.x >> 16);
                *(LAS bf16*)(vp + 2 * AT_STR) = (bf16)(vreg.y & 0xffffu); *(LAS bf16*)(vp + 3 * AT_STR) = (bf16)(vreg.y >> 16);
                *(LAS bf16*)(vp + 4 * AT_STR) = (bf16)(vreg.z & 0xffffu); *(LAS bf16*)(vp + 5 * AT_STR) = (bf16)(vreg.z >> 16);
                *(LAS bf16*)(vp + 6 * AT_STR) = (bf16)(vreg.w & 0xffffu); *(LAS bf16*)(vp + 7 * AT_STR) = (bf16)(vreg.w >> 16);
            }
            if (kb + 1 < nblk) { const int kn = kb + 1; const int jb2 = kn < nband ? j0 + kn * 64 : (kn - nband) * 64; const int krow2 = kn < nband ? b * SEQ + jb2 : ML + b * CTXL + jb2;
                kreg = *(const u32x4*)(QKV + (size_t)(krow2 + key) * QKVW + K_OFF + hkv * 64 + d8); vreg = *(const u32x4*)(QKV + (size_t)(krow2 + key2) * QKVW + V_OFF + hkv * 64 + dv); }
            __syncthreads();
            bf16x8 kf[4][2], vf[4][2];
#pragma unroll
            for (int kt = 0; kt < 4; ++kt)
#pragma unroll
                for (int ks = 0; ks < 2; ++ks) kf[kt][ks] = *(const LAS bf16x8*)(lds + AT_KS + (kt * 16 + fr) * AT_STR + ks * 64 + fq * 16);
#pragma unroll
            for (int dt = 0; dt < 4; ++dt)
#pragma unroll
                for (int c = 0; c < 2; ++c) vf[dt][c] = *(const LAS bf16x8*)(lds + AT_VT + (dt * 16 + fr) * AT_STR + c * 64 + fq * 16);
            const bool allvalid = !band || ((pos0 + 63 - jbase <= 128) && (jbase + 63 - pos0 <= 128));
            const bool allmasked = band && ((pos0 - (jbase + 63) > 128) || (jbase - (pos0 + 63) > 128));
            if (!allmasked)
#pragma unroll
            for (int it = 0; it < 4; ++it) {
                asm volatile("" ::: "memory");
                bf16x8 qf0 = *(const LAS bf16x8*)(lds + AT_QS + w * (64 * AT_STR) + (it * 16 + fr) * AT_STR + fq * 16), qf1 = *(const LAS bf16x8*)(lds + AT_QS + w * (64 * AT_STR) + (it * 16 + fr) * AT_STR + 64 + fq * 16);
                f32x4 s[4];
#pragma unroll
                for (int kt = 0; kt < 4; ++kt) { s[kt] = (f32x4){0.f, 0.f, 0.f, 0.f};
                    s[kt] = __builtin_amdgcn_mfma_f32_16x16x32_bf16(kf[kt][0], qf0, s[kt], 0, 0, 0); s[kt] = __builtin_amdgcn_mfma_f32_16x16x32_bf16(kf[kt][1], qf1, s[kt], 0, 0, 0); }
                const int ipos = pos0 + it * 16 + fr;
                if (!allvalid) {
#pragma unroll
                    for (int kt = 0; kt < 4; ++kt)
#pragma unroll
                        for (int r = 0; r < 4; ++r) { const int dd = ipos - (jbase + kt * 16 + 4 * fq + r); s[kt][r] = (dd <= 128 && dd >= -128) ? s[kt][r] : -1e30f; }
                }
                float mt = -1e30f;
#pragma unroll
                for (int kt = 0; kt < 4; ++kt)
#pragma unroll
                    for (int r = 0; r < 4; ++r) mt = fmaxf(mt, s[kt][r]);
                mt = fmaxf(mt, shx(mt, 16, lane)); mt = fmaxf(mt, shx(mt, 32, lane));
                const float mnew = fmaxf(mrun[it], mt);
                const bool grow = __builtin_amdgcn_ballot_w64(mnew > mrun[it]) != 0ull;
                if (grow) { const float corr = __builtin_amdgcn_exp2f(mrun[it] - mnew); lrun[it] *= corr; mrun[it] = mnew;
#pragma unroll
                    for (int dt = 0; dt < 4; ++dt) oacc[it][dt] = oacc[it][dt] * corr; }
                const float msafe = fmaxf(mrun[it], -1e20f);
                float ps = 0.f;
#pragma unroll
                for (int kt = 0; kt < 4; ++kt)
#pragma unroll
                    for (int r = 0; r < 4; ++r) { const float p = __builtin_amdgcn_exp2f(s[kt][r] - msafe); s[kt][r] = p; ps += p; }
                lrun[it] += ps;
                bf16x8 pf[2];
#pragma unroll
                for (int c = 0; c < 2; ++c) { u32x4 pw; pw.x = pk2(s[2 * c][0], s[2 * c][1]); pw.y = pk2(s[2 * c][2], s[2 * c][3]); pw.z = pk2(s[2 * c + 1][0], s[2 * c + 1][1]); pw.w = pk2(s[2 * c + 1][2], s[2 * c + 1][3]);
                    pf[c] = __builtin_bit_cast(bf16x8, pw); }
#pragma unroll
                for (int dt = 0; dt < 4; ++dt)
#pragma unroll
                    for (int c = 0; c < 2; ++c) oacc[it][dt] = __builtin_amdgcn_mfma_f32_16x16x32_bf16(vf[dt][c], pf[c], oacc[it][dt], 0, 0, 0);
            }
        }
        const float sk = sink[head] * 1.44269504f;
#pragma unroll
        for (int it = 0; it < 4; ++it) {
            float lt = lrun[it]; lt += shx(lt, 16, lane); lt += shx(lt, 32, lane);
            const float mf = fmaxf(mrun[it], sk); const float cf = __builtin_amdgcn_exp2f(mrun[it] - mf);
            const float sc = cf / (lt * cf + __builtin_amdgcn_exp2f(sk - mf));
            bf16* op = YA + (size_t)(rowq0 + it * 16 + fr) * YMW + head * 64 + 4 * fq;
#pragma unroll
            for (int dt = 0; dt < 4; ++dt) { const f32x4 v = oacc[it][dt] * sc; u32x2 ww; ww.x = pk2(v[0], v[1]); ww.y = pk2(v[2], v[3]); *(u32x2*)(op + dt * 16) = ww; }
        }
    }
    __syncthreads();
}

constexpr int PH_PER_LAYER = 9, PH_L0 = 2, N_PHASES = 3 + DEPTH * PH_PER_LAYER;
struct Args { const float* in[29]; float* out; unsigned char* ws; int ph_lo, ph_hi; };

__global__ void __launch_bounds__(NTHR, 2) fwd_kernel(Args args) {
    extern __shared__ __attribute__((aligned(16))) unsigned char lds_raw[];
    Frame F;
    F.lds = (LAS unsigned char*)lds_raw;
    F.tid = threadIdx.x; F.lane = F.tid & 63; F.wave = __builtin_amdgcn_readfirstlane(F.tid >> 6);
    F.G = gridDim.x; F.bid = blockIdx.x;
    F.out = args.out; F.ws = (GAS unsigned char*)args.ws;
    volatile LAS unsigned* MISC = (volatile LAS unsigned*)(F.lds + MISC_OFF);
    if (F.tid < 64) MISC[F.tid] = 0u;
    __syncthreads();
    const int lo = args.ph_lo, hi = args.ph_hi;
    int zero = 0;
#ifndef DBL_SEL
#define DBL_SEL -1
#endif
#define RPT(x) for (int rp_ = 0; rp_ < ((DBL_SEL == (x)) ? 2 : 1); ++rp_)
#define PHASE_BEGIN() do { int zv_ = 0; asm volatile("" : "+v"(zv_)); asm volatile("" : "+s"(F.ws), "+s"(F.G), "+s"(F.bid), "+s"(zero), "+s"(F.wave)); F.lane = __builtin_amdgcn_mbcnt_hi(~0u, __builtin_amdgcn_mbcnt_lo(~0u, zv_)); F.tid = F.wave * 64 + F.lane; } while (0)
#define AIN(i) ((const float*)(const GAS float*)args.in[(i) + zero])
    XcdBarrier bar; bar.bar = (unsigned*)(args.ws + WS_CTL) + CW_BAR; bar.x = 0; bar.st = nullptr;
    if (hi - lo > 1) bar = xcd_barrier_post((unsigned*)(args.ws + WS_CTL) + CW_BAR, MISC);
#define IN(k) (lo <= (k) && (k) < hi)
#define SEAM(k) do { if (IN(k) && IN((k) + 1)) xcd_barrier(bar); } while (0)
#define ring (F.lds)

#ifndef EN_MASK
#define EN_MASK 0xFFFFFFFF
#endif
#define EN(b) ((EN_MASK >> (b)) & 1)
    if (EN(0) && IN(0)) {
        RPT(0) {
        PHASE_BEGIN();
        RPT(20) pro_copy_x(F, AIN(IN_X), AIN(IN_CTX));
        RPT(21) { pro_weights(F, AIN(IN_WIN), AIN(IN_WBA), AIN(IN_WBF), AIN(IN_WBH), AIN(IN_WOUT), AIN(IN_FW3));
        __syncthreads(); }
        RPT(22) pro_fold(F, AIN(IN_WIN));
        RPT(23) pro_mods(F, AIN(IN_C), AIN(IN_CCTX), AIN(IN_WMOD), AIN(IN_BMOD));
        RPT(24) pro_tables(F);
        RPT(25) pro_hid(F, AIN(IN_FW1), AIN(IN_FB1), AIN(IN_FFREQ), AIN(IN_FW2), AIN(IN_FB2));
        }
    }
    SEAM(0);
    if (EN(0) && IN(1)) RPT(26) { PHASE_BEGIN(); pro_filt2(F); }
    SEAM(1);

    for (int l = 0; l < DEPTH; ++l) {
        const int pb = PH_L0 + l * PH_PER_LAYER;
        const bool lastl = (l == DEPTH - 1);
        const int nMt = lastl ? ML / 256 : MT / 256;
#define wl ((unsigned char*)(F.ws + WS_W + (size_t)l * WL_SIZE))
#define modsL (WSP(float, WS_MODS) + (size_t)l * 5 * (NMOD * D))
        if (EN(1) && IN(pb + 0)) {
            PHASE_BEGIN();
            if (l == 0) RPT(1) norm_rows<false, 0>(F, AIN(IN_NMIX) + (size_t)l * D, modsL, 0, nullptr);
            else norm_rows<true, 0>(F, AIN(IN_NMIX) + (size_t)l * D, modsL, 0, modsL - 5 * (NMOD * D));
            __syncthreads();
            constexpr int CV_SPLIT = 12288;
            RPT(2) { conv_experts(F, l, AIN(IN_WEG), AIN(IN_WEU), AIN(IN_WED), l == 0 ? 0 : CV_SPLIT, NEXP * 3 * 512, 0);
            __syncthreads(); }
            PHASE_BEGIN();
            if (l == 0) RPT(3) hy_kf_pass(F, l, 0);
        }
        SEAM(pb + 0);
        if (EN(2) && IN(pb + 1)) {
            RPT(4) {
            PHASE_BEGIN();
            { pg8::GridOrder<1> S; S.init(WSP(unsigned char, WS_HN8), wl + WL_G8, (size_t)256 * D, (size_t)256 * D, nMt, GW / 256, F.G, F.bid);
              EpiGates E{WSP(unsigned char, WS_G)};
              pg8::gemm_phase<EpiGates, pg8::GridOrder<1>, true>(F.tid, ring, pg8::Shape{D, D, D, E8_ACT, E8_W, WSP(char, WS_HN8), wl + WL_G8}, S, E); }
            PHASE_BEGIN();
            { pg8::GridOrder<1> S; S.init(WSP(bf16, WS_HN), wl + WL_QKVG, (size_t)256 * D * 2, (size_t)256 * D * 2, nMt, QKVW / 256, F.G, (F.bid + 156) % F.G, lastl ? MC / 256 : 0, ML / 256, 2);
              EpiQKVG E{WSP(bf16, WS_QKV), WSP(float, WS_ROPE)};
              pg8::gemm_phase(F.tid, ring, pg8::Shape{D, D, D, 0, 0, WSP(char, WS_HN), wl + WL_QKVG}, S, E); }
            PHASE_BEGIN();
            { FtOrder S{(const char*)(wl + WL_F), (const char*)WSP(bf16, WS_HN), F.G, (F.bid + 56) % F.G, nMt};
              EpiStore E{WSP(bf16, WS_FT), WSP(bf16, WS_FTC), 8192, 512};
              pg8::gemm_phase<EpiStore, FtOrder, false, true>(F.tid, ring, pg8::Shape{D, D, D, 0, 0, wl + WL_F, WSP(char, WS_HN)}, S, E); }
            PHASE_BEGIN();
            { pg8::GridOrder<256> S; S.init(wl + WL_H, WSP(bf16, WS_HN), (size_t)256 * D * 2, (size_t)256 * D * 2, HYW / 256, nMt, F.G, (F.bid + 208) % F.G);
              EpiStore E{WSP(bf16, WS_UT), WSP(bf16, WS_UT), MT, MT};
              pg8::gemm_phase<EpiStore, pg8::GridOrder<256>, false, true>(F.tid, ring, pg8::Shape{D, D, D, 0, 0, wl + WL_H, WSP(char, WS_HN)}, S, E); }
            }
        }
        SEAM(pb + 1);
        if (IN(pb + 2)) {
            PHASE_BEGIN();
            RPT(5) { PHASE_BEGIN(); if (EN(3)) attn_mfma_phase(F, AIN(IN_SINK) + l * NQH, lastl ? 256 : 272); }
            RPT(6) if (EN(4)) {
            PHASE_BEGIN();
            fourier_fft_phase(F);
            PHASE_BEGIN();
            if (!lastl) { FourierCtxOrder S{(const char*)WSP(bf16, WS_TC), (const char*)WSP(bf16, WS_FTC), F.G, F.bid};
              EpiStoreBlk E{WSP(bf16, WS_YB)};
              pg8::gemm_phase<EpiStoreBlk, FourierCtxOrder, false, true>(F.tid, ring, pg8::Shape{512, 512, 512, 0, 0, WSP(char, WS_TC), WSP(char, WS_FTC)}, S, E); }
            }
            __syncthreads();
            PHASE_BEGIN();
            if (EN(5)) { RPT(7) { PHASE_BEGIN(); hyena_fft_phase(F, l, AIN(IN_CONVW), AIN(IN_CONVB), AIN(IN_HBIAS)); } RPT(8) if (!lastl) { PHASE_BEGIN(); hyena_ctx_phase(F, l, AIN(IN_CONVW), AIN(IN_CONVB), AIN(IN_HBIAS)); } }
        }
        SEAM(pb + 2);
        if (EN(6) && IN(pb + 3)) {
            RPT(9) {
            PHASE_BEGIN();
            pg8::GridOrder<1> S; S.init(WSP(bf16, WS_YM), wl + WL_BA, (size_t)256 * YMW * 2, (size_t)256 * YMW * 2, nMt, D / 256, F.G, F.bid);
            EpiBranch E{WSP(unsigned char, WS_G), WSP(bf16, WS_MB)};
            pg8::gemm_phase<EpiBranch, pg8::GridOrder<1>, false, false, 8>(F.tid, ring, pg8::Shape{YMW, YMW, YMW, 0, 0, WSP(char, WS_YM), wl + WL_BA, (unsigned)(WS_YB - WS_YM)}, S, E);
            }
            if (!lastl) { PHASE_BEGIN(); __syncthreads(); hy_kf_pass(F, l + 1, 16); }
        }
        SEAM(pb + 3);
        if (EN(7) && IN(pb + 4)) {
            PHASE_BEGIN();
            pg8::GridOrder<1> S; S.init(WSP(bf16, WS_MB), wl + WL_OUT, (size_t)256 * D * 2, (size_t)256 * D * 2, nMt, D / 256, F.G, F.bid);
            EpiResid E{WSP(bf16, WS_X), modsL + 2 * D, WSP(float, WS_SSQ)};
            pg8::gemm_phase(F.tid, ring, pg8::Shape{D, D, D, 0, 0, WSP(char, WS_MB), wl + WL_OUT}, S, E);
            if (!lastl) { PHASE_BEGIN(); __syncthreads(); conv_experts(F, l + 1, AIN(IN_WEG), AIN(IN_WEU), AIN(IN_WED), 0, 12288, 16); __syncthreads(); }
        }
        SEAM(pb + 4);
        if (EN(8) && IN(pb + 5)) RPT(10) { PHASE_BEGIN(); norm_route(F, AIN(IN_NFFN) + (size_t)l * D, modsL, AIN(IN_WROUTER), AIN(IN_BROUTER), lastl ? ML : MT); }
        SEAM(pb + 5);
        if (EN(9) && IN(pb + 6)) RPT(11) { PHASE_BEGIN(); moe_scatter(F, lastl ? ML : MT); }
        SEAM(pb + 6);
        if (EN(10) && IN(pb + 7)) RPT(12) {
            PHASE_BEGIN();
            __syncthreads();
            if (F.tid < 17) MISC[16 + F.tid] = (unsigned)WSP(int, WS_TILEINFO)[F.tid];
            __syncthreads();
            MoeOrder<8, 1, 1> S{(const volatile LAS int*)(MISC + 16), (const char*)WSP(char, WS_XS), (const char*)WSP(char, WS_WEXP + WE_GU) + (size_t)(l & 1) * WE_BUF, (size_t)2048 * D, F.G, F.bid};
            EpiGateUp E{WSP(unsigned char, WS_HM)};
            pg8::gemm_phase<EpiGateUp, MoeOrder<8, 1, 1>, true>(F.tid, ring, pg8::Shape{D, D, D, E8_ACT, E8_W, WSP(char, WS_XS), WSP(char, WS_WEXP + WE_GU) + (size_t)(l & 1) * WE_BUF}, S, E);
        }
        SEAM(pb + 7);
        if (EN(11) && IN(pb + 8)) RPT(13) {
            PHASE_BEGIN();
            __syncthreads();
            if (F.tid < 17) MISC[16 + F.tid] = (unsigned)WSP(int, WS_TILEINFO)[F.tid];
            __syncthreads();
            MoeOrder<4, 256, 1> S{(const volatile LAS int*)(MISC + 16), (const char*)WSP(char, WS_HM), (const char*)WSP(char, WS_WEXP + WE_D) + (size_t)(l & 1) * WE_BUF, (size_t)D * FF, F.G, F.bid};
            EpiStore E{WSP(bf16, WS_Y), WSP(bf16, WS_Y), D, D};
            pg8::gemm_phase<EpiStore, MoeOrder<4, 256, 1>, true>(F.tid, ring, pg8::Shape{FF, FF, FF, E8_HM, E8_W, WSP(char, WS_HM), WSP(char, WS_WEXP + WE_D) + (size_t)(l & 1) * WE_BUF}, S, E);
        }
        SEAM(pb + 8);
    }
    if (EN(12) && IN(N_PHASES - 1)) { PHASE_BEGIN(); norm_rows<true, 1>(F, AIN(IN_NFINAL), nullptr, 0, WSP(float, WS_MODS) + (size_t)(DEPTH - 1) * 5 * (NMOD * D)); }
#undef IN
#undef SEAM
}

#ifndef N_LAUNCH_MODE
#define N_LAUNCH_MODE 1
#endif
extern "C" void kernel_launch(void* const* d_in, const int* in_sizes, int n_in, void* d_out, int out_size, void* d_ws, size_t ws_size, hipStream_t stream) {
    static int grid = 0;
    if (grid == 0) {
        if (n_in != 29 || out_size != ML * D || ws_size < WS_END) { fprintf(stderr, "kernel_launch: unexpected shapes (n_in %d out %d ws %zu need %zu)\n", n_in, out_size, ws_size, (size_t)WS_END); grid = -1; return; }
        int dev = 0, cus = 0, per_cu = 0;
        if (hipGetDevice(&dev) != hipSuccess || hipDeviceGetAttribute(&cus, hipDeviceAttributeMultiprocessorCount, dev) != hipSuccess) { grid = -1; return; }
        if (hipFuncSetAttribute((const void*)fwd_kernel, hipFuncAttributeMaxDynamicSharedMemorySize, LDS_BYTES) != hipSuccess) { fprintf(stderr, "kernel_launch: hipFuncSetAttribute failed\n"); grid = -1; return; }
        if (hipOccupancyMaxActiveBlocksPerMultiprocessor(&per_cu, (const void*)fwd_kernel, NTHR, LDS_BYTES) != hipSuccess || per_cu < 1) { fprintf(stderr, "kernel_launch: occupancy query reports %d\n", per_cu); }
        (void)hipGetLastError();
        grid = cus;
        if (grid > 1024) grid = 1024;
    }
    if (grid < 0) return;
    (void)hipMemsetAsync((char*)d_ws + WS_CTL, 0, CTL_ZERO_BYTES, stream);
    Args a{};
    for (int i = 0; i < 29; ++i) a.in[i] = (const float*)d_in[i];
    a.out = (float*)d_out; a.ws = (unsigned char*)d_ws;
#if N_LAUNCH_MODE == 1
    a.ph_lo = 0; a.ph_hi = N_PHASES;
    hipLaunchKernelGGL(fwd_kernel, dim3(grid), dim3(NTHR), LDS_BYTES, stream, a);
#else
    for (int p = 0; p < N_PHASES; ++p) { a.ph_lo = p; a.ph_hi = p + 1; hipLaunchKernelGGL(fwd_kernel, dim3(grid), dim3(NTHR), LDS_BYTES, stream, a); }
#endif
}
```

```cpp
#include <hip/hip_runtime.h>
#include <cstdio>
#include <cstdint>

#define GAS __attribute__((address_space(1)))
#define LAS __attribute__((address_space(3)))
typedef unsigned short bf16;
typedef float f32x4 __attribute__((ext_vector_type(4)));
typedef float f32x2 __attribute__((ext_vector_type(2)));
typedef short bf16x8 __attribute__((ext_vector_type(8)));
typedef unsigned u32x4 __attribute__((ext_vector_type(4)));
typedef unsigned u32x2 __attribute__((ext_vector_type(2)));

constexpr int D = 1024, NB = 4, SEQ = 4096, DEPTH = 4, CTXL = 256, GRIDW = 64;
constexpr int ML = NB * SEQ, MC = NB * CTXL, MT = ML + MC;
constexpr int HD = 64, NQH = 8, NKVH = 2;
constexpr int K_OFF = 512, V_OFF = 640, F_OFF = 768, H_OFF = 1280, G_OFF = 2816, INW = 5888;
constexpr int NEXP = 16, FF = 1024;
constexpr int NMOD = 6;
constexpr int NWAVES = 8, NTHR = 512;
constexpr float EPS = 1e-6f;
constexpr int QKVW = 768;
constexpr int GW = 3072;
constexpr int NQKVG = QKVW + GW;
constexpr int HYW = 1536;
constexpr int XS_ROWS = 39168;

constexpr size_t MiB = 1u << 20;
constexpr size_t WS_CTL = 0, CTL_ZERO_BYTES = 1 * MiB;
constexpr size_t WS_MODS = 1 * MiB;
constexpr size_t WS_ROPE = WS_MODS + 512 * 1024;
constexpr size_t WS_ROUTE = 2 * MiB;
constexpr size_t WS_SLOT = WS_ROUTE + 320 * 1024;
constexpr size_t WS_WGCNT = WS_SLOT + 192 * 1024;
constexpr size_t WS_TILEINFO = WS_WGCNT + 64 * 1024;
constexpr size_t WS_TC = 3 * MiB;
constexpr size_t WS_FT1 = WS_TC + 256 * 1024;
constexpr size_t WS_FT1F = WS_FT1 + 65536, WS_FT2 = WS_FT1F + 65536, WS_FT3 = WS_FT2 + 32768, WS_FT4 = WS_FT3 + 32768;
static_assert(WS_FT4 + 65536 <= 4 * MiB, "tables");
constexpr size_t WS_W = 4 * MiB;
constexpr size_t WL_QKVG = 0;
constexpr size_t WL_G8 = (size_t)QKVW * D * 2;
constexpr size_t WL_F = WL_QKVG + (size_t)NQKVG * D * 2;
constexpr size_t WL_H = WL_F + (size_t)1024 * D * 2;
constexpr size_t WL_BA = WL_H + (size_t)HYW * D * 2;
constexpr size_t WL_BF = WL_BA + (size_t)D * 512 * 2;
constexpr size_t WL_BH = WL_BF + (size_t)D * 512 * 2;
constexpr size_t WL_OUT = WL_BH + (size_t)D * 512 * 2;
constexpr size_t WL_SIZE = WL_OUT + (size_t)D * D * 2;
constexpr size_t WS_WEXP = WS_W + DEPTH * WL_SIZE;
constexpr size_t WE_GU = 0;
constexpr size_t WE_D = (size_t)NEXP * 2048 * D;
constexpr size_t WE_BUF = WE_D + (size_t)NEXP * D * FF;
constexpr size_t WE_SIZE = 2 * WE_BUF;
constexpr size_t WS_TDFT = WS_WEXP + WE_SIZE;
constexpr size_t WS_HID = WS_TDFT;
constexpr size_t WS_W3T = WS_HID + 4 * MiB;
constexpr size_t WS_HFILT = WS_TDFT + (size_t)4096 * 8192 * 2;
constexpr size_t HF_LAYER = (size_t)4352 * 2048 * 4;
constexpr size_t WS_X = WS_HFILT + DEPTH * HF_LAYER;
constexpr size_t WS_HN = WS_X + (size_t)MT * D * 4;
constexpr size_t WS_U = WS_HN + (size_t)MT * D * 2;
constexpr size_t WS_QKV = WS_U;
constexpr size_t WS_G = WS_QKV + (size_t)MT * QKVW * 2;
constexpr size_t WS_FT = WS_G + (size_t)MT * GW * 2;
constexpr size_t WS_FTC = WS_FT + (size_t)NB * 512 * 8192 * 2;
constexpr size_t WS_UT = WS_FTC + (size_t)NB * 512 * 512 * 2;
constexpr size_t WS_YA = WS_UT + (size_t)HYW * MT * 2;
constexpr size_t WS_YM = WS_YA; constexpr int YMW = 1536;
constexpr size_t WS_YF = WS_YA + (size_t)MT * 512 * 2;
constexpr size_t WS_YH = WS_YF + (size_t)MT * 512 * 2;
constexpr size_t WS_MF = WS_YH + (size_t)MT * 512 * 2;
constexpr size_t WS_MB = WS_MF + (size_t)MT * D * 4;
constexpr size_t WS_MIX_END = WS_MB + (size_t)MT * D * 2;
constexpr size_t WS_XS = WS_U;
constexpr size_t WS_HM = WS_XS + (size_t)XS_ROWS * D * 2;
constexpr size_t WS_Y = WS_HM + (size_t)XS_ROWS * D * 2;
constexpr size_t WS_MOE_END = WS_Y + (size_t)XS_ROWS * D * 2;
constexpr size_t WS_KF = WS_MIX_END > WS_MOE_END ? WS_MIX_END : WS_MOE_END;
constexpr size_t WS_SSQ = WS_KF + (size_t)512 * 2 * 8192 * 8;
constexpr size_t WS_HN8 = WS_SSQ + (size_t)MT * 16 * 4;
constexpr size_t WS_YB = WS_HN8 + (size_t)MT * D;
constexpr size_t WS_END = WS_YB + (size_t)128 * MT * 16;

constexpr int CW_BAR = 4096;

constexpr int RING_BYTES = 131072;
constexpr int LDS_BYTES = 147456;
constexpr int MISC_OFF = LDS_BYTES - 256;

__device__ __forceinline__ unsigned pk2(float lo, float hi) { unsigned r; asm("v_cvt_pk_bf16_f32 %0, %1, %2" : "=v"(r) : "v"(lo), "v"(hi)); return r; }
__device__ __forceinline__ float bflo(unsigned u) { return __uint_as_float(u << 16); }
__device__ __forceinline__ float bfhi(unsigned u) { return __uint_as_float(u & 0xffff0000u); }
__device__ __forceinline__ float bf2f(bf16 b) { return __uint_as_float(((unsigned)b) << 16); }
__device__ __forceinline__ bf16 f2bf(float f) { return (bf16)(pk2(f, 0.f) & 0xffffu); }
__device__ __forceinline__ float shx(float v, int o, int lane) {
    const unsigned u = __float_as_uint(v);
    if (o == 16) { const auto r = __builtin_amdgcn_permlane16_swap(u, u, false, false); return __uint_as_float((lane & 16) ? r[0] : r[1]); }
    const auto r = __builtin_amdgcn_permlane32_swap(u, u, false, false); return __uint_as_float((lane & 32) ? r[0] : r[1]);
}
__device__ __forceinline__ float rdlane(float v, int i) { return __int_as_float(__builtin_amdgcn_readlane(__float_as_int(v), i)); }
#define DPP_ADD(v, ctrl) ((v) + __int_as_float(__builtin_amdgcn_update_dpp(0, __float_as_int(v), (ctrl), 0xF, 0xF, false)))
__device__ __forceinline__ float wave_sum(float v, int lane) {
    v = DPP_ADD(v, 0xB1); v = DPP_ADD(v, 0x4E); v = DPP_ADD(v, 0x141); v = DPP_ADD(v, 0x140);
    v += shx(v, 16, lane); v += shx(v, 32, lane);
    return v;
}
#define LDS_WAIT() asm volatile("s_waitcnt lgkmcnt(0)" ::: "memory")
#define VM_WAIT() asm volatile("s_waitcnt vmcnt(0)" ::: "memory")
__device__ __forceinline__ unsigned pk4_fp8(float a, float b, float c, float d) { int w = 0; w = __builtin_amdgcn_cvt_pk_fp8_f32(a, b, w, false); w = __builtin_amdgcn_cvt_pk_fp8_f32(c, d, w, true); return (unsigned)w; }
constexpr float FP8_ACT_SCALE = 8.0f, FP8_HM_SCALE = 8.0f, FP8_W_SCALE = 32.0f;
constexpr int E8_ACT = 0x7B7B7B7B, E8_HM = 0x7B7B7B7B, E8_W = 0x7B7B7B7B;
__device__ __forceinline__ float sigmoidf_(float x) { return __builtin_amdgcn_rcpf(1.0f + __expf(-x)); }

#define XB_TMO      128
#define XB_XCNT(j)  (256  + 64 * (j))
#define XB_XSUB(j)  (1280 + 64 * (j))
#define XB_XGEN(j)  (2304 + 64 * (j))
#define XB_TOP      3328
#define XB_TOPGEN   3392
#define XCD_BAR_WORDS 3456
#define XB_SPIN_CAP (1u << 23)

__device__ __forceinline__ unsigned xb_ld(unsigned* p)              { return __hip_atomic_load(p, __ATOMIC_RELAXED, __HIP_MEMORY_SCOPE_AGENT); }
__device__ __forceinline__ unsigned xb_add(unsigned* p, unsigned v) { return __hip_atomic_fetch_add(p, v, __ATOMIC_RELAXED, __HIP_MEMORY_SCOPE_AGENT); }
__device__ __forceinline__ unsigned xb_xcc_id() { return (unsigned)__builtin_amdgcn_s_getreg((3 << 11) | 20) & 0xFu; }
#define XB_SPIN(cond, bar) do { unsigned _sp = 0; while (cond) { __builtin_amdgcn_s_sleep(1); \
    if ((++_sp & 255u) == 0u) { if (xb_ld(&(bar)[XB_TMO])) break; if (_sp > XB_SPIN_CAP) { atomicAdd(&(bar)[XB_TMO], 1u); break; } } } } while (0)

struct XcdBarrier {
    unsigned* bar; unsigned x;
    volatile LAS unsigned* st;
};

__device__ __forceinline__ XcdBarrier xcd_barrier_post(unsigned* bar, volatile LAS unsigned* st) {
    XcdBarrier b; b.bar = bar; b.x = xb_xcc_id(); b.st = st;
    if (threadIdx.x == 0) (void)xb_add(&bar[XB_XCNT(b.x)], 1u);
    return b;
}
__device__ __forceinline__ void xcd_barrier_complete(unsigned* bar, unsigned x, unsigned& nloc, unsigned& nx) {
    const unsigned G = gridDim.x * gridDim.y * gridDim.z;
    unsigned sum, cnt, mine, sp = 0u;
    for (;;) {
        sum = 0u; cnt = 0u; mine = 0u;
#pragma unroll
        for (unsigned j = 0; j < 16; ++j) { const unsigned c = xb_ld(&bar[XB_XCNT(j)]); sum += c; cnt += (c > 0u) ? 1u : 0u; mine = (j == x) ? c : mine; }
        if (sum == G) break;
        __builtin_amdgcn_s_sleep(1);
        if ((++sp & 255u) == 0u) { if (xb_ld(&bar[XB_TMO])) break; if (sp > XB_SPIN_CAP) { atomicAdd(&bar[XB_TMO], 1u); break; } }
    }
    nloc = mine > 0u ? mine : 1u; nx = cnt > 0u ? cnt : 1u;
}

__device__ __forceinline__ void xcd_barrier(const XcdBarrier& b) {
    asm volatile("s_waitcnt vmcnt(0)" ::: "memory");
    __syncthreads();
    if (threadIdx.x == 0) {
        unsigned* bar = b.bar;
        __builtin_amdgcn_s_waitcnt(0);
        unsigned nloc = b.st[0], nx = b.st[1];
        if (nloc == 0u) { xcd_barrier_complete(bar, b.x, nloc, nx); b.st[0] = nloc; b.st[1] = nx; }
        const unsigned old = xb_add(&bar[XB_XSUB(b.x)], 1u);
        const unsigned gen = old / nloc;
        if (old + 1u == (gen + 1u) * nloc) {
            __builtin_amdgcn_fence(__ATOMIC_RELEASE, "agent");
            asm volatile("s_waitcnt vmcnt(0)" ::: "memory");
            const unsigned og = xb_add(&bar[XB_TOP], 1u);
            const unsigned tg = og / nx;
            if (og + 1u == (tg + 1u) * nx) xb_add(&bar[XB_TOPGEN], 1u);
            else XB_SPIN(xb_ld(&bar[XB_TOPGEN]) == tg, bar);
            __builtin_amdgcn_fence(__ATOMIC_ACQUIRE, "agent");
            xb_add(&bar[XB_XGEN(b.x)], 1u);
            asm volatile("s_waitcnt vmcnt(0)" ::: "memory");
        } else {
            XB_SPIN(xb_ld(&bar[XB_XGEN(b.x)]) == gen, bar);
            __builtin_amdgcn_fence(__ATOMIC_ACQUIRE, "agent");
            asm volatile("s_waitcnt vmcnt(0)" ::: "memory");
        }
    }
    __syncthreads();
}

namespace pg8 {
constexpr int BM = 256, BK = 64, HALF = 128, HTB = HALF * BK * 2, STAGE_BYTES = 8 * HTB;
__host__ __device__ __forceinline__ int lds_byte(int r, int c) { const int st = (r >> 4) * 2 + (c >> 5), rr = r & 15, cc = c & 31, ob = rr * 64 + cc * 2; return st * 1024 + (ob ^ (((ob >> 9) & 1) << 5)); }
__host__ __device__ __forceinline__ void stage_rc(int b, int& R, int& C) { const int st = b / 1024, sb = b % 1024, swz = sb ^ (((sb >> 9) & 1) << 5); R = (st >> 1) * 16 + swz / 64; C = (st & 1) * 32 + (swz % 64) / 2; }

struct Unit { const char* a; const char* b; int p0, p1, p2, p3; };
__device__ __forceinline__ const char* uni_ptr(const char* p) { const unsigned long long v = (unsigned long long)p; const unsigned lo = (unsigned)__builtin_amdgcn_readfirstlane((int)(unsigned)v), hi = (unsigned)__builtin_amdgcn_readfirstlane((int)(unsigned)(v >> 32)); return (const char*)(((unsigned long long)hi << 32) | lo); }
__device__ __forceinline__ void uni_unit(Unit& u) { u.a = uni_ptr(u.a); u.b = uni_ptr(u.b); u.p0 = __builtin_amdgcn_readfirstlane(u.p0); u.p1 = __builtin_amdgcn_readfirstlane(u.p1); u.p2 = __builtin_amdgcn_readfirstlane(u.p2); u.p3 = __builtin_amdgcn_readfirstlane(u.p3); }
struct Shape { int K; int lda, ldb; int sa, sb; const void* abase; const void* bbase; unsigned hbase; };
typedef int v8i __attribute__((ext_vector_type(8)));

struct FragH { bf16x8 hx[2]; }; struct FragW { v8i wx; };
template <bool F8> struct FragSel { typedef FragH type; }; template <> struct FragSel<true> { typedef FragW type; };
__device__ __forceinline__ void ld_h(FragH& f, int k, const LAS unsigned char* p) { f.hx[k] = *(const LAS bf16x8*)p; }
__device__ __forceinline__ void ld_h(FragW&, int, const LAS unsigned char*) {}
__device__ __forceinline__ void ld_w(FragW& f, const LAS unsigned char* p) { const u32x4 lo = *(const LAS u32x4*)p, hi = *(const LAS u32x4*)(p + 16); f.wx = __builtin_bit_cast(v8i, __builtin_shufflevector(lo, hi, 0, 1, 2, 3, 4, 5, 6, 7)); }
__device__ __forceinline__ void ld_w(FragH&, const LAS unsigned char*) {}
__device__ __forceinline__ f32x4 mma_frag(const FragH& b, const FragH& a, f32x4 c, int, int) { c = __builtin_amdgcn_mfma_f32_16x16x32_bf16(b.hx[0], a.hx[0], c, 0, 0, 0); return __builtin_amdgcn_mfma_f32_16x16x32_bf16(b.hx[1], a.hx[1], c, 0, 0, 0); }
__device__ __forceinline__ f32x4 mma_frag(const FragW& b, const FragW& a, f32x4 c, int sB, int sA) { return __builtin_amdgcn_mfma_scale_f32_16x16x128_f8f6f4(b.wx, a.wx, c, 0, 0, 0, sB, 0, sA); }
__host__ __device__ __forceinline__ int perm32(int rho) { const int n = rho >> 4, i = rho & 15; return 8 * (i >> 2) + 4 * n + (i & 3); }
template <class Epi, class Sched, bool FP8 = false, bool PERMB = false, int HSEG = 0>
__device__ __forceinline__ void gemm_phase(const int tid, LAS unsigned char* lds, const Shape g, const Sched& S, const Epi& E) {
    const int wid = __builtin_amdgcn_readfirstlane(tid >> 6), lane = tid & 63, wr = wid >> 2, wc = wid & 3, fr = lane & 15, fq = lane >> 4;
    int K = g.K, lda = g.lda, ldb = g.ldb; asm volatile("" : "+s"(K), "+s"(lda), "+s"(ldb));
    const int nt = FP8 ? K / 128 : K / BK;
    const int sA = g.sa, sB = g.sb;
    unsigned voffA[2], voffBp[2];
#pragma unroll
    for (int i = 0; i < 2; ++i) { int R, C; stage_rc(tid * 16 + i * 8192, R, C);
        voffA[i] = FP8 ? (unsigned)(R * lda + 2 * C) : (unsigned)(R * lda + C) * 2u;
        const int Rb = (R & ~31) + perm32(R & 31); voffBp[i] = PERMB ? (FP8 ? (unsigned)(Rb * ldb + 2 * C) : (unsigned)(Rb * ldb + C) * 2u) : voffA[i]; }
#define voffB voffBp
    unsigned voffH[2] = {0u, 0u};
    if constexpr (HSEG > 0) {
#pragma unroll
        for (int i = 0; i < 2; ++i) { int R, C; stage_rc(tid * 16 + i * 8192, R, C); voffH[i] = (unsigned)(((C >> 3) * MT + R) * 16); }
    }
    constexpr unsigned hkstep = 8u * (unsigned)MT * 16u, hhstep = (unsigned)HALF * 16u;
    const unsigned kstep = (unsigned)(BK * 2);
    const unsigned hstepA = (unsigned)HALF * lda * (FP8 ? 1 : 2), hstepB = (unsigned)HALF * ldb * (FP8 ? 1 : 2);
    const __amdgpu_buffer_rsrc_t rsA = __builtin_amdgcn_make_buffer_rsrc((void*)g.abase, 0, 0xffffffff, 0x00020000), rsB = __builtin_amdgcn_make_buffer_rsrc((void*)g.bbase, 0, 0xffffffff, 0x00020000);
    const unsigned ldsw = (unsigned)wid * 1024u;
    const int aoff = lds_byte(wr * 64 + fr, FP8 ? fq * 16 : fq * 8), boff = lds_byte(wc * 32 + fr, FP8 ? fq * 16 : fq * 8);
#define PG8_SA(b, h) (((b) * 2 + (h)) * HTB)
#define PG8_SB(b, h) ((4 + (b) * 2 + (h)) * HTB)
#define PG8_STAGE(bufoff, rs_soff, voff) do { _Pragma("unroll") for (int _i = 0; _i < 2; ++_i) \
        __builtin_amdgcn_raw_ptr_buffer_load_lds(PG8_RS rs_soff, (LAS unsigned*)(lds + (bufoff) + ldsw + _i * 8192), 16, (voff)[_i], PG8_SO rs_soff, 0, 0); } while (0)
#define PG8_RS(r, s) r
#define PG8_SO(r, s) (int)(s)
#define PG8_LDA(dst, b, h) do { _Pragma("unroll") for (int m = 0; m < 4; ++m) { if constexpr (FP8) ld_w(dst[m], lds + PG8_SA(b, h) + aoff + m * 2048); else { _Pragma("unroll") for (int k = 0; k < 2; ++k) ld_h(dst[m], k, lds + PG8_SA(b, h) + aoff + m * 2048 + k * 1024); } } } while (0)
#define PG8_LDB(dst, b, h) do { _Pragma("unroll") for (int n = 0; n < 2; ++n) { if constexpr (FP8) ld_w(dst[n], lds + PG8_SB(b, h) + boff + n * 2048); else { _Pragma("unroll") for (int k = 0; k < 2; ++k) ld_h(dst[n], k, lds + PG8_SB(b, h) + boff + n * 2048 + k * 1024); } } } while (0)
#define PG8_MMA(ai, bj, At, Bt) do { __builtin_amdgcn_s_setprio(1); _Pragma("unroll") for (int m = 0; m < 4; ++m) _Pragma("unroll") for (int n = 0; n < 2; ++n) { \
        acc[ai][bj][m][n] = mma_frag(Bt[n], At[m], acc[ai][bj][m][n], sB, sA); } \
        __builtin_amdgcn_s_setprio(0); } while (0)
#define PG8_WAIT_V(n) asm volatile("s_waitcnt vmcnt(" #n ")" ::: "memory")
#define PG8_WAIT_L(n) asm volatile("s_waitcnt lgkmcnt(" #n ")" ::: "memory")
#define PG8_BAR __builtin_amdgcn_s_barrier()
#define PG8_SCHED __builtin_amdgcn_sched_barrier(0)
    Unit cur, nxt; int ui = 0;
    if (!S.next(0, cur)) return;
    uni_unit(cur);
    f32x4 acc[2][2][4][2];
#pragma unroll
    for (int a = 0; a < 2; ++a)
#pragma unroll
        for (int b = 0; b < 2; ++b)
#pragma unroll
            for (int m = 0; m < 4; ++m)
#pragma unroll
                for (int n = 0; n < 2; ++n) acc[a][b][m][n] = (f32x4){0.f, 0.f, 0.f, 0.f};
    typename FragSel<FP8>::type At[4], B0[2], B1[2];
    unsigned cA = (unsigned)(cur.a - (const char*)g.abase), cB = (unsigned)(cur.b - (const char*)g.bbase);
    PG8_STAGE(PG8_SB(0, 0), (rsB, cB), voffB); PG8_STAGE(PG8_SB(0, 1), (rsB, cB + hstepB), voffB); PG8_STAGE(PG8_SA(0, 0), (rsA, cA), voffA); PG8_STAGE(PG8_SA(0, 1), (rsA, cA + hstepA), voffA);
    if (wr == 1) PG8_BAR;
    PG8_WAIT_V(2); PG8_BAR;
    PG8_STAGE(PG8_SB(1, 0), (rsB, cB + kstep), voffB); PG8_STAGE(PG8_SA(1, 0), (rsA, cA + kstep), voffA); PG8_STAGE(PG8_SB(1, 1), (rsB, cB + hstepB + kstep), voffB);
    PG8_WAIT_V(6); PG8_BAR;
    for (;;) {
        const bool has_next = __builtin_amdgcn_readfirstlane((int)S.next(ui + 1, nxt)) != 0;
        uni_unit(nxt);
        const unsigned nA = has_next ? (unsigned)(nxt.a - (const char*)g.abase) : cA, nB = has_next ? (unsigned)(nxt.b - (const char*)g.bbase) : cB;
        for (int t = 0; t < nt; t += 2) {
            const bool last = (t == nt - 2);
            if constexpr (Epi::MID > 0) { if (t != 0 && (t % Epi::MID) == 0) E.mid(acc, cur, t / Epi::MID, wr, wc, fr, fq); }
            unsigned a1 = cA + (unsigned)(t + 1) * kstep;
            unsigned a2 = last ? nA : cA + (unsigned)(t + 2) * kstep; const unsigned b2 = last ? nB : cB + (unsigned)(t + 2) * kstep;
            unsigned a3 = a2 + kstep; const unsigned b3 = b2 + kstep;
            unsigned hs1 = hstepA, hs2 = hstepA; unsigned vA1[2] = {voffA[0], voffA[1]}, vA2[2] = {voffA[0], voffA[1]}, vA3[2] = {voffA[0], voffA[1]};
            if constexpr (HSEG > 0) {
                const unsigned hb = g.hbase + (unsigned)cur.p0 * (256u * 16u);
                if (t + 1 >= HSEG) { a1 = hb + (unsigned)(t + 1 - HSEG) * hkstep; hs1 = hhstep; vA1[0] = voffH[0]; vA1[1] = voffH[1]; }
                if (!last && t + 2 >= HSEG) { a2 = hb + (unsigned)(t + 2 - HSEG) * hkstep; hs2 = hhstep; vA2[0] = voffH[0]; vA2[1] = voffH[1]; }
                if (!last && t + 3 >= HSEG) { a3 = hb + (unsigned)(t + 3 - HSEG) * hkstep; vA3[0] = voffH[0]; vA3[1] = voffH[1]; }
            }
            PG8_LDB(B0, 0, 0); PG8_LDB(B1, 0, 1); PG8_SCHED; PG8_LDA(At, 0, 0); PG8_STAGE(PG8_SA(1, 1), (rsA, a1 + hs1), vA1);
            PG8_WAIT_V(8); PG8_WAIT_L(0); PG8_BAR; PG8_MMA(0, 0, At, B0); PG8_MMA(0, 1, At, B1); PG8_BAR; PG8_SCHED;
            PG8_LDA(At, 0, 1); PG8_STAGE(PG8_SB(0, 0), (rsB, b2), voffB); PG8_STAGE(PG8_SB(0, 1), (rsB, b2 + hstepB), voffB); PG8_STAGE(PG8_SA(0, 0), (rsA, a2), vA2);
            PG8_WAIT_V(8); PG8_WAIT_L(0); PG8_BAR; PG8_MMA(1, 0, At, B0); PG8_MMA(1, 1, At, B1); PG8_BAR; PG8_SCHED;
            PG8_LDB(B0, 1, 0); PG8_LDB(B1, 1, 1); PG8_SCHED; PG8_LDA(At, 1, 0); PG8_STAGE(PG8_SA(0, 1), (rsA, a2 + hs2), vA2);
            PG8_WAIT_V(8); PG8_WAIT_L(0); PG8_BAR; PG8_MMA(0, 0, At, B0); PG8_MMA(0, 1, At, B1); PG8_BAR; PG8_SCHED;
            PG8_LDA(At, 1, 1); PG8_STAGE(PG8_SB(1, 0), (rsB, b3), voffB); PG8_STAGE(PG8_SB(1, 1), (rsB, b3 + hstepB), voffB); PG8_STAGE(PG8_SA(1, 0), (rsA, a3), vA3);
            PG8_WAIT_V(8); PG8_WAIT_L(0); PG8_BAR; PG8_MMA(1, 0, At, B0); PG8_MMA(1, 1, At, B1); PG8_BAR; PG8_SCHED;
        }
        if (wr == 0) PG8_BAR;
        E(acc, cur, wr, wc, fr, fq);
        if (!has_next) break;
#pragma unroll
        for (int a = 0; a < 2; ++a)
#pragma unroll
            for (int b = 0; b < 2; ++b)
#pragma unroll
                for (int m = 0; m < 4; ++m)
#pragma unroll
                    for (int n = 0; n < 2; ++n) acc[a][b][m][n] = (f32x4){0.f, 0.f, 0.f, 0.f};
        cur = nxt; cA = nA; cB = nB; ++ui;
        if (wr == 1) PG8_BAR;
    }
    PG8_WAIT_V(0);
    PG8_BAR;
#undef voffB
#undef PG8_SA
#undef PG8_SB
#undef PG8_STAGE
#undef PG8_RS
#undef PG8_SO
#undef PG8_LDA
#undef PG8_LDB
#undef PG8_MMA
#undef PG8_WAIT_V
#undef PG8_WAIT_L
#undef PG8_BAR
#undef PG8_SCHED
}

template <int PMUL = 1>
struct GridOrder {
    const char* aBase; const char* bBase; size_t aTile, bTile; int nM, nN, nwg, G, c, nextra, epm, epn;
    __device__ void init(const void* a, const void* b, size_t at, size_t bt, int nM_, int nN_, int G_, int c_, int nextra_ = 0, int epm_ = 0, int epn_ = 0) { aBase = (const char*)a; bBase = (const char*)b; aTile = at; bTile = bt; nM = nM_; nN = nN_; nwg = nM * nN; G = G_; c = c_; nextra = nextra_; epm = epm_; epn = epn_; }
    __device__ __forceinline__ bool next(int i, Unit& u) const {
        const long L = (long)i * G + c; if (L >= nwg + nextra) return false;
        if (L >= nwg) { const int pm = epm + (int)(L - nwg), pn = epn; u.a = aBase + (size_t)pm * aTile; u.b = bBase + (size_t)pn * bTile; u.p0 = pm * PMUL; u.p1 = pn * PMUL; u.p2 = 0; u.p3 = 0; return true; }
        int wgid = (int)L; { const int q = nwg / 8, r = nwg % 8, xcd = wgid % 8, off = wgid / 8; wgid = (xcd < r ? xcd * (q + 1) : r * (q + 1) + (xcd - r) * q) + off; }
        const int nig = 8 * nN, gid = wgid / nig, fm = gid * 8, gsz = (nM - fm) < 8 ? (nM - fm) : 8;
        const int pm = fm + ((wgid % nig) % gsz), pn = (wgid % nig) / gsz;
        u.a = aBase + (size_t)pm * aTile; u.b = bBase + (size_t)pn * bTile; u.p0 = pm * PMUL; u.p1 = pn * PMUL; u.p2 = 0; u.p3 = 0; return true;
    }
};
}

using pg8::Unit;
#define EPI_ARGS const f32x4 (&acc)[2][2][4][2], const Unit& u, int wr, int wc, int fr, int fq

struct EpiStore {
    static constexpr int MID = 0;
    bf16* dst0; bf16* dst1; int ld0, ld1;
    __device__ __forceinline__ void operator()(EPI_ARGS) const {
        bf16* dst = u.p2 ? dst1 : dst0; const int ld = u.p2 ? ld1 : ld0;
        const size_t base = (size_t)(u.p0 + wr * 64 + fr) * ld + u.p1 + wc * 32 + 8 * fq;
#pragma unroll
        for (int ai = 0; ai < 2; ++ai)
#pragma unroll
            for (int m = 0; m < 4; ++m) { bf16* rowp = dst + base + (size_t)(ai * 128 + m * 16) * ld;
#pragma unroll
                for (int bj = 0; bj < 2; ++bj) { const f32x4 v0 = acc[ai][bj][m][0], v1 = acc[ai][bj][m][1];
                    u32x4 w; w.x = pk2(v0[0], v0[1]); w.y = pk2(v0[2], v0[3]); w.z = pk2(v1[0], v1[1]); w.w = pk2(v1[2], v1[3]); *(u32x4*)(rowp + bj * 128) = w; }
                asm volatile("" ::: "memory"); }
    }
};

struct EpiStoreBlk {
    static constexpr int MID = 0;
    bf16* dst;
    __device__ __forceinline__ void operator()(EPI_ARGS) const {
        const size_t base = ((size_t)((u.p1 + wc * 32 + 8 * fq) >> 3) * MT + (u.p0 + wr * 64 + fr)) * 8;
#pragma unroll
        for (int ai = 0; ai < 2; ++ai)
#pragma unroll
            for (int m = 0; m < 4; ++m) { bf16* rowp = dst + base + (size_t)(ai * 128 + m * 16) * 8;
#pragma unroll
                for (int bj = 0; bj < 2; ++bj) { const f32x4 v0 = acc[ai][bj][m][0], v1 = acc[ai][bj][m][1];
                    u32x4 w; w.x = pk2(v0[0], v0[1]); w.y = pk2(v0[2], v0[3]); w.z = pk2(v1[0], v1[1]); w.w = pk2(v1[2], v1[3]); *(u32x4*)(rowp + (size_t)bj * 16 * MT * 8) = w; }
                asm volatile("" ::: "memory"); }
    }
};
struct EpiQKVG {
    static constexpr int MID = 0;
    bf16* qkv; const float* rope;
    __device__ __forceinline__ void operator()(EPI_ARGS) const {
        const int pm = u.p0, pn = u.p1;
        const int row0 = pm * 256 + wr * 64 + fr;
        {
            const bool latent = pm < (ML / 256);
#pragma unroll
            for (int ai = 0; ai < 2; ++ai)
#pragma unroll
                for (int m = 0; m < 4; ++m) {
                    const int row = row0 + ai * 128 + m * 16; const int t = row & (SEQ - 1);
                    const int pos = (wc & 1) ? (t & 63) : (t >> 6);
                    bf16* rowp = qkv + (size_t)row * QKVW + pn * 256 + wc * 32 + 4 * fq;
                    const f32x4* rp = (const f32x4*)(rope + (size_t)pos * 32 + 8 * fq);
                    const f32x4 r0 = rp[0], r1 = rp[1];
#pragma unroll
                    for (int bj = 0; bj < 2; ++bj) {
                        const bool dorope = latent && (pn < 2 || bj == 0);
                        const float sc = (pn < 2) ? 0.125f * 1.44269504f : 1.0f;
                        f32x4 v0 = acc[ai][bj][m][0] * sc, v1 = acc[ai][bj][m][1] * sc;
                        if (dorope) {
                            const f32x4 cs = (f32x4){r0[0], r0[2], r1[0], r1[2]}, sn = (f32x4){r0[1], r0[3], r1[1], r1[3]};
                            const f32x4 o0 = v0 * cs - v1 * sn, o1 = v0 * sn + v1 * cs; v0 = o0; v1 = o1;
                        }
                        u32x2 w0, w1; w0.x = pk2(v0[0], v0[1]); w0.y = pk2(v0[2], v0[3]); w1.x = pk2(v1[0], v1[1]); w1.y = pk2(v1[2], v1[3]);
                        *(u32x2*)(rowp + bj * 128) = w0; *(u32x2*)(rowp + bj * 128 + 16) = w1;
                    }
                    asm volatile("" ::: "memory");
                }
        }
    }
};
__device__ __forceinline__ unsigned pk4_gate(float a, float b, float c, float d) {
    unsigned r = 0; r = __builtin_amdgcn_cvt_pk_u8_f32(a * 256.0f - 0.5f, 0, r); r = __builtin_amdgcn_cvt_pk_u8_f32(b * 256.0f - 0.5f, 1, r);
    r = __builtin_amdgcn_cvt_pk_u8_f32(c * 256.0f - 0.5f, 2, r); r = __builtin_amdgcn_cvt_pk_u8_f32(d * 256.0f - 0.5f, 3, r); return r; }
__device__ __forceinline__ f32x4 gate4(unsigned w) { return (f32x4){(float)(w & 0xffu) + 0.5f, (float)((w >> 8) & 0xffu) + 0.5f, (float)((w >> 16) & 0xffu) + 0.5f, (float)(w >> 24) + 0.5f}; }
struct EpiGates {
    static constexpr int MID = 0;
    unsigned char* gates;
    __device__ __forceinline__ void operator()(EPI_ARGS) const {
        const int row0 = u.p0 * 256 + wr * 64 + fr;
#pragma unroll
        for (int ai = 0; ai < 2; ++ai)
#pragma unroll
            for (int m = 0; m < 4; ++m) { unsigned char* rowp = gates + (unsigned)((row0 + ai * 128 + m * 16) * GW + u.p1 * 256 + wc * 32 + 8 * fq);
#pragma unroll
                for (int bj = 0; bj < 2; ++bj) { const f32x4 v0 = acc[ai][bj][m][0], v1 = acc[ai][bj][m][1];
                    u32x2 w; w.x = pk4_gate(sigmoidf_(v0[0]), sigmoidf_(v0[1]), sigmoidf_(v0[2]), sigmoidf_(v0[3])); w.y = pk4_gate(sigmoidf_(v1[0]), sigmoidf_(v1[1]), sigmoidf_(v1[2]), sigmoidf_(v1[3]));
                    *(u32x2*)(rowp + bj * 128) = w; }
                asm volatile("" ::: "memory"); }
    }
};

struct EpiBranch {
    static constexpr int MID = 8;
    const unsigned char* gates; bf16* mb;
    __device__ __forceinline__ static f32x4 ratio4(unsigned a, unsigned b) {
        const f32x4 x = gate4(a), y = gate4(b);
        return (f32x4){x[0] * __builtin_amdgcn_rcpf(y[0]), x[1] * __builtin_amdgcn_rcpf(y[1]), x[2] * __builtin_amdgcn_rcpf(y[2]), x[3] * __builtin_amdgcn_rcpf(y[3])}; }
    __device__ __forceinline__ void mid(f32x4 (&acc)[2][2][4][2], const Unit& u, int seg, int wr, int wc, int fr, int fq) const {
        const int row0 = u.p0 * 256 + wr * 64 + fr, col0 = u.p1 * 256 + wc * 32 + 8 * fq;
        const unsigned char* gbase = gates + (size_t)row0 * GW + (seg - 1) * 1024 + col0;
        u32x2 ga[2][2], gb[2][2];
#define EB_LD(grp, buf) do { const unsigned char* gp_ = gbase + (size_t)(((grp) >> 2) * 128 + ((grp) & 3) * 16) * GW; _Pragma("unroll") for (int q_ = 0; q_ < 2; ++q_) { \
            ga[buf][q_] = *(const u32x2*)(gp_ + q_ * 128); gb[buf][q_] = *(const u32x2*)(gp_ + 1024 + q_ * 128); } } while (0)
        EB_LD(0, 0);
#pragma unroll
        for (int grp = 0; grp < 8; ++grp) {
            if (grp < 7) EB_LD(grp + 1, (grp + 1) & 1);
            const int ai = grp >> 2, m = grp & 3, buf = grp & 1;
#pragma unroll
            for (int bj = 0; bj < 2; ++bj) { const u32x2 a_ = ga[buf][bj], b_ = gb[buf][bj];
                acc[ai][bj][m][0] = acc[ai][bj][m][0] * ratio4(a_.x, b_.x); acc[ai][bj][m][1] = acc[ai][bj][m][1] * ratio4(a_.y, b_.y); }
            asm volatile("" ::: "memory");
        }
#undef EB_LD
    }
    __device__ __forceinline__ void operator()(EPI_ARGS) const {
        const int row0 = u.p0 * 256 + wr * 64 + fr, col0 = u.p1 * 256 + wc * 32 + 8 * fq;
        const unsigned char* gbase = gates + (size_t)row0 * GW + 2 * 1024 + col0; bf16* bbase = mb + (size_t)row0 * D + col0;
        u32x2 gg[2][2];
#define EB_LD(grp, buf) do { const unsigned char* gp_ = gbase + (size_t)(((grp) >> 2) * 128 + ((grp) & 3) * 16) * GW; _Pragma("unroll") for (int q_ = 0; q_ < 2; ++q_) gg[buf][q_] = *(const u32x2*)(gp_ + q_ * 128); } while (0)
        EB_LD(0, 0);
#pragma unroll
        for (int grp = 0; grp < 8; ++grp) {
            if (grp < 7) EB_LD(grp + 1, (grp + 1) & 1);
            const int ai = grp >> 2, m = grp & 3, buf = grp & 1; bf16* bp = bbase + (size_t)(ai * 128 + m * 16) * D;
#pragma unroll
            for (int bj = 0; bj < 2; ++bj) { const u32x2 gw = gg[buf][bj]; const f32x4 a0 = acc[ai][bj][m][0] * gate4(gw.x) * (1.0f / 256.0f), a1 = acc[ai][bj][m][1] * gate4(gw.y) * (1.0f / 256.0f);
                u32x4 w; w.x = pk2(a0[0], a0[1]); w.y = pk2(a0[2], a0[3]); w.z = pk2(a1[0], a1[1]); w.w = pk2(a1[2], a1[3]);
                *(u32x4*)(bp + bj * 128) = w; }
            asm volatile("" ::: "memory");
        }
#undef EB_LD
    }
};

struct EpiResid {
    static constexpr int MID = 0;
    bf16* x; const float* gvec; float* ssq;
    __device__ __forceinline__ void operator()(EPI_ARGS) const {
        const int pm = u.p0; const int v = pm < (ML / 256) ? (pm >> 4) : 4;
        const int row0 = pm * 256 + wr * 64 + fr, col0 = u.p1 * 256 + wc * 32 + 8 * fq;
        const float* gp = gvec + (size_t)v * (NMOD * D) + col0;
        f32x4 gv[4];
#pragma unroll
        for (int q = 0; q < 4; ++q) gv[q] = *(const f32x4*)(gp + (q >> 1) * 128 + (q & 1) * 4);
        bf16* xbase = x + (size_t)row0 * D + col0;
        u32x4 xv[2][2];
#define ER_LD(grp, buf) do { const bf16* xp_ = xbase + (size_t)(((grp) >> 2) * 128 + ((grp) & 3) * 16) * D; xv[buf][0] = *(const u32x4*)xp_; xv[buf][1] = *(const u32x4*)(xp_ + 128); } while (0)
        ER_LD(0, 0);
#pragma unroll
        for (int grp = 0; grp < 8; ++grp) {
            if (grp < 7) ER_LD(grp + 1, (grp + 1) & 1);
            const int ai = grp >> 2, m = grp & 3, buf = grp & 1; bf16* xp = xbase + (size_t)(ai * 128 + m * 16) * D;
            float s2 = 0.f;
#pragma unroll
            for (int bj = 0; bj < 2; ++bj) { const u32x4 w = xv[buf][bj];
                const f32x4 n0 = (f32x4){bflo(w.x), bfhi(w.x), bflo(w.y), bfhi(w.y)} + gv[bj * 2] * acc[ai][bj][m][0], n1 = (f32x4){bflo(w.z), bfhi(w.z), bflo(w.w), bfhi(w.w)} + gv[bj * 2 + 1] * acc[ai][bj][m][1];
                u32x4 o; o.x = pk2(n0[0], n0[1]); o.y = pk2(n0[2], n0[3]); o.z = pk2(n1[0], n1[1]); o.w = pk2(n1[2], n1[3]); *(u32x4*)(xp + bj * 128) = o;
                s2 += ((n0[0] * n0[0] + n0[1] * n0[1]) + (n0[2] * n0[2] + n0[3] * n0[3])) + ((n1[0] * n1[0] + n1[1] * n1[1]) + (n1[2] * n1[2] + n1[3] * n1[3])); }
            s2 += shx(s2, 16, fq * 16 + fr); s2 += shx(s2, 32, fq * 16 + fr);
            if (fq == 0) ssq[(size_t)(row0 + ai * 128 + m * 16) * 16 + u.p1 * 4 + wc] = s2;
            asm volatile("" ::: "memory");
        }
#undef ER_LD
    }
};

struct EpiGateUp {
    static constexpr int MID = 0;
    unsigned char* hm;
    __device__ __forceinline__ void operator()(EPI_ARGS) const {
        const size_t base = (size_t)(u.p0 + wr * 64 + fr) * FF + u.p1 * 128 + wc * 32 + 8 * fq;
#pragma unroll
        for (int ai = 0; ai < 2; ++ai)
#pragma unroll
            for (int m = 0; m < 4; ++m) { unsigned char* rowp = hm + base + (size_t)(ai * 128 + m * 16) * FF;
                u32x2 w;
#pragma unroll
                for (int n = 0; n < 2; ++n) { const f32x4 g = acc[ai][0][m][n], up = acc[ai][1][m][n]; f32x4 v;
#pragma unroll
                    for (int j = 0; j < 4; ++j) v[j] = g[j] * sigmoidf_(g[j]) * up[j] * FP8_HM_SCALE;
                    const unsigned pk = pk4_fp8(v[0], v[1], v[2], v[3]); if (n == 0) w.x = pk; else w.y = pk; }
                *(u32x2*)rowp = w;
                asm volatile("" ::: "memory"); }
    }
};

struct FourierCtxOrder {
    const char* tc; const char* ftc; int G, c;
    __device__ __forceinline__ bool next(int i, Unit& u) const {
        const int L = i * G + ((c + G - 100) % G); if (L >= 8) return false;
        const int b = L >> 1, pn = L & 1;
        u.a = tc; u.b = ftc + ((size_t)b * 512 + pn * 256) * 512 * 2; u.p0 = ML + b * CTXL; u.p1 = pn * 256; u.p2 = 0; u.p3 = 0; return true;
    }
};
struct FtOrder {
    const char* w; const char* hn; int G, c, ntok;
    __device__ __forceinline__ bool next(int i, Unit& u) const {
        const int L = i * G + c; if (L >= 4 * ntok) return false;
        const int pn = L >> 2, pm = L & 3;
        u.a = w + (size_t)pm * 256 * D * 2; u.b = hn + (size_t)pn * 256 * D * 2;
        const int part = pm >> 1, m0 = (pm & 1) * 256;
        if (pn < 64) { const int b = pn >> 4; u.p0 = b * 512 + m0; u.p1 = part * SEQ + (pn & 15) * 256; u.p2 = 0; }
        else { const int b = pn - 64; u.p0 = b * 512 + m0; u.p1 = part * CTXL; u.p2 = 1; }
        u.p3 = 0; return true;
    }
};
template <int NPN, int P1MUL, int ESZ>
struct MoeOrder {
    const volatile LAS int* tstart; const char* a; const char* w; size_t wexp; int G, c;
    __device__ __forceinline__ bool next(int i, Unit& u) const {
        const int nt = __builtin_amdgcn_readfirstlane(tstart[16]); const int L = i * G + c; if (L >= nt * NPN) return false;
        const int tile = L / NPN, pn = L - tile * NPN;
        int e = 0;
#pragma unroll
        for (int k = 1; k < 16; ++k) e += (tile >= __builtin_amdgcn_readfirstlane(tstart[k])) ? 1 : 0;
        u.a = a + (size_t)tile * 256 * D * ESZ; u.b = w + (size_t)e * wexp + (size_t)pn * 256 * D * ESZ;
        u.p0 = tile * 256; u.p1 = pn * P1MUL; u.p2 = 0; u.p3 = e; return true;
    }
};

struct Frame {
    LAS unsigned char* lds;
    int tid, lane, wave, G, bid;
    float* out;
    GAS unsigned char* ws;
};
#define WSP(T, off) ((T*)(F.ws + (off)))
enum { IN_X = 0, IN_C, IN_CTX, IN_CCTX, IN_WMOD, IN_BMOD, IN_NMIX, IN_NFFN, IN_WIN, IN_SINK, IN_CONVW, IN_CONVB, IN_FW1, IN_FB1, IN_FFREQ, IN_FW2, IN_FB2, IN_FW3, IN_HBIAS,
       IN_WBA, IN_WBF, IN_WBH, IN_WOUT, IN_WROUTER, IN_BROUTER, IN_WEG, IN_WEU, IN_WED, IN_NFINAL };

__device__ __forceinline__ int pslot(int n) { return 16 * ((n >> 2) & 1) + 4 * (n >> 3) + (n & 3); }
__device__ __forceinline__ void transpose_item(const float* W, int lds_, int k0, int n0, bf16* WT, int ldd, int drow0, LAS float* scr, int lane, bool perm = false) {
#pragma unroll
    for (int i = 0; i < 8; ++i) { const int kk = 8 * i + (lane >> 3), c4 = (lane & 7) * 4; const f32x4 v = *(const f32x4*)(W + (size_t)(k0 + kk) * lds_ + n0 + c4);
        LAS float* d = scr + kk * 33 + c4; d[0] = v[0]; d[1] = v[1]; d[2] = v[2]; d[3] = v[3]; }
    LDS_WAIT(); asm volatile("" ::: "memory");
    const int c = lane & 7;
#pragma unroll
    for (int j = 0; j < 4; ++j) { const int n = (lane >> 3) + 8 * j; const LAS float* s = scr + (8 * c) * 33 + n;
        u32x4 o; o.x = pk2(s[0 * 33], s[1 * 33]); o.y = pk2(s[2 * 33], s[3 * 33]); o.z = pk2(s[4 * 33], s[5 * 33]); o.w = pk2(s[6 * 33], s[7 * 33]);
        *(u32x4*)(WT + (size_t)(drow0 + (perm ? pslot(n) : n)) * ldd + k0 + 8 * c) = o; }
    LDS_WAIT(); asm volatile("" ::: "memory");
}

__device__ __forceinline__ void transpose_item8(const float* W, int lds_, int k0, int n0, unsigned char* WT, int ldd, int drow0, LAS float* scr, int lane, float scale) {
#pragma unroll
    for (int i = 0; i < 8; ++i) { const int kk = 8 * i + (lane >> 3), c4 = (lane & 7) * 4; const f32x4 v = *(const f32x4*)(W + (size_t)(k0 + kk) * lds_ + n0 + c4);
        LAS float* d = scr + kk * 33 + c4; d[0] = v[0]; d[1] = v[1]; d[2] = v[2]; d[3] = v[3]; }
    LDS_WAIT(); asm volatile("" ::: "memory");
    const int c = lane & 7;
#pragma unroll
    for (int j = 0; j < 4; ++j) { const int n = (lane >> 3) + 8 * j; const LAS float* s = scr + (8 * c) * 33 + n;
        u32x2 o; o.x = pk4_fp8(s[0 * 33] * scale, s[1 * 33] * scale, s[2 * 33] * scale, s[3 * 33] * scale); o.y = pk4_fp8(s[4 * 33] * scale, s[5 * 33] * scale, s[6 * 33] * scale, s[7 * 33] * scale);
        *(u32x2*)(WT + (size_t)(drow0 + pslot(n)) * ldd + k0 + 8 * c) = o; }
    LDS_WAIT(); asm volatile("" ::: "memory");
}

__device__ __forceinline__ void pro_weights(Frame& F, const float* w_in, const float* wba, const float* wbf, const float* wbh, const float* wout, const float* fw3) {
    LAS float* scr = (LAS float*)(F.lds + F.wave * 16384);
    const int gw = F.bid * NWAVES + F.wave, NGW = F.G * NWAVES;
    constexpr int I1 = 16 * 24, I2 = 16 * 96, I3 = 16 * 48, I4 = 8 * 32, I7 = 16 * 32;
    constexpr int I8 = 64;
    constexpr int NPER = I1 + I2 + I3 + 3 * I4 + I7 + I8;
    for (int it = gw; it < DEPTH * NPER; it += NGW) {
        const int l = it / NPER; int r = it - l * NPER;
        unsigned char* wl = (unsigned char*)(F.ws + WS_W + (size_t)l * WL_SIZE);
        const float* win = w_in + (size_t)l * D * INW;
        if (r < I1) { const int kb = r / 24, nb = r % 24; transpose_item(win, INW, kb * 64, nb * 32, (bf16*)(wl + WL_QKVG), D, nb * 32, scr, F.lane); continue; } r -= I1;
        if (r < I2) { const int kb = r / 96, nb = r % 96; transpose_item8(win, INW, kb * 64, G_OFF + nb * 32, wl + WL_G8, D, nb * 32, scr, F.lane, FP8_W_SCALE); continue; } r -= I2;
        if (r < I3) { const int kb = r / 48, nb = r % 48; transpose_item(win, INW, kb * 64, H_OFF + nb * 32, (bf16*)(wl + WL_H), D, nb * 32, scr, F.lane); continue; } r -= I3;
        if (r < 3 * I4) { const int br = r / I4; r -= br * I4; const int kb = r / 32, nb = r % 32;
            const float* w = (br == 0 ? wba : br == 1 ? wbf : wbh) + (size_t)l * 512 * D;
            transpose_item(w, D, kb * 64, nb * 32, (bf16*)(wl + WL_BA) + br * 512, 1536, nb * 32, scr, F.lane, true); continue; } r -= 3 * I4;
        if (r < I7) { const int kb = r / 32, nb = r % 32; transpose_item(wout + (size_t)l * D * D, D, kb * 64, nb * 32, (bf16*)(wl + WL_OUT), D, nb * 32, scr, F.lane, true); continue; } r -= I7;
        transpose_item(fw3 + (size_t)l * 64 * 2048, 2048, 0, r * 32, WSP(bf16, WS_W3T) + (size_t)l * 2048 * 64, 64, r * 32, scr, F.lane);
    }
}
__device__ __forceinline__ void conv_experts(Frame& F, int l, const float* weg, const float* weu, const float* wed, int lo, int hi, int bid0) {
    LAS float* scr = (LAS float*)(F.lds + F.wave * 16384);
    if (F.bid < bid0) return;
    const int gw = (F.bid - bid0) * NWAVES + F.wave, NGW = (F.G - bid0) * NWAVES;
    constexpr int IE = 16 * 32;
    unsigned char* wbuf = (unsigned char*)(F.ws + WS_WEXP + (size_t)(l & 1) * WE_BUF);
    for (int it = lo + gw; it < hi; it += NGW) {
        const int e = it / (3 * IE); int r = it - e * 3 * IE; const int which = r / IE; r -= which * IE;
        const int kb = r / 32, nb = r % 32, n0 = nb * 32;
        const size_t eoff = ((size_t)l * NEXP + e) * D * FF;
        if (which < 2) {
            const float* w = (which == 0 ? weg : weu) + eoff;
            unsigned char* dst = wbuf + WE_GU + (size_t)e * 2048 * D;
            const int drow = (n0 >> 7) * 256 + which * 128 + (n0 & 127);
            transpose_item8(w, FF, kb * 64, n0, dst, D, drow, scr, F.lane, FP8_W_SCALE);
        } else {
            unsigned char* dst = wbuf + WE_D + (size_t)e * D * FF;
            transpose_item8(wed + eoff, D, kb * 64, n0, dst, FF, n0, scr, F.lane, FP8_W_SCALE);
        }
    }
}
__device__ __forceinline__ void pro_fold(Frame& F, const float* w_in) {
    LAS unsigned char* wl_ = F.lds;
    LAS unsigned char* tl_ = F.lds + 64 * 272;
    const int lane = F.lane, fr = lane & 15, fq = lane >> 4, w = F.wave;
    for (int unit = F.bid; unit < DEPTH * 4 * 16; unit += F.G) {
        const int l = unit >> 6, g = (unit >> 4) & 3, kb = unit & 15;
        __syncthreads();
        for (int i = F.tid; i < 256 * 64; i += NTHR) { const int pm = i >> 6, c2 = (i & 63) * 2, m = pm & 127; const bool sn = pm >= 128;
        const float a0 = (float)((m * c2) & 127) / 64.0f, a1 = (float)((m * (c2 + 1)) & 127) / 64.0f;
        *(LAS unsigned*)(tl_ + pm * 272 + c2 * 2) = pk2(sn ? sinpif(a0) : cospif(a0), sn ? sinpif(a1) : cospif(a1)); }
        const float* win = w_in + (size_t)l * D * INW + (size_t)(kb * 64) * INW + F_OFF + g * 128;
        for (int i = F.tid; i < 64 * 32; i += NTHR) { const int k = i >> 5, c4 = (i & 31) * 4; const f32x4 v = *(const f32x4*)(win + (size_t)k * INW + c4);
            u32x2 o; o.x = pk2(v[0], v[1]); o.y = pk2(v[2], v[3]); *(LAS u32x2*)(wl_ + k * 272 + c4 * 2) = o; }
        __syncthreads();
        bf16* dstb = (bf16*)(F.ws + WS_W + (size_t)l * WL_SIZE + WL_F) + kb * 64;
#pragma unroll
        for (int pt = 0; pt < 2; ++pt) {
            const int pm = 32 * w + 16 * pt + fr, part = pm >> 7, m = pm & 127;
            bf16x8 tf[4];
#pragma unroll
            for (int ks = 0; ks < 4; ++ks) tf[ks] = *(const LAS bf16x8*)(tl_ + pm * 272 + ks * 64 + fq * 16);
#pragma unroll
            for (int kt = 0; kt < 4; ++kt) {
                f32x4 acc = (f32x4){0.f, 0.f, 0.f, 0.f};
#pragma unroll
                for (int ks = 0; ks < 4; ++ks) { const bf16x8 wf = *(const LAS bf16x8*)(wl_ + (kt * 16 + fr) * 272 + ks * 64 + fq * 16); acc = __builtin_amdgcn_mfma_f32_16x16x32_bf16(wf, tf[ks], acc, 0, 0, 0); }
                acc = acc * 0.08838834764831845f;
                u32x2 o; o.x = pk2(acc[0], acc[1]); o.y = pk2(acc[2], acc[3]);
                *(u32x2*)(dstb + (size_t)(part * 512 + g * 128 + m) * D + kt * 16 + 4 * fq) = o;
            }
        }
    }
    __syncthreads();
}
__device__ __forceinline__ void pro_mods(Frame& F, const float* cvec, const float* cctx, const float* wmod, const float* bmod) {
    LAS float* sc = (LAS float*)F.lds;
    LAS float* part = sc + 5 * 1024;
    __syncthreads();
    for (int i = F.tid; i < 5 * 1024; i += NTHR) { const int v = i >> 10, k = i & 1023; const float x = v < 4 ? cvec[v * D + k] : cctx[k]; sc[i] = x * sigmoidf_(x); }
    __syncthreads();
    float* mods = WSP(float, WS_MODS);
    const int krow = F.tid >> 3, col4 = (F.tid & 7) * 4;
    for (int unit = F.bid; unit < DEPTH * 192; unit += F.G) {
        const int l = unit / 192, jc = unit % 192;
        const float* w = wmod + (size_t)l * D * (NMOD * D) + (size_t)krow * (NMOD * D) + jc * 32 + col4;
        f32x4 a[5];
#pragma unroll
        for (int v = 0; v < 5; ++v) a[v] = (f32x4){0.f, 0.f, 0.f, 0.f};
#pragma unroll
        for (int i = 0; i < 16; ++i) { const f32x4 wv = *(const f32x4*)(w + (size_t)(64 * i) * (NMOD * D)); const int kk = krow + 64 * i;
#pragma unroll
            for (int v = 0; v < 5; ++v) a[v] += sc[v * 1024 + kk] * wv; }
#pragma unroll
        for (int v = 0; v < 5; ++v) *(LAS f32x4*)(part + (krow * 5 + v) * 32 + col4) = a[v];
        __syncthreads();
        if (F.tid < 160) { const int v = F.tid >> 5, c2 = F.tid & 31; float s = bmod[(size_t)l * (NMOD * D) + jc * 32 + c2];
#pragma unroll 8
            for (int k = 0; k < 64; ++k) s += part[(k * 5 + v) * 32 + c2];
            mods[((size_t)l * 5 + v) * (NMOD * D) + jc * 32 + c2] = s; }
        __syncthreads();
    }
}
__device__ __forceinline__ void pro_tables(Frame& F) {
    LAS float* lc = (LAS float*)F.lds;
    LAS float* lsn = lc + 4096;
    __syncthreads();
    for (int j = F.tid; j < 4096; j += NTHR) { lc[j] = cospif((float)j / 2048.0f) * 0.015625f; lsn[j] = sinpif((float)j / 2048.0f) * 0.015625f; }
    __syncthreads();
    if (F.bid == 0) {
        float* rope = WSP(float, WS_ROPE);
        for (int i = F.tid; i < 64 * 16; i += NTHR) { const int pos = i >> 4, d = i & 15; const float fr = powf(10000.0f, -(float)d / 16.0f); const float ang = (float)pos * fr; rope[2 * i] = cosf(ang); rope[2 * i + 1] = sinf(ang); }
    }
    bf16* TCp = WSP(bf16, WS_TC);
    for (int k = F.bid; k < 256; k += F.G) {
        if (F.tid < 64) { const int ch = F.tid; const int n0 = (ch * 8) & 255; const bool isS = ch >= 32;
            float v[8];
#pragma unroll
            for (int j = 0; j < 8; ++j) { const int idx = ((k * (n0 + j)) & 255) * 16; v[j] = 4.0f * (isS ? -lsn[idx] : lc[idx]); }
            u32x4 o; o.x = pk2(v[0], v[1]); o.y = pk2(v[2], v[3]); o.z = pk2(v[4], v[5]); o.w = pk2(v[6], v[7]);
            *(u32x4*)(TCp + (size_t)k * 512 + ch * 8) = o; }
    }
    { bf16* T1 = WSP(bf16, WS_FT1); bf16* T1F = WSP(bf16, WS_FT1F); bf16* T2 = WSP(bf16, WS_FT2); bf16* T3 = WSP(bf16, WS_FT3); bf16* T4 = WSP(bf16, WS_FT4);
      for (int i = F.bid * NTHR + F.tid; i < 32768; i += F.G * NTHR) {
          { const int row = i >> 7, col = i & 127, k1 = row & 127, im = row >> 7, kk = col & 63, part = col >> 6;
            const float a = (float)((kk * k1) & 127) / 64.0f; const float c = cospif(a), s = sinpif(a);
            T1[i] = f2bf(im == 0 ? (part == 0 ? c : s) : (part == 0 ? -s : c));
            const float af = (float)((col * k1) & 127) / 64.0f; T1F[i] = f2bf(im == 0 ? cospif(af) : -sinpif(af)); }
          { const int row = i >> 8, col = i & 255, n1 = row & 63, im = row >> 6, k1 = col & 127, part = col >> 7;
            const float a = (float)((k1 * n1) & 127) / 64.0f; const float c = cospif(a), s = sinpif(a);
            T4[((((n1 >> 4) * 2 + im) * 8 + (col >> 5)) * 64 + ((col >> 3) & 3) * 16 + (n1 & 15)) * 8 + (col & 7)] = f2bf(im == 0 ? (part == 0 ? c : -s) : (part == 0 ? s : c)); }
          if (i < 16384) { const int row = i >> 7, col = i & 127, kr = row & 63, im = row >> 6, kc = col & 63, part = col >> 6;
            const float a = (float)((kr * kc) & 63) / 32.0f; const float c = cospif(a), s = sinpif(a);
            T2[i] = f2bf(im == 0 ? (part == 0 ? c : s) : (part == 0 ? -s : c));
            T3[i] = f2bf(im == 0 ? (part == 0 ? c : -s) : (part == 0 ? s : c)); }
      } }
    __syncthreads();
}
__device__ __forceinline__ void pro_hid(Frame& F, const float* fw1, const float* fb1, const float* ffreq, const float* fw2, const float* fb2) {
    const int gw = F.bid * NWAVES + F.wave, NGW = F.G * NWAVES;
    bf16* HID = WSP(bf16, WS_HID);
    const int wpl = NGW / DEPTH;
    if (wpl == 0 || gw >= wpl * DEPTH) return;
    const int l = gw / wpl, wi = gw - l * wpl;
    const float* w1 = fw1 + (size_t)l * 33 * 64; const float* w2 = fw2 + (size_t)l * 64 * 64;
    float w1r[33], w2r[64];
#pragma unroll
    for (int i = 0; i < 33; ++i) w1r[i] = w1[i * 64 + F.lane];
#pragma unroll
    for (int i = 0; i < 64; ++i) w2r[i] = w2[i * 64 + F.lane];
    const float b1v = fb1[l * 64 + F.lane], b2v = fb2[l * 64 + F.lane], fqv = ffreq[l * 64 + F.lane];
    for (int p = wi; p < 4352; p += wpl) {
        const int n = p < 4096 ? 4096 : 256; const int pos = p < 4096 ? p : p - 4096;
        const float t = (float)pos / (float)(n - 1); const float omega = 6.283185307179586f * (float)pos / (float)n;
        float feat = 0.f;
        if (F.lane == 0) feat = t;
        else if (F.lane <= 16) { const float band = 1e-4f + (float)(F.lane - 1) * ((15.0f - 1e-4f) / 15.0f); feat = cosf(omega * band); }
        else if (F.lane <= 32) { const float band = 1e-4f + (float)(F.lane - 17) * ((15.0f - 1e-4f) / 15.0f); feat = -sinf(omega * band); }
        float a = b1v;
#pragma unroll
        for (int i = 0; i < 33; ++i) a += rdlane(feat, i) * w1r[i];
        const float h1 = sinf(fqv * a);
        float a2 = b2v;
#pragma unroll
        for (int i = 0; i < 64; ++i) a2 += rdlane(h1, i) * w2r[i];
        HID[((size_t)l * 4352 + p) * 64 + F.lane] = f2bf(sinf(fqv * a2));
    }
}
__device__ __forceinline__ void pro_filt2(Frame& F) {
    const bf16* HID = WSP(bf16, WS_HID); const bf16* W3T = WSP(bf16, WS_W3T); bf16* HFB = WSP(bf16, WS_HFILT);
    const int fr = F.lane & 15, fq = F.lane >> 4;
    constexpr int NITEM = DEPTH * 68 * 16;
    const int per = (NITEM + F.G - 1) / F.G, j0 = F.bid * per, j1 = (j0 + per < NITEM) ? j0 + per : NITEM;
    int cur_unit = -1;
    bf16x8 pf[4][2];
    for (int jb = j0; jb < j1; jb += 8) {
        bf16x8 qa[8], qb[8];
#pragma unroll
        for (int k = 0; k < 8; ++k) { const int j = (jb + k < j1) ? jb + k : j1 - 1; const int unit = j >> 4, ct = j & 15, l = unit / 68;
            const bf16* w3t = W3T + (size_t)l * 2048 * 64 + (size_t)(F.wave * 256 + ct * 16 + fr) * 64;
            qa[k] = *(const bf16x8*)(w3t + fq * 8); qb[k] = *(const bf16x8*)(w3t + 32 + fq * 8); }
#pragma unroll
        for (int k = 0; k < 8; ++k) {
            const int j = jb + k; if (j >= j1) break;
            const int unit = j >> 4, ct = j & 15, l = unit / 68, pb = unit % 68;
            if (unit != cur_unit) { cur_unit = unit; const bf16* hid = HID + ((size_t)l * 4352 + pb * 64) * 64;
#pragma unroll
                for (int it = 0; it < 4; ++it)
#pragma unroll
                    for (int ks = 0; ks < 2; ++ks) pf[it][ks] = *(const bf16x8*)(hid + (size_t)(8 * (fr >> 2) + 4 * (it & 1) + (fr & 3) + 32 * (it >> 1)) * 64 + ks * 32 + fq * 8); }
            bf16* hf = HFB + (size_t)l * 2048 * 4352;
            const bool ctxblk = pb >= 64;
            const int col = F.wave * 256 + ct * 16 + fr;
            const int c = col & 511; const bool bwd = (col & 512) != 0;
            const float delta = 3.0701134573253944f + (15.350567286626972f - 3.0701134573253944f) * (float)c / 511.0f;
#pragma unroll
            for (int h = 0; h < 2; ++h) {
                f32x4 a0 = (f32x4){0.f, 0.f, 0.f, 0.f}, a1 = a0;
                a0 = __builtin_amdgcn_mfma_f32_16x16x32_bf16(pf[2 * h][0], qa[k], a0, 0, 0, 0); a0 = __builtin_amdgcn_mfma_f32_16x16x32_bf16(pf[2 * h][1], qb[k], a0, 0, 0, 0);
                a1 = __builtin_amdgcn_mfma_f32_16x16x32_bf16(pf[2 * h + 1][0], qa[k], a1, 0, 0, 0); a1 = __builtin_amdgcn_mfma_f32_16x16x32_bf16(pf[2 * h + 1][1], qb[k], a1, 0, 0, 0);
                const int pos0 = (ctxblk ? (pb - 64) * 64 : pb * 64) + 32 * h + 8 * fq;
                const float tinv = ctxblk ? (1.0f / 255.0f) : (1.0f / 4095.0f);
                float v[8];
#pragma unroll
                for (int r = 0; r < 4; ++r) { v[r] = a0[r] * __expf(-(float)(pos0 + r) * tinv * delta); v[4 + r] = a1[r] * __expf(-(float)(pos0 + 4 + r) * tinv * delta); }
                u32x4 wv;
                if (!bwd) { wv.x = pk2(v[0], v[1]); wv.y = pk2(v[2], v[3]); wv.z = pk2(v[4], v[5]); wv.w = pk2(v[6], v[7]); *(u32x4*)(hf + (size_t)col * 4352 + (ctxblk ? 4096 : 0) + pos0) = wv; }
                else { wv.x = pk2(v[7], v[6]); wv.y = pk2(v[5], v[4]); wv.z = pk2(v[3], v[2]); wv.w = pk2(v[1], v[0]); *(u32x4*)(hf + (size_t)col * 4352 + (ctxblk ? 4096 + 248 - pos0 : 4088 - pos0)) = wv; }
            }
        }
    }
}
__device__ __forceinline__ void pro_copy_x(Frame& F, const float* xin, const float* ctxin) {
    u32x4* X = WSP(u32x4, WS_X);
    const f32x4* xl = (const f32x4*)xin; const f32x4* xc = (const f32x4*)ctxin;
    const size_t nl = (size_t)ML * D / 8, nc = (size_t)MC * D / 8;
    for (size_t i = (size_t)F.bid * NTHR + F.tid; i < nl + nc; i += (size_t)F.G * NTHR) { const f32x4* s = i < nl ? xl + 2 * i : xc + 2 * (i - nl); const f32x4 a = s[0], b = s[1];
        u32x4 w; w.x = pk2(a[0], a[1]); w.y = pk2(a[2], a[3]); w.z = pk2(b[0], b[1]); w.w = pk2(b[2], b[3]); X[i] = w; }
}

__device__ __forceinline__ void unpk8(const u32x4 w, f32x4& lo, f32x4& hi) { lo = (f32x4){bflo(w.x), bfhi(w.x), bflo(w.y), bfhi(w.y)}; hi = (f32x4){bflo(w.z), bfhi(w.z), bflo(w.w), bfhi(w.w)}; }
__device__ __forceinline__ u32x4 pk8(const f32x4 lo, const f32x4 hi) { u32x4 w; w.x = pk2(lo[0], lo[1]); w.y = pk2(lo[2], lo[3]); w.z = pk2(hi[0], hi[1]); w.w = pk2(hi[2], hi[3]); return w; }
template <bool COMBINE, int MODE>
__device__ __forceinline__ void norm_rows(Frame& F, const float* gamma, const float* modsL  , int sh_idx, const float* modsPrev  ) {
    const int gw = F.bid * NWAVES + F.wave, NGW = F.G * NWAVES;
    bf16* X = WSP(bf16, WS_X); bf16* HN = WSP(bf16, WS_HN);
    const int* slot = WSP(int, WS_SLOT); const f32x4* route = WSP(f32x4, WS_ROUTE); const bf16* Y = WSP(bf16, WS_Y);
    f32x4 gm[2][2];
#pragma unroll
    for (int j = 0; j < 2; ++j)
#pragma unroll
        for (int h = 0; h < 2; ++h) gm[j][h] = *(const f32x4*)(gamma + 8 * F.lane + 512 * j + 4 * h);
    const int nrows = MODE == 1 ? ML : MT;
    auto process = [&](int row, const u32x4 (&xraw)[2], const u32x4 (&y0raw)[2], const u32x4 (&y1raw)[2], float w0, float w1, bool st) {
        const int v = row < ML ? (row >> 12) : 4;
        bf16* xr = X + (size_t)row * D + 8 * F.lane;
        f32x4 x[2][2];
#pragma unroll
        for (int j = 0; j < 2; ++j) unpk8(xraw[j], x[j][0], x[j][1]);
        if (COMBINE) {
            const float* g2 = modsPrev + (size_t)v * (NMOD * D) + 5 * D + 8 * F.lane;
#pragma unroll
            for (int j = 0; j < 2; ++j) { f32x4 a[2], b[2]; unpk8(y0raw[j], a[0], a[1]); unpk8(y1raw[j], b[0], b[1]);
#pragma unroll
                for (int h = 0; h < 2; ++h) { const f32x4 g = *(const f32x4*)(g2 + 512 * j + 4 * h); x[j][h] += g * (w0 * a[h] + w1 * b[h]); }
                if (st) *(u32x4*)(xr + 512 * j) = pk8(x[j][0], x[j][1]); }
        }
        float ss = 0.f;
#pragma unroll
        for (int j = 0; j < 2; ++j)
#pragma unroll
            for (int h = 0; h < 2; ++h) ss += (x[j][h][0] * x[j][h][0] + x[j][h][1] * x[j][h][1]) + (x[j][h][2] * x[j][h][2] + x[j][h][3] * x[j][h][3]);
        const float rstd = 1.0f / sqrtf(wave_sum(ss, F.lane) * (1.0f / D) + EPS);
        if (MODE == 0) {
            const float* sh = modsL + (size_t)v * (NMOD * D) + sh_idx * D + 8 * F.lane; const float* sc = sh + D;
            bf16* hr = HN + (size_t)row * D + 8 * F.lane; unsigned char* h8 = WSP(unsigned char, WS_HN8) + (size_t)row * D + 8 * F.lane;
#pragma unroll
            for (int j = 0; j < 2; ++j) { f32x4 hh[2];
#pragma unroll
                for (int h = 0; h < 2; ++h) { const f32x4 s1 = *(const f32x4*)(sc + 512 * j + 4 * h), s0 = *(const f32x4*)(sh + 512 * j + 4 * h); hh[h] = x[j][h] * rstd * gm[j][h] * (1.0f + s1) + s0; }
                u32x2 q8; q8.x = pk4_fp8(hh[0][0] * FP8_ACT_SCALE, hh[0][1] * FP8_ACT_SCALE, hh[0][2] * FP8_ACT_SCALE, hh[0][3] * FP8_ACT_SCALE); q8.y = pk4_fp8(hh[1][0] * FP8_ACT_SCALE, hh[1][1] * FP8_ACT_SCALE, hh[1][2] * FP8_ACT_SCALE, hh[1][3] * FP8_ACT_SCALE);
                if (st) { *(u32x4*)(hr + 512 * j) = pk8(hh[0], hh[1]); *(u32x2*)(h8 + 512 * j) = q8; } }
        } else {
            float* orow = F.out + (size_t)row * D + 8 * F.lane;
#pragma unroll
            for (int j = 0; j < 2; ++j)
#pragma unroll
                for (int h = 0; h < 2; ++h) if (st) *(f32x4*)(orow + 512 * j + 4 * h) = x[j][h] * rstd * gm[j][h];
        }
    };
    for (int row = gw; row < nrows; row += 2 * NGW) {
        const bool hasB = row + NGW < nrows; const int rowB = hasB ? row + NGW : row;
        u32x4 xa[2], xb[2], ya0[2], ya1[2], yb0[2], yb1[2]; float wa0 = 0.f, wa1 = 0.f, wb0 = 0.f, wb1 = 0.f;
#pragma unroll
        for (int j = 0; j < 2; ++j) { xa[j] = *(const u32x4*)(X + (size_t)row * D + 8 * F.lane + 512 * j); xb[j] = *(const u32x4*)(X + (size_t)rowB * D + 8 * F.lane + 512 * j); }
        if (COMBINE) {
            const int sa0 = slot[2 * row], sa1 = slot[2 * row + 1], sb0 = slot[2 * rowB], sb1 = slot[2 * rowB + 1];
            const f32x4 ra = route[row], rb = route[rowB]; wa0 = ra[2]; wa1 = ra[3]; wb0 = rb[2]; wb1 = rb[3];
#pragma unroll
            for (int j = 0; j < 2; ++j) { ya0[j] = *(const u32x4*)(Y + (size_t)sa0 * D + 8 * F.lane + 512 * j); ya1[j] = *(const u32x4*)(Y + (size_t)sa1 * D + 8 * F.lane + 512 * j);
                yb0[j] = *(const u32x4*)(Y + (size_t)sb0 * D + 8 * F.lane + 512 * j); yb1[j] = *(const u32x4*)(Y + (size_t)sb1 * D + 8 * F.lane + 512 * j); }
        } else {
#pragma unroll
            for (int j = 0; j < 2; ++j) { ya0[j] = xa[j]; ya1[j] = xa[j]; yb0[j] = xa[j]; yb1[j] = xa[j]; }
        }
        asm volatile("" ::: "memory");
        process(row, xa, ya0, ya1, wa0, wa1, true);
        process(rowB, xb, yb0, yb1, wb0, wb1, hasB);
    }
}

__device__ __forceinline__ void norm_route(Frame& F, const float* gamma, const float* modsL, const float* wrouter, const float* brouter, int nrows) {
    constexpr int WBLK = 256 * 16 + 16;
    LAS float* wl = (LAS float*)F.lds;
    LAS float* lgx = wl + 4 * WBLK;
    LAS int* lcnt = (LAS int*)(lgx + 8 * 16 * 17);
    LAS float* mA = (LAS float*)(lcnt + 16);
    LAS float* mB = mA + 5 * 1024;
    __syncthreads();
    for (int i = F.tid; i < 5 * 1024; i += NTHR) { const int v_ = i >> 10, c_ = i & 1023; mA[i] = gamma[c_] * (1.0f + modsL[(size_t)v_ * (NMOD * D) + 4 * D + c_]); mB[i] = modsL[(size_t)v_ * (NMOD * D) + 3 * D + c_]; }
    for (int i = F.tid; i < 16 * 1024; i += NTHR) { const int k = i >> 4; wl[((k >> 3) & 3) * WBLK + ((k >> 5) * 8 + (k & 7)) * 16 + (i & 15)] = wrouter[i]; }
    if (F.tid < 16) lcnt[F.tid] = 0;
    __syncthreads();
    const int gw = F.bid * NWAVES + F.wave, NGW = F.G * NWAVES;
    const bf16* X = WSP(bf16, WS_X); unsigned char* HN8 = WSP(unsigned char, WS_HN8); f32x4* route = WSP(f32x4, WS_ROUTE);
    const int r = F.lane & 15, kk = F.lane >> 4;
    LAS float* lgw = lgx + F.wave * (16 * 17);
    for (int pass = F.bid + F.wave * F.G; pass < nrows / 16; pass += NGW) {
        const int row = pass * 16 + r; const int v = row < ML ? (row >> 12) : 4;
        const u32x4* xp = (const u32x4*)(X + (size_t)row * D) + kk;
        const f32x4 sq = *((const f32x4*)(WSP(float, WS_SSQ) + (size_t)row * 16) + kk);
        float ss = (sq[0] + sq[1]) + (sq[2] + sq[3]);
        ss += shx(ss, 16, F.lane); ss += shx(ss, 32, F.lane);
        const float rstd = 1.0f / sqrtf(ss * (1.0f / D) + EPS);
        const LAS f32x4* ap = (const LAS f32x4*)(mA + v * 1024) + 2 * kk; const LAS f32x4* bp = (const LAS f32x4*)(mB + v * 1024) + 2 * kk;
        u32x2* hp = (u32x2*)(HN8 + (size_t)row * D) + kk;
        const LAS float* wk = wl + kk * WBLK + r;
        f32x4 acc = (f32x4){0.f, 0.f, 0.f, 0.f}, accB = acc;
        u32x4 xraw[32];
#pragma unroll
        for (int s4 = 0; s4 < 32; ++s4) xraw[s4] = xp[4 * s4];
#pragma unroll
        for (int s4 = 0; s4 < 32; ++s4) {
            f32x4 xl, xh; unpk8(xraw[s4], xl, xh);
            const f32x4 hl = xl * rstd * ap[8 * s4] + bp[8 * s4], hh = xh * rstd * ap[8 * s4 + 1] + bp[8 * s4 + 1];
            u32x2 w; w.x = pk4_fp8(hl[0] * FP8_ACT_SCALE, hl[1] * FP8_ACT_SCALE, hl[2] * FP8_ACT_SCALE, hl[3] * FP8_ACT_SCALE); w.y = pk4_fp8(hh[0] * FP8_ACT_SCALE, hh[1] * FP8_ACT_SCALE, hh[2] * FP8_ACT_SCALE, hh[3] * FP8_ACT_SCALE); hp[4 * s4] = w;
#pragma unroll
            for (int j = 0; j < 4; ++j) acc = __builtin_amdgcn_mfma_f32_16x16x4f32(hl[j], wk[(8 * s4 + j) * 16], acc, 0, 0, 0);
#pragma unroll
            for (int j = 0; j < 4; ++j) accB = __builtin_amdgcn_mfma_f32_16x16x4f32(hh[j], wk[(8 * s4 + 4 + j) * 16], accB, 0, 0, 0);
        }
        acc = acc + accB;
#pragma unroll
        for (int q = 0; q < 4; ++q) lgw[(4 * kk + q) * 17 + r] = acc[q];
        LDS_WAIT(); asm volatile("" ::: "memory");
        if (F.lane < 16) {
            float aff[16], bs[16];
#pragma unroll
            for (int e = 0; e < 16; ++e) { aff[e] = 1.0f / (1.0f + expf(-lgw[F.lane * 17 + e])); bs[e] = aff[e] + brouter[e]; }
            int gsel = 0; float gbest = -1e30f;
#pragma unroll
            for (int g = 0; g < 4; ++g) {
                float m1 = bs[4 * g]; int i1 = 0;
#pragma unroll
                for (int k = 1; k < 4; ++k) if (bs[4 * g + k] > m1) { m1 = bs[4 * g + k]; i1 = k; }
                float m2 = -1e30f;
#pragma unroll
                for (int k = 0; k < 4; ++k) if (k != i1 && bs[4 * g + k] > m2) m2 = bs[4 * g + k];
                const float s = m1 + m2; if (s > gbest) { gbest = s; gsel = g; }
            }
            float v4[4], a4[4];
#pragma unroll
            for (int k = 0; k < 4; ++k) { v4[k] = gsel == 0 ? bs[k] : gsel == 1 ? bs[4 + k] : gsel == 2 ? bs[8 + k] : bs[12 + k]; a4[k] = gsel == 0 ? aff[k] : gsel == 1 ? aff[4 + k] : gsel == 2 ? aff[8 + k] : aff[12 + k]; }
            int i1 = 0; float m1 = v4[0];
#pragma unroll
            for (int k = 1; k < 4; ++k) if (v4[k] > m1) { m1 = v4[k]; i1 = k; }
            int i2 = -1; float m2 = -1e30f;
#pragma unroll
            for (int k = 0; k < 4; ++k) if (k != i1 && v4[k] > m2) { m2 = v4[k]; i2 = k; }
            const float wa = i1 == 0 ? a4[0] : i1 == 1 ? a4[1] : i1 == 2 ? a4[2] : a4[3];
            const float wb = i2 == 0 ? a4[0] : i2 == 1 ? a4[1] : i2 == 2 ? a4[2] : a4[3];
            const float inv = 1.0f / (wa + wb);
            const int e0 = gsel * 4 + i1, e1 = gsel * 4 + i2;
            f32x4 rt; rt[0] = __int_as_float(e0); rt[1] = __int_as_float(e1); rt[2] = wa * inv; rt[3] = wb * inv; route[pass * 16 + F.lane] = rt;
            __hip_atomic_fetch_add(&lcnt[e0], 1, __ATOMIC_RELAXED, __HIP_MEMORY_SCOPE_WORKGROUP); __hip_atomic_fetch_add(&lcnt[e1], 1, __ATOMIC_RELAXED, __HIP_MEMORY_SCOPE_WORKGROUP);
        }
        asm volatile("" ::: "memory");
    }
    __syncthreads();
    if (F.tid < 16) WSP(int, WS_WGCNT)[F.bid * 16 + F.tid] = lcnt[F.tid];
}

__device__ __forceinline__ void moe_scatter(Frame& F, int nrows) {
    LAS int* ptot = (LAS int*)F.lds;
    LAS int* poff = ptot + 512;
    LAS int* ctr = poff + 512;
    __syncthreads();
    { const int e = F.tid & 15, seg = F.tid >> 4; const int per = (F.G + 31) / 32; int t = 0, o = 0; const int* wc = WSP(int, WS_WGCNT);
      for (int w = seg * per; w < (seg + 1) * per && w < F.G; ++w) { const int c = wc[w * 16 + e]; t += c; if (w < F.bid) o += c; }
      ptot[seg * 16 + e] = t; poff[seg * 16 + e] = o; }
    __syncthreads();
    if (F.tid == 0) {
        int base = 0; int* ti = WSP(int, WS_TILEINFO);
        for (int e = 0; e < 16; ++e) { int t = 0, o = 0; for (int s = 0; s < 32; ++s) { t += ptot[s * 16 + e]; o += poff[s * 16 + e]; }
            ctr[e] = base + o; if (F.bid == 0) ti[e] = base >> 8; base += (t + 255) & ~255; }
        if (F.bid == 0) ti[16] = base >> 8;
    }
    __syncthreads();
    const int gw = F.bid * NWAVES + F.wave, NGW = F.G * NWAVES;
    const unsigned char* HN8 = WSP(unsigned char, WS_HN8); unsigned char* XS = WSP(unsigned char, WS_XS); int* slot = WSP(int, WS_SLOT); const f32x4* route = WSP(f32x4, WS_ROUTE);
    const int npass = (nrows / 16 - F.bid + F.G - 1) / F.G;
#pragma unroll 2
    for (int idx = F.wave; idx < npass * 16; idx += NWAVES) {
        const int row = (F.bid + (idx >> 4) * F.G) * 16 + (idx & 15);
        int d0 = 0, d1 = 0;
        if (F.lane == 0) { const f32x4 rt = route[row]; const int e0 = __float_as_int(rt[0]), e1 = __float_as_int(rt[1]);
            d0 = __hip_atomic_fetch_add(&ctr[e0], 1, __ATOMIC_RELAXED, __HIP_MEMORY_SCOPE_WORKGROUP); d1 = __hip_atomic_fetch_add(&ctr[e1], 1, __ATOMIC_RELAXED, __HIP_MEMORY_SCOPE_WORKGROUP); slot[2 * row] = d0; slot[2 * row + 1] = d1; }
        d0 = __builtin_amdgcn_readfirstlane(d0); d1 = __builtin_amdgcn_readfirstlane(d1);
        const u32x4 a = *((const u32x4*)(HN8 + (size_t)row * D) + F.lane);
        *((u32x4*)(XS + (size_t)d0 * D) + F.lane) = a; *((u32x4*)(XS + (size_t)d1 * D) + F.lane) = a;
    }
}

__device__ __forceinline__ float sconv(const bf16* ut, int t, int n, float w0, float w1, float w2, float bb) {
    const float um = t > 0 ? bf2f(ut[t - 1]) : 0.f, u0 = bf2f(ut[t]), up = t < n - 1 ? bf2f(ut[t + 1]) : 0.f;
    return um * w0 + u0 * w1 + up * w2 + bb;
}
__device__ __forceinline__ float block_sum(Frame& F, float v, LAS float* red) {
    v = wave_sum(v, F.lane);
    __syncthreads();
    if (F.lane == 0) red[F.wave] = v;
    __syncthreads();
    float s = 0.f;
#pragma unroll
    for (int w = 0; w < NWAVES; ++w) s += red[w];
    return s;
}
__device__ __forceinline__ void sconv4(const bf16* ut, int t0, int n, float w0, float w1, float w2, float bb, float (&o)[4]) {
    const u32x2 w = *(const u32x2*)(ut + t0); const float xm = t0 > 0 ? bf2f(ut[t0 - 1]) : 0.f, xp = t0 + 4 < n ? bf2f(ut[t0 + 4]) : 0.f;
    const float x0 = bflo(w.x), x1 = bfhi(w.x), x2 = bflo(w.y), x3 = bfhi(w.y);
    o[0] = xm * w0 + x0 * w1 + x1 * w2 + bb; o[1] = x0 * w0 + x1 * w1 + x2 * w2 + bb; o[2] = x1 * w0 + x2 * w1 + x3 * w2 + bb; o[3] = x2 * w0 + x3 * w1 + xp * w2 + bb;
}
__device__ __forceinline__ void hyena_ctx_phase(Frame& F, int layer, const float* convw, const float* convb, const float* hbias) {
    LAS float* kk = (LAS float*)(F.lds + F.wave * 4096);
    LAS float* us = kk + 512;
    const bf16* UT = WSP(bf16, WS_UT); bf16* YH = WSP(bf16, WS_YB) + (size_t)64 * MT * 8;
    const bf16* HF = WSP(bf16, WS_HFILT) + (size_t)layer * (4352 * 2048);
    const float* cw = convw + (size_t)layer * 3 * HYW; const float* cb = convb + (size_t)layer * HYW;
    const float* hb = hbias + (size_t)layer * 2 * 512;
    const int l = F.lane;
    __syncthreads();
    if (F.wave < 4)
    for (int unit = F.bid * 4 + F.wave; unit < 1024; unit += F.G * 4) {
        const int c = unit >> 1, bp = unit & 1;
        float vz[2][4], xa[2][4], xb[2][4];
#pragma unroll
        for (int s = 0; s < 2; ++s) { const int row0 = ML + (2 * bp + s) * CTXL;
            sconv4(UT + (size_t)c * MT + row0, 4 * l, CTXL, cw[c], cw[HYW + c], cw[2 * HYW + c], cb[c], vz[s]);
            sconv4(UT + (size_t)(512 + c) * MT + row0, 4 * l, CTXL, cw[512 + c], cw[HYW + 512 + c], cw[2 * HYW + 512 + c], cb[512 + c], xa[s]);
            sconv4(UT + (size_t)(1024 + c) * MT + row0, 4 * l, CTXL, cw[1024 + c], cw[HYW + 1024 + c], cw[2 * HYW + 1024 + c], cb[1024 + c], xb[s]); }
#pragma unroll 1
        for (int ord = 0; ord < 2; ++ord) {
            float asum = 0.f;
#pragma unroll
            for (int j = 0; j < 4; ++j) { const int d = l + 64 * j;
                const float f = bf2f(HF[(size_t)(ord * 1024 + c) * 4352 + 4096 + d]), bw = bf2f(HF[(size_t)(ord * 1024 + 512 + c) * 4352 + 4096 + 255 - d]);
                kk[256 + d] = f; asum += fabsf(f); if (d > 0) { kk[256 - d] = bw; asum += fabsf(bw); } }
            if (l == 0) kk[0] = 0.f;
#pragma unroll
            for (int s = 0; s < 2; ++s) *(LAS f32x4*)(us + s * 256 + 4 * l) = (f32x4){vz[s][0], vz[s][1], vz[s][2], vz[s][3]};
            const float inv = 1.0f / wave_sum(asum, l);
            LDS_WAIT(); asm volatile("" ::: "memory");
            f32x2 acc[4];
#pragma unroll
            for (int i = 0; i < 4; ++i) acc[i] = (f32x2){0.f, 0.f};
            const LAS f32x4* kq = (const LAS f32x4*)kk + 64 + l;
            f32x4 hi = kq[0];
#pragma unroll 4
            for (int sp = 0; sp < CTXL; sp += 4) {
                const f32x4 lo = kq[-(sp >> 2) - 1];
                const f32x4 u0 = *(const LAS f32x4*)(us + sp), u1 = *(const LAS f32x4*)(us + 256 + sp);
                const float win[7] = {lo[1], lo[2], lo[3], hi[0], hi[1], hi[2], hi[3]};
#pragma unroll
                for (int i = 0; i < 4; ++i)
#pragma unroll
                    for (int jj = 0; jj < 4; ++jj) { const float k = win[3 + i - jj]; acc[i] += (f32x2){k, k} * (f32x2){u0[jj], u1[jj]}; }
                hi = lo;
            }
            const float bias = hb[ord * 512 + c];
#pragma unroll
            for (int s = 0; s < 2; ++s)
#pragma unroll
                for (int i = 0; i < 4; ++i) vz[s][i] = (ord == 0 ? xa[s][i] : xb[s][i]) * (acc[i][s] * inv + vz[s][i] * bias);
            asm volatile("" ::: "memory");
        }
#pragma unroll
        for (int s = 0; s < 2; ++s)
#pragma unroll
            for (int i = 0; i < 4; ++i) YH[((size_t)(c >> 3) * MT + (ML + (2 * bp + s) * CTXL + 4 * l + i)) * 8 + (c & 7)] = f2bf(vz[s][i]);
    }
    __syncthreads();
}

constexpr int HY_STR = 272, HY_STRD = 528;
constexpr int HY_IN = 0, HY_XG = 17408, HY_S1 = 34816, HY_S2 = 69632, HY_RED = 104448, HY_XG2 = 104512;
typedef float f32x4_ __attribute__((ext_vector_type(4)));

__device__ __forceinline__ bf16x8 ldfrag_lds(const LAS unsigned char* base, int row, int stride, int kbyte) { return *(const LAS bf16x8*)(base + row * stride + kbyte); }
__device__ __forceinline__ bf16x8 ldfrag_glb(const bf16* tab, int row, int ldk, int kel) { return *(const bf16x8*)(tab + (size_t)row * ldk + kel); }
__device__ __forceinline__ void st4_lds(LAS unsigned char* p, f32x4 v) { u32x2 w; w.x = pk2(v[0], v[1]); w.y = pk2(v[2], v[3]); *(LAS u32x2*)p = w; }
__device__ __forceinline__ f32x4 ld4_lds(const LAS unsigned char* p) { const u32x2 w = *(const LAS u32x2*)p; return (f32x4){bflo(w.x), bfhi(w.x), bflo(w.y), bfhi(w.y)}; }

template <int KS> struct TabFrag { bf16x8 re[KS], im[KS]; };
template <int KS>
__device__ __forceinline__ void load_tab(TabFrag<KS>& t, const bf16* tab, int trow_re, int trow_im, int ldk, int fr, int fq) {
#pragma unroll
    for (int ks = 0; ks < KS; ++ks) { t.re[ks] = ldfrag_glb(tab, trow_re + fr, ldk, ks * 32 + fq * 8); t.im[ks] = ldfrag_glb(tab, trow_im + fr, ldk, ks * 32 + fq * 8); }
}
template <int KS, int NIT, class Post>
__device__ __forceinline__ void stage_tq(const LAS unsigned char* pbase, int pstride, int prow0, const TabFrag<KS>& T, int fr, int fq, const Post& post) {
    const bf16x8 (&qre)[KS] = T.re; const bf16x8 (&qim)[KS] = T.im;
#pragma unroll 2
    for (int it = 0; it < NIT; ++it) {
        f32x4 are = (f32x4){0.f, 0.f, 0.f, 0.f}, aim = are;
#pragma unroll
        for (int ks = 0; ks < KS; ++ks) { const bf16x8 p = ldfrag_lds(pbase, prow0 + it * 16 + fr, pstride, ks * 64 + fq * 16);
            are = __builtin_amdgcn_mfma_f32_16x16x32_bf16(p, qre[ks], are, 0, 0, 0); aim = __builtin_amdgcn_mfma_f32_16x16x32_bf16(p, qim[ks], aim, 0, 0, 0); }
        post(it, are, aim);
    }
}
template <int KS, int NJT, class Post>
__device__ __forceinline__ void stage_tp(const LAS unsigned char* qbase, int qstride, int qrow0, const TabFrag<KS>& T, int fr, int fq, const Post& post) {
    const bf16x8 (&pre)[KS] = T.re; const bf16x8 (&pim)[KS] = T.im;
#pragma unroll 2
    for (int jt = 0; jt < NJT; ++jt) {
        f32x4 are = (f32x4){0.f, 0.f, 0.f, 0.f}, aim = are;
#pragma unroll
        for (int ks = 0; ks < KS; ++ks) { const bf16x8 q = ldfrag_lds(qbase, qrow0 + jt * 16 + fr, qstride, ks * 64 + fq * 16);
            are = __builtin_amdgcn_mfma_f32_16x16x32_bf16(pre[ks], q, are, 0, 0, 0); aim = __builtin_amdgcn_mfma_f32_16x16x32_bf16(pim[ks], q, aim, 0, 0, 0); }
        post(jt, are, aim);
    }
}
__device__ __forceinline__ void twid(int m, float& c, float& s) { const float fr_ = (float)(m & 8191) * (1.0f / 8192.0f); c = __builtin_amdgcn_cosf(fr_); s = __builtin_amdgcn_sinf(fr_); }

template <class PostB>
__device__ __forceinline__ void hy_forward(Frame& F, const TabFrag<4>& tabA, const TabFrag<4>& tabB, const PostB& post_b) {
    LAS unsigned char* lds = F.lds;
    const int w = F.wave, fr = F.lane & 15, fq = F.lane >> 4;
    {
        const int k1 = 16 * w + fr;
        auto post = [&](int it, f32x4 xr, f32x4 xi) {
            f32x4 orr, oi;
#pragma unroll
            for (int r = 0; r < 4; ++r) { const int n2 = it * 16 + 4 * fq + r; float c, s; twid(n2 * k1, c, s); orr[r] = xr[r] * c + xi[r] * s; oi[r] = xi[r] * c - xr[r] * s; }
            LAS unsigned char* o = lds + HY_S1 + k1 * HY_STR + (it * 16 + 4 * fq) * 2;
            st4_lds(o, orr); st4_lds(o + 128, oi);
        };
        stage_tq<4, 4>(lds + HY_IN, HY_STR, 0, tabA, fr, fq, post);
    }
    __syncthreads();
    {
        const int q = w & 3, h = w >> 2;
        stage_tp<4, 4>(lds + HY_S1, HY_STR, 64 * h, tabB, fr, fq, post_b);
    }
}
__device__ __forceinline__ bf16x8 negfrag(bf16x8 v, unsigned sgn) { u32x4 u = __builtin_bit_cast(u32x4, v); u.x ^= sgn; u.y ^= sgn; u.z ^= sgn; u.w ^= sgn; return __builtin_bit_cast(bf16x8, u); }
template <class PostD>
__device__ __forceinline__ void hy_inverse(Frame& F, const TabFrag<4>& tabB, const TabFrag<8>& tabD, const PostD& post_d) {
    LAS unsigned char* lds = F.lds;
    const int w = F.wave, fr = F.lane & 15, fq = F.lane >> 4, q = w & 3, h = w >> 2;
    {
        const int n2 = 16 * q + fr;
        auto post = [&](int it, f32x4 br, f32x4 bi) {
            f32x4 orr, oi; const int k10 = 64 * h + it * 16 + 4 * fq;
#pragma unroll
            for (int r = 0; r < 4; ++r) { float c, s; twid(n2 * (k10 + r), c, s); orr[r] = br[r] * c - bi[r] * s; oi[r] = br[r] * s + bi[r] * c; }
            LAS unsigned char* o = lds + HY_S1 + n2 * HY_STRD + k10 * 2;
            st4_lds(o, orr); st4_lds(o + 256, oi);
        };
        unsigned sgn = 0x80008000u; asm volatile("" : "+v"(sgn));
        TabFrag<4> tabC; tabC.re[0] = tabB.re[0]; tabC.re[1] = tabB.re[1]; tabC.re[2] = negfrag(tabB.re[2], sgn); tabC.re[3] = negfrag(tabB.re[3], sgn);
        tabC.im[0] = negfrag(tabB.im[0], sgn); tabC.im[1] = negfrag(tabB.im[1], sgn); tabC.im[2] = tabB.im[2]; tabC.im[3] = tabB.im[3];
        stage_tq<4, 4>(lds + HY_S2, HY_STR, 64 * h, tabC, fr, fq, post);
    }
    __syncthreads();
    stage_tp<8, 2>(lds + HY_S1, HY_STRD, 32 * h, tabD, fr, fq, post_d);
}

__device__ __forceinline__ void hy_kf_pass(Frame& F, int layer, int bid0) {
    if (F.bid < bid0) return;
    LAS unsigned char* lds = F.lds; LAS float* red = (LAS float*)(lds + HY_RED);
    const bf16* HF = WSP(bf16, WS_HFILT) + (size_t)layer * (4352 * 2048);
    TabFrag<4> tA, tB;
    { const int w_ = F.wave, fr_ = F.lane & 15, fq_ = F.lane >> 4; load_tab<4>(tA, WSP(bf16, WS_FT1F), 16 * w_, 128 + 16 * w_, 128, fr_, fq_); load_tab<4>(tB, WSP(bf16, WS_FT2), 16 * (w_ & 3), 64 + 16 * (w_ & 3), 128, fr_, fq_); }
    unsigned* KF = WSP(unsigned, WS_KF);
    for (int unit = F.bid - bid0; unit < 1024; unit += F.G - bid0) {
        const int c = unit >> 1, o = unit & 1;
        __syncthreads();
        float asum = 0.f;
        {
            const int t = F.tid;
            const u32x4 fw = *(const u32x4*)(HF + (size_t)(o * 1024 + c) * 4352 + 8 * t);
            const bf16* bcol = HF + (size_t)(o * 1024 + 512 + c) * 4352;
            const u32x4 b1 = *(const u32x4*)(bcol + 8 * t);
            const unsigned prev = t > 0 ? (unsigned)bcol[8 * t - 1] : 0u;
            u32x4 bw; bw.x = prev | (b1.x << 16); bw.y = (b1.x >> 16) | (b1.y << 16); bw.z = (b1.y >> 16) | (b1.z << 16); bw.w = (b1.z >> 16) | (b1.w << 16);
            const unsigned fwv[4] = {fw.x, fw.y, fw.z, fw.w}, bwv[4] = {bw.x, bw.y, bw.z, bw.w};
#pragma unroll
            for (int j = 0; j < 4; ++j) {
                const int n = 8 * t + 2 * j;
                asum += fabsf(bflo(fwv[j])) + fabsf(bfhi(fwv[j])) + fabsf(bflo(bwv[j])) + fabsf(bfhi(bwv[j]));
                *(LAS bf16*)(lds + HY_IN + (n & 63) * HY_STR + (n >> 6) * 2) = (bf16)(fwv[j] & 0xffffu); *(LAS bf16*)(lds + HY_IN + ((n + 1) & 63) * HY_STR + (n >> 6) * 2) = (bf16)(fwv[j] >> 16);
                *(LAS bf16*)(lds + HY_IN + (n & 63) * HY_STR + (64 + (n >> 6)) * 2) = (bf16)(bwv[j] & 0xffffu); *(LAS bf16*)(lds + HY_IN + ((n + 1) & 63) * HY_STR + (64 + (n >> 6)) * 2) = (bf16)(bwv[j] >> 16);
            }
        }
        const float inv = 1.0f / (block_sum(F, asum, red) * 8192.0f);
        unsigned* kfo = KF + (size_t)(c * 2 + o) * 8192;
        const int w = F.wave, lane = F.lane;
        auto post_b = [&](int jt, f32x4 zr, f32x4 zi) {
            u32x4 kw; kw.x = pk2(zr[0] * inv, zi[0] * inv); kw.y = pk2(zr[1] * inv, zi[1] * inv); kw.z = pk2(zr[2] * inv, zi[2] * inv); kw.w = pk2(zr[3] * inv, zi[3] * inv);
            *(u32x4*)(kfo + ((w * 4 + jt) * 64 + lane) * 4) = kw;
        };
        hy_forward(F, tA, tB, post_b);
    }
    __syncthreads();
}

__device__ __forceinline__ void hy_load_seq(Frame& F, const bf16* UT, int ch, int c3  , const float* cw, const float* cb, int b0, int dst_off) {
    const float w0 = cw[c3], w1 = cw[HYW + c3], w2 = cw[2 * HYW + c3], bb = cb[c3];
    const int t = F.tid, n1 = t >> 3, n2b = (8 * t) & 63;
#pragma unroll
    for (int s = 0; s < 2; ++s) {
        const bf16* u = UT + (size_t)ch * MT + (size_t)(b0 + s) * SEQ + 8 * t;
        const u32x4 wv = *(const u32x4*)u;
        float x[10];
        { const int ln = F.lane; const unsigned up = (unsigned)__builtin_amdgcn_ds_bpermute(((ln + 63) & 63) << 2, (int)(wv.w >> 16)), dn = (unsigned)__builtin_amdgcn_ds_bpermute(((ln + 1) & 63) << 2, (int)(wv.x & 0xffffu));
          x[0] = bflo(up); x[9] = bflo(dn);
          if (ln == 0) x[0] = t > 0 ? bf2f(u[-1]) : 0.f;
          if (ln == 63) x[9] = t < 511 ? bf2f(u[8]) : 0.f; }
        x[1] = bflo(wv.x); x[2] = bfhi(wv.x); x[3] = bflo(wv.y); x[4] = bfhi(wv.y); x[5] = bflo(wv.z); x[6] = bfhi(wv.z); x[7] = bflo(wv.w); x[8] = bfhi(wv.w);
#pragma unroll
        for (int j = 0; j < 8; ++j) { const float v = x[j] * w0 + x[j + 1] * w1 + x[j + 2] * w2 + bb;
            *(LAS bf16*)(F.lds + dst_off + (n2b + j) * HY_STR + (s * 64 + n1) * 2) = f2bf(v); }
    }
}
__device__ __forceinline__ void hyena_fft_phase(Frame& F, int layer, const float* convw, const float* convb, const float* hbias) {
    LAS unsigned char* lds = F.lds;
    const bf16* UT = WSP(bf16, WS_UT); bf16* YH = WSP(bf16, WS_YB) + (size_t)64 * MT * 8;
    TabFrag<4> tA, tB;
    const bf16* T4 = WSP(bf16, WS_FT4);
    { const int w_ = F.wave, fr_ = F.lane & 15, fq_ = F.lane >> 4, q_ = w_ & 3;
      load_tab<4>(tA, WSP(bf16, WS_FT1), 16 * w_, 128 + 16 * w_, 128, fr_, fq_); load_tab<4>(tB, WSP(bf16, WS_FT2), 16 * q_, 64 + 16 * q_, 128, fr_, fq_);
      }
    TabFrag<8> tabD;
    { const int q_ = F.wave & 3;
#pragma unroll
      for (int ks = 0; ks < 8; ++ks) { tabD.re[ks] = *(const bf16x8*)(T4 + ((size_t)((q_ * 2 + 0) * 8 + ks) * 64 + F.lane) * 8); tabD.im[ks] = *(const bf16x8*)(T4 + ((size_t)((q_ * 2 + 1) * 8 + ks) * 64 + F.lane) * 8); } }
    const unsigned* KF = WSP(unsigned, WS_KF);
    const float* cw = convw + (size_t)layer * 3 * HYW; const float* cb = convb + (size_t)layer * HYW;
    const float* hb = hbias + (size_t)layer * 2 * 512;
    for (int unit = F.bid; unit < 1024; unit += F.G) {
        const int c = unit >> 1, p = unit & 1, b0 = 2 * p;
        __syncthreads();
        hy_load_seq(F, UT, c, c, cw, cb, b0, HY_IN);
        hy_load_seq(F, UT, 512 + c, 512 + c, cw, cb, b0, HY_XG);
        hy_load_seq(F, UT, 1024 + c, 1024 + c, cw, cb, b0, HY_XG2);
        __syncthreads();
#pragma unroll 1
        for (int ord = 0; ord < 2; ++ord) {
            const unsigned* kf = KF + (size_t)(c * 2 + ord) * 8192;
            const int w = F.wave, lane = F.lane, fr = lane & 15, fq = lane >> 4, q = w & 3, h = w >> 2;
            u32x4 kfr[4];
#pragma unroll
            for (int jt = 0; jt < 4; ++jt) kfr[jt] = *(const u32x4*)(kf + ((w * 4 + jt) * 64 + lane) * 4);
            auto post_b = [&](int jt, f32x4 zr, f32x4 zi) {
                f32x4 yr, yi;
                const u32x4 kq = jt == 0 ? kfr[0] : jt == 1 ? kfr[1] : jt == 2 ? kfr[2] : kfr[3];
#pragma unroll
                for (int r = 0; r < 4; ++r) { const float kx = bflo(kq[r]), ky = bfhi(kq[r]); yr[r] = zr[r] * kx - zi[r] * ky; yi[r] = zr[r] * ky + zi[r] * kx; }
                LAS unsigned char* o = lds + HY_S2 + (64 * h + jt * 16 + fr) * HY_STR + (16 * q + 4 * fq) * 2;
                st4_lds(o, yr); st4_lds(o + 128, yi);
            };
            hy_forward(F, tA, tB, post_b);
            __syncthreads();
            const float bias = hb[ord * 512 + c];
            auto post_d = [&](int jt, f32x4 yr, f32x4 yi) {
                const int n2 = 32 * h + jt * 16 + fr, n10 = 16 * q + 4 * fq;
                LAS unsigned char* ip = lds + HY_IN + n2 * HY_STR + n10 * 2; const LAS unsigned char* xp = lds + (ord == 0 ? HY_XG : HY_XG2) + n2 * HY_STR + n10 * 2;
                const f32x4 vr = ld4_lds(ip), vi = ld4_lds(ip + 128), xr = ld4_lds(xp), xi = ld4_lds(xp + 128);
                const f32x4 orr = xr * (yr + vr * bias), oi = xi * (yi + vi * bias);
                if (ord == 0) { st4_lds(ip, orr); st4_lds(ip + 128, oi); }
                else {
#pragma unroll
                    for (int r = 0; r < 4; ++r) { const size_t tok = (size_t)b0 * SEQ + 64 * (n10 + r) + n2;
                        YH[((size_t)(c >> 3) * MT + tok) * 8 + (c & 7)] = f2bf(orr[r]); YH[((size_t)(c >> 3) * MT + tok + SEQ) * 8 + (c & 7)] = f2bf(oi[r]); }
                }
            };
            hy_inverse(F, tB, tabD, post_d);
            __syncthreads();
        }
    }
    __syncthreads();
}

constexpr int FO_SEQ = 34816, FO_S1 = 17408, FO_OUT = 69632;
template <int KS, int NJT, class Post>
__device__ __forceinline__ void stage_tp_re(const LAS unsigned char* qbase, int qstride, int qrow0, const bf16x8 (&pre)[KS], int fr, int fq, const Post& post) {
#pragma unroll 1
    for (int jt = 0; jt < NJT; ++jt) {
        f32x4 are = (f32x4){0.f, 0.f, 0.f, 0.f};
#pragma unroll
        for (int ks = 0; ks < KS; ++ks) { const bf16x8 q = ldfrag_lds(qbase, qrow0 + jt * 16 + fr, qstride, ks * 64 + fq * 16);
            are = __builtin_amdgcn_mfma_f32_16x16x32_bf16(pre[ks], q, are, 0, 0, 0); }
        post(jt, are);
    }
}
__device__ __forceinline__ void fourier_fft_phase(Frame& F) {
    LAS unsigned char* lds = F.lds;
    const bf16* FT = WSP(bf16, WS_FT); bf16* YM = WSP(bf16, WS_YM);
    const int w = F.wave, lane = F.lane, fr = lane & 15, fq = lane >> 4, wq = w & 3, s = w >> 2;
    TabFrag<4> tB; load_tab<4>(tB, WSP(bf16, WS_FT2), 16 * wq, 64 + 16 * wq, 128, fr, fq);
    LAS unsigned char* INs = lds + s * FO_SEQ; LAS unsigned char* S1s = INs + FO_S1;
    for (int unit = F.bid; unit < 256; unit += F.G) {
        const int b = unit >> 6, g = (unit >> 4) & 3, mb = unit & 15;
#pragma unroll 1
        for (int pass = 0; pass < 4; ++pass) {
            const int mloc = pass * 2 + s, mrow = g * 128 + mb * 8 + mloc;
            __syncthreads();
            {
                const int tp = F.tid & 255, n1 = tp >> 2, n2b = (16 * tp) & 63;
                const bf16* src = FT + ((size_t)b * 512 + mrow) * 8192 + 16 * tp;
#pragma unroll
                for (int part = 0; part < 2; ++part) {
                    const u32x4 v0 = *(const u32x4*)(src + part * 4096), v1 = *(const u32x4*)(src + part * 4096 + 8);
                    const unsigned sg = part ? 0x8000u : 0u;
                    LAS unsigned char* dst = INs + n2b * HY_STR + (part * 64 + n1) * 2;
                    const unsigned ww[8] = {v0.x, v0.y, v0.z, v0.w, v1.x, v1.y, v1.z, v1.w};
#pragma unroll
                    for (int j = 0; j < 8; ++j) { *(LAS bf16*)(dst + (2 * j) * HY_STR) = (bf16)((ww[j] & 0xffffu) ^ sg); *(LAS bf16*)(dst + (2 * j + 1) * HY_STR) = (bf16)((ww[j] >> 16) ^ sg); }
                }
            }
            __syncthreads();
            {
                const int k1 = 16 * wq + fr;
                auto post = [&](int it, f32x4 xr, f32x4 xi) {
                    f32x4 orr, oi;
#pragma unroll
                    for (int r = 0; r < 4; ++r) { const int n2 = it * 16 + 4 * fq + r; const float fr_ = (float)((n2 * k1) & 4095) * (1.0f / 4096.0f);
                        const float c = __builtin_amdgcn_cosf(fr_), sn = __builtin_amdgcn_sinf(fr_); orr[r] = xr[r] * c + xi[r] * sn; oi[r] = xi[r] * c - xr[r] * sn; }
                    LAS unsigned char* o = S1s + k1 * HY_STR + (it * 16 + 4 * fq) * 2;
                    st4_lds(o, orr); st4_lds(o + 128, oi);
                };
                stage_tq<4, 4>(INs, HY_STR, 0, tB, fr, fq, post);
            }
            __syncthreads();
            {
                auto post = [&](int jt, f32x4 zr) {
                    const int k1 = jt * 16 + fr;
#pragma unroll
                    for (int r = 0; r < 4; ++r) { const int k = k1 + 64 * (16 * wq + 4 * fq + r); *(LAS bf16*)(lds + FO_OUT + k * 16 + mloc * 2) = f2bf(zr[r] * 0.015625f); }
                };
                stage_tp_re<4, 4>(S1s, HY_STR, 0, tB.re, fr, fq, post);
            }
        }
        __syncthreads();
        bf16* dst = WSP(bf16, WS_YB) + ((size_t)(g * 16 + mb) * MT + (size_t)b * SEQ) * 8;
#pragma unroll
        for (int i = 0; i < 8; ++i) { const int k = F.tid + 512 * i; *(u32x4*)(dst + (size_t)k * 8) = *(const LAS u32x4*)(lds + FO_OUT + k * 16); }
    }
    __syncthreads();
}

constexpr int AT_STR = 144;
constexpr int AT_KS = 0, AT_VT = 64 * AT_STR, AT_QS = 2 * 64 * AT_STR;
__device__ __forceinline__ void attn_mfma_phase(Frame& F, const float* sink, int nunits) {
    LAS unsigned char* lds = F.lds;
    const bf16* QKV = WSP(bf16, WS_QKV); bf16* YA = WSP(bf16, WS_YM);
    const int w = F.wave, lane = F.lane, fr = lane & 15, fq = lane >> 4;
    const int g = w & 3, ph = w >> 2;
    const int nextra = nunits - 256;
    const int nlat = F.bid < 256 ? (256 - F.bid + F.G - 1) / F.G : 0;
    for (int kq = 0;; ++kq) {
        int unit;
        if (kq < nlat) unit = F.bid + kq * F.G;
        else { const int e = F.bid + (kq - nlat) * F.G; if (e >= nextra) break; unit = 256 + e; }
        int b, hkv, qb; const bool latent = unit < 256;
        if (latent) { b = unit >> 6; hkv = (unit >> 5) & 1; qb = unit & 31; } else { const int u2 = unit - 256; b = u2 >> 2; hkv = (u2 >> 1) & 1; qb = u2 & 1; }
        const int head = hkv * 4 + g;
        const int pos0 = qb * 128 + ph * 64;
        const int rowq0 = (latent ? b * SEQ : ML + b * CTXL) + pos0;
        __syncthreads();
        { LAS unsigned char* qs = lds + AT_QS + w * (64 * AT_STR) + lane * AT_STR; const u32x4* qp = (const u32x4*)(QKV + (size_t)(rowq0 + lane) * QKVW + head * 64);
#pragma unroll
          for (int i = 0; i < 8; ++i) *(LAS u32x4*)(qs + 16 * i) = qp[i]; }
        f32x4 oacc[4][4];
#pragma unroll
        for (int it = 0; it < 4; ++it)
#pragma unroll
            for (int dt = 0; dt < 4; ++dt) oacc[it][dt] = (f32x4){0.f, 0.f, 0.f, 0.f};
        float mrun[4], lrun[4];
#pragma unroll
        for (int it = 0; it < 4; ++it) { mrun[it] = -1e30f; lrun[it] = 0.f; }
        const int j0 = latent ? (qb * 128 - 128 < 0 ? 0 : qb * 128 - 128) : 0;
        const int j1 = latent ? (qb * 128 + 256 > SEQ ? SEQ : qb * 128 + 256) : 0;
        const int nband = (j1 - j0) >> 6;
        const int nblk = nband + 4;
        const int key = F.tid >> 3, d8 = (F.tid & 7) * 8, key2 = lane, dv = w * 8;
        const int vc = key2 >> 5, va = (key2 >> 4) & 1, vf_ = (key2 >> 2) & 3, vr = key2 & 3;
        u32x4 kreg, vreg;
        { const int krow0 = nband > 0 ? b * SEQ + j0 : ML + b * CTXL;
          kreg = *(const u32x4*)(QKV + (size_t)(krow0 + key) * QKVW + K_OFF + hkv * 64 + d8); vreg = *(const u32x4*)(QKV + (size_t)(krow0 + key2) * QKVW + V_OFF + hkv * 64 + dv); }
#pragma unroll 1
        for (int kb = 0; kb < nblk; ++kb) {
            const bool band = kb < nband;
            const int jbase = band ? j0 + kb * 64 : (kb - nband) * 64;
            __syncthreads();
            {
                *(LAS u32x4*)(lds + AT_KS + key * AT_STR + d8 * 2) = kreg;
                LAS unsigned char* vp = lds + AT_VT + dv * AT_STR + (32 * vc + 8 * vf_ + 4 * va + vr) * 2;
                *(LAS bf16*)(vp + 0 * AT_STR) = (bf16)(vreg.x & 0xffffu); *(LAS bf16*)(vp + 1 * AT_STR) = (bf16)(vreg.x >> 16);
                *(LAS bf16*)(vp + 2 * AT_STR) = (bf16)(vreg.y & 0xffffu); *(LAS bf16*)(vp + 3 * AT_STR) = (bf16)(vreg.y >> 16);
                *(LAS bf16*)(vp + 4 * AT_STR) = (bf16)(vreg.z & 0xffffu); *(LAS bf16*)(vp + 5 * AT_STR) = (bf16)(vreg.z >> 16);
                *(LAS bf16*)(vp + 6 * AT_STR) = (bf16)(vreg.w & 0xffffu); *(LAS bf16*)(vp + 7 * AT_STR) = (bf16)(vreg.w >> 16);
            }
            if (kb + 1 < nblk) { const int kn = kb + 1; const int jb2 = kn < nband ? j0 + kn * 64 : (kn - nband) * 64; const int krow2 = kn < nband ? b * SEQ + jb2 : ML + b * CTXL + jb2;
                kreg = *(const u32x4*)(QKV + (size_t)(krow2 + key) * QKVW + K_OFF + hkv * 64 + d8); vreg = *(const u32x4*)(QKV + (size_t)(krow2 + key2) * QKVW + V_OFF + hkv * 64 + dv); }
            __syncthreads();
            bf16x8 kf[4][2], vf[4][2];
#pragma unroll
            for (int kt = 0; kt < 4; ++kt)
#pragma unroll
                for (int ks = 0; ks < 2; ++ks) kf[kt][ks] = *(const LAS bf16x8*)(lds + AT_KS + (kt * 16 + fr) * AT_STR + ks * 64 + fq * 16);
#pragma unroll
            for (int dt = 0; dt < 4; ++dt)
#pragma unroll
                for (int c = 0; c < 2; ++c) vf[dt][c] = *(const LAS bf16x8*)(lds + AT_VT + (dt * 16 + fr) * AT_STR + c * 64 + fq * 16);
            const bool allvalid = !band || ((pos0 + 63 - jbase <= 128) && (jbase + 63 - pos0 <= 128));
            const bool allmasked = band && ((pos0 - (jbase + 63) > 128) || (jbase - (pos0 + 63) > 128));
            if (!allmasked)
#pragma unroll
            for (int it = 0; it < 4; ++it) {
                asm volatile("" ::: "memory");
                bf16x8 qf0 = *(const LAS bf16x8*)(lds + AT_QS + w * (64 * AT_STR) + (it * 16 + fr) * AT_STR + fq * 16), qf1 = *(const LAS bf16x8*)(lds + AT_QS + w * (64 * AT_STR) + (it * 16 + fr) * AT_STR + 64 + fq * 16);
                f32x4 s[4];
#pragma unroll
                for (int kt = 0; kt < 4; ++kt) { s[kt] = (f32x4){0.f, 0.f, 0.f, 0.f};
                    s[kt] = __builtin_amdgcn_mfma_f32_16x16x32_bf16(kf[kt][0], qf0, s[kt], 0, 0, 0); s[kt] = __builtin_amdgcn_mfma_f32_16x16x32_bf16(kf[kt][1], qf1, s[kt], 0, 0, 0); }
                const int ipos = pos0 + it * 16 + fr;
                if (!allvalid) {
#pragma unroll
                    for (int kt = 0; kt < 4; ++kt)
#pragma unroll
                        for (int r = 0; r < 4; ++r) { const int dd = ipos - (jbase + kt * 16 + 4 * fq + r); s[kt][r] = (dd <= 128 && dd >= -128) ? s[kt][r] : -1e30f; }
                }
                float mt = -1e30f;
#pragma unroll
                for (int kt = 0; kt < 4; ++kt)
#pragma unroll
                    for (int r = 0; r < 4; ++r) mt = fmaxf(mt, s[kt][r]);
                mt = fmaxf(mt, shx(mt, 16, lane)); mt = fmaxf(mt, shx(mt, 32, lane));
                const float mnew = fmaxf(mrun[it], mt);
                const bool grow = __builtin_amdgcn_ballot_w64(mnew > mrun[it]) != 0ull;
                if (grow) { const float corr = __builtin_amdgcn_exp2f(mrun[it] - mnew); lrun[it] *= corr; mrun[it] = mnew;
#pragma unroll
                    for (int dt = 0; dt < 4; ++dt) oacc[it][dt] = oacc[it][dt] * corr; }
                const float msafe = fmaxf(mrun[it], -1e20f);
                float ps = 0.f;
#pragma unroll
                for (int kt = 0; kt < 4; ++kt)
#pragma unroll
                    for (int r = 0; r < 4; ++r) { const float p = __builtin_amdgcn_exp2f(s[kt][r] - msafe); s[kt][r] = p; ps += p; }
                lrun[it] += ps;
                bf16x8 pf[2];
#pragma unroll
                for (int c = 0; c < 2; ++c) { u32x4 pw; pw.x = pk2(s[2 * c][0], s[2 * c][1]); pw.y = pk2(s[2 * c][2], s[2 * c][3]); pw.z = pk2(s[2 * c + 1][0], s[2 * c + 1][1]); pw.w = pk2(s[2 * c + 1][2], s[2 * c + 1][3]);
                    pf[c] = __builtin_bit_cast(bf16x8, pw); }
#pragma unroll
                for (int dt = 0; dt < 4; ++dt)
#pragma unroll
                    for (int c = 0; c < 2; ++c) oacc[it][dt] = __builtin_amdgcn_mfma_f32_16x16x32_bf16(vf[dt][c], pf[c], oacc[it][dt], 0, 0, 0);
            }
        }
        const float sk = sink[head] * 1.44269504f;
#pragma unroll
        for (int it = 0; it < 4; ++it) {
            float lt = lrun[it]; lt += shx(lt, 16, lane); lt += shx(lt, 32, lane);
            const float mf = fmaxf(mrun[it], sk); const float cf = __builtin_amdgcn_exp2f(mrun[it] - mf);
            const float sc = cf / (lt * cf + __builtin_amdgcn_exp2f(sk - mf));
            bf16* op = YA + (size_t)(rowq0 + it * 16 + fr) * YMW + head * 64 + 4 * fq;
#pragma unroll
            for (int dt = 0; dt < 4; ++dt) { const f32x4 v = oacc[it][dt] * sc; u32x2 ww; ww.x = pk2(v[0], v[1]); ww.y = pk2(v[2], v[3]); *(u32x2*)(op + dt * 16) = ww; }
        }
    }
    __syncthreads();
}

constexpr int PH_PER_LAYER = 9, PH_L0 = 2, N_PHASES = 3 + DEPTH * PH_PER_LAYER;
struct Args { const float* in[29]; float* out; unsigned char* ws; int ph_lo, ph_hi; };

__global__ void __launch_bounds__(NTHR, 2) fwd_kernel(Args args) {
    extern __shared__ __attribute__((aligned(16))) unsigned char lds_raw[];
    Frame F;
    F.lds = (LAS unsigned char*)lds_raw;
    F.tid = threadIdx.x; F.lane = F.tid & 63; F.wave = __builtin_amdgcn_readfirstlane(F.tid >> 6);
    F.G = gridDim.x; F.bid = blockIdx.x;
    F.out = args.out; F.ws = (GAS unsigned char*)args.ws;
    volatile LAS unsigned* MISC = (volatile LAS unsigned*)(F.lds + MISC_OFF);
    if (F.tid < 64) MISC[F.tid] = 0u;
    __syncthreads();
    const int lo = args.ph_lo, hi = args.ph_hi;
    int zero = 0;
#ifndef DBL_SEL
#define DBL_SEL -1
#endif
#define RPT(x) for (int rp_ = 0; rp_ < ((DBL_SEL == (x)) ? 2 : 1); ++rp_)
#define PHASE_BEGIN() do { int zv_ = 0; asm volatile("" : "+v"(zv_)); asm volatile("" : "+s"(F.ws), "+s"(F.G), "+s"(F.bid), "+s"(zero), "+s"(F.wave)); F.lane = __builtin_amdgcn_mbcnt_hi(~0u, __builtin_amdgcn_mbcnt_lo(~0u, zv_)); F.tid = F.wave * 64 + F.lane; } while (0)
#define AIN(i) ((const float*)(const GAS float*)args.in[(i) + zero])
    XcdBarrier bar; bar.bar = (unsigned*)(args.ws + WS_CTL) + CW_BAR; bar.x = 0; bar.st = nullptr;
    if (hi - lo > 1) bar = xcd_barrier_post((unsigned*)(args.ws + WS_CTL) + CW_BAR, MISC);
#define IN(k) (lo <= (k) && (k) < hi)
#define SEAM(k) do { if (IN(k) && IN((k) + 1)) xcd_barrier(bar); } while (0)
#define ring (F.lds)

#ifndef EN_MASK
#define EN_MASK 0xFFFFFFFF
#endif
#define EN(b) ((EN_MASK >> (b)) & 1)
    if (EN(0) && IN(0)) {
        RPT(0) {
        PHASE_BEGIN();
        RPT(20) pro_copy_x(F, AIN(IN_X), AIN(IN_CTX));
        RPT(21) { pro_weights(F, AIN(IN_WIN), AIN(IN_WBA), AIN(IN_WBF), AIN(IN_WBH), AIN(IN_WOUT), AIN(IN_FW3));
        __syncthreads(); }
        RPT(22) pro_fold(F, AIN(IN_WIN));
        RPT(23) pro_mods(F, AIN(IN_C), AIN(IN_CCTX), AIN(IN_WMOD), AIN(IN_BMOD));
        RPT(24) pro_tables(F);
        RPT(25) pro_hid(F, AIN(IN_FW1), AIN(IN_FB1), AIN(IN_FFREQ), AIN(IN_FW2), AIN(IN_FB2));
        }
    }
    SEAM(0);
    if (EN(0) && IN(1)) RPT(26) { PHASE_BEGIN(); pro_filt2(F); }
    SEAM(1);

    for (int l = 0; l < DEPTH; ++l) {
        const int pb = PH_L0 + l * PH_PER_LAYER;
        const bool lastl = (l == DEPTH - 1);
        const int nMt = lastl ? ML / 256 : MT / 256;
#define wl ((unsigned char*)(F.ws + WS_W + (size_t)l * WL_SIZE))
#define modsL (WSP(float, WS_MODS) + (size_t)l * 5 * (NMOD * D))
        if (EN(1) && IN(pb + 0)) {
            PHASE_BEGIN();
            if (l == 0) RPT(1) norm_rows<false, 0>(F, AIN(IN_NMIX) + (size_t)l * D, modsL, 0, nullptr);
            else norm_rows<true, 0>(F, AIN(IN_NMIX) + (size_t)l * D, modsL, 0, modsL - 5 * (NMOD * D));
            __syncthreads();
            constexpr int CV_SPLIT = 12288;
            RPT(2) { conv_experts(F, l, AIN(IN_WEG), AIN(IN_WEU), AIN(IN_WED), l == 0 ? 0 : CV_SPLIT, NEXP * 3 * 512, 0);
            __syncthreads(); }
            PHASE_BEGIN();
            if (l == 0) RPT(3) hy_kf_pass(F, l, 0);
        }
        SEAM(pb + 0);
        if (EN(2) && IN(pb + 1)) {
            RPT(4) {
            PHASE_BEGIN();
            { pg8::GridOrder<1> S; S.init(WSP(unsigned char, WS_HN8), wl + WL_G8, (size_t)256 * D, (size_t)256 * D, nMt, GW / 256, F.G, F.bid);
              EpiGates E{WSP(unsigned char, WS_G)};
              pg8::gemm_phase<EpiGates, pg8::GridOrder<1>, true>(F.tid, ring, pg8::Shape{D, D, D, E8_ACT, E8_W, WSP(char, WS_HN8), wl + WL_G8}, S, E); }
            PHASE_BEGIN();
            { pg8::GridOrder<1> S; S.init(WSP(bf16, WS_HN), wl + WL_QKVG, (size_t)256 * D * 2, (size_t)256 * D * 2, nMt, QKVW / 256, F.G, (F.bid + 156) % F.G, lastl ? MC / 256 : 0, ML / 256, 2);
              EpiQKVG E{WSP(bf16, WS_QKV), WSP(float, WS_ROPE)};
              pg8::gemm_phase(F.tid, ring, pg8::Shape{D, D, D, 0, 0, WSP(char, WS_HN), wl + WL_QKVG}, S, E); }
            PHASE_BEGIN();
            { FtOrder S{(const char*)(wl + WL_F), (const char*)WSP(bf16, WS_HN), F.G, (F.bid + 56) % F.G, nMt};
              EpiStore E{WSP(bf16, WS_FT), WSP(bf16, WS_FTC), 8192, 512};
              pg8::gemm_phase<EpiStore, FtOrder, false, true>(F.tid, ring, pg8::Shape{D, D, D, 0, 0, wl + WL_F, WSP(char, WS_HN)}, S, E); }
            PHASE_BEGIN();
            { pg8::GridOrder<256> S; S.init(wl + WL_H, WSP(bf16, WS_HN), (size_t)256 * D * 2, (size_t)256 * D * 2, HYW / 256, nMt, F.G, (F.bid + 208) % F.G);
              EpiStore E{WSP(bf16, WS_UT), WSP(bf16, WS_UT), MT, MT};
              pg8::gemm_phase<EpiStore, pg8::GridOrder<256>, false, true>(F.tid, ring, pg8::Shape{D, D, D, 0, 0, wl + WL_H, WSP(char, WS_HN)}, S, E); }
            }
        }
        SEAM(pb + 1);
        if (IN(pb + 2)) {
            PHASE_BEGIN();
            RPT(5) { PHASE_BEGIN(); if (EN(3)) attn_mfma_phase(F, AIN(IN_SINK) + l * NQH, lastl ? 256 : 272); }
            RPT(6) if (EN(4)) {
            PHASE_BEGIN();
            fourier_fft_phase(F);
            PHASE_BEGIN();
            if (!lastl) { FourierCtxOrder S{(const char*)WSP(bf16, WS_TC), (const char*)WSP(bf16, WS_FTC), F.G, F.bid};
              EpiStoreBlk E{WSP(bf16, WS_YB)};
              pg8::gemm_phase<EpiStoreBlk, FourierCtxOrder, false, true>(F.tid, ring, pg8::Shape{512, 512, 512, 0, 0, WSP(char, WS_TC), WSP(char, WS_FTC)}, S, E); }
            }
            __syncthreads();
            PHASE_BEGIN();
            if (EN(5)) { RPT(7) { PHASE_BEGIN(); hyena_fft_phase(F, l, AIN(IN_CONVW), AIN(IN_CONVB), AIN(IN_HBIAS)); } RPT(8) if (!lastl) { PHASE_BEGIN(); hyena_ctx_phase(F, l, AIN(IN_CONVW), AIN(IN_CONVB), AIN(IN_HBIAS)); } }
        }
        SEAM(pb + 2);
        if (EN(6) && IN(pb + 3)) {
            RPT(9) {
            PHASE_BEGIN();
            pg8::GridOrder<1> S; S.init(WSP(bf16, WS_YM), wl + WL_BA, (size_t)256 * YMW * 2, (size_t)256 * YMW * 2, nMt, D / 256, F.G, F.bid);
            EpiBranch E{WSP(unsigned char, WS_G), WSP(bf16, WS_MB)};
            pg8::gemm_phase<EpiBranch, pg8::GridOrder<1>, false, false, 8>(F.tid, ring, pg8::Shape{YMW, YMW, YMW, 0, 0, WSP(char, WS_YM), wl + WL_BA, (unsigned)(WS_YB - WS_YM)}, S, E);
            }
            if (!lastl) { PHASE_BEGIN(); __syncthreads(); hy_kf_pass(F, l + 1, 16); }
        }
        SEAM(pb + 3);
        if (EN(7) && IN(pb + 4)) {
            PHASE_BEGIN();
            pg8::GridOrder<1> S; S.init(WSP(bf16, WS_MB), wl + WL_OUT, (size_t)256 * D * 2, (size_t)256 * D * 2, nMt, D / 256, F.G, F.bid);
            EpiResid E{WSP(bf16, WS_X), modsL + 2 * D, WSP(float, WS_SSQ)};
            pg8::gemm_phase(F.tid, ring, pg8::Shape{D, D, D, 0, 0, WSP(char, WS_MB), wl + WL_OUT}, S, E);
            if (!lastl) { PHASE_BEGIN(); __syncthreads(); conv_experts(F, l + 1, AIN(IN_WEG), AIN(IN_WEU), AIN(IN_WED), 0, 12288, 16); __syncthreads(); }
        }
        SEAM(pb + 4);
        if (EN(8) && IN(pb + 5)) RPT(10) { PHASE_BEGIN(); norm_route(F, AIN(IN_NFFN) + (size_t)l * D, modsL, AIN(IN_WROUTER), AIN(IN_BROUTER), lastl ? ML : MT); }
        SEAM(pb + 5);
        if (EN(9) && IN(pb + 6)) RPT(11) { PHASE_BEGIN(); moe_scatter(F, lastl ? ML : MT); }
        SEAM(pb + 6);
        if (EN(10) && IN(pb + 7)) RPT(12) {
            PHASE_BEGIN();
            __syncthreads();
            if (F.tid < 17) MISC[16 + F.tid] = (unsigned)WSP(int, WS_TILEINFO)[F.tid];
            __syncthreads();
            MoeOrder<8, 1, 1> S{(const volatile LAS int*)(MISC + 16), (const char*)WSP(char, WS_XS), (const char*)WSP(char, WS_WEXP + WE_GU) + (size_t)(l & 1) * WE_BUF, (size_t)2048 * D, F.G, F.bid};
            EpiGateUp E{WSP(unsigned char, WS_HM)};
            pg8::gemm_phase<EpiGateUp, MoeOrder<8, 1, 1>, true>(F.tid, ring, pg8::Shape{D, D, D, E8_ACT, E8_W, WSP(char, WS_XS), WSP(char, WS_WEXP + WE_GU) + (size_t)(l & 1) * WE_BUF}, S, E);
        }
        SEAM(pb + 7);
        if (EN(11) && IN(pb + 8)) RPT(13) {
            PHASE_BEGIN();
            __syncthreads();
            if (F.tid < 17) MISC[16 + F.tid] = (unsigned)WSP(int, WS_TILEINFO)[F.tid];
            __syncthreads();
            MoeOrder<4, 256, 1> S{(const volatile LAS int*)(MISC + 16), (const char*)WSP(char, WS_HM), (const char*)WSP(char, WS_WEXP + WE_D) + (size_t)(l & 1) * WE_BUF, (size_t)D * FF, F.G, F.bid};
            EpiStore E{WSP(bf16, WS_Y), WSP(bf16, WS_Y), D, D};
            pg8::gemm_phase<EpiStore, MoeOrder<4, 256, 1>, true>(F.tid, ring, pg8::Shape{FF, FF, FF, E8_HM, E8_W, WSP(char, WS_HM), WSP(char, WS_WEXP + WE_D) + (size_t)(l & 1) * WE_BUF}, S, E);
        }
        SEAM(pb + 8);
    }
    if (EN(12) && IN(N_PHASES - 1)) { PHASE_BEGIN(); norm_rows<true, 1>(F, AIN(IN_NFINAL), nullptr, 0, WSP(float, WS_MODS) + (size_t)(DEPTH - 1) * 5 * (NMOD * D)); }
#undef IN
#undef SEAM
}

#ifndef N_LAUNCH_MODE
#define N_LAUNCH_MODE 1
#endif
extern "C" void kernel_launch(void* const* d_in, const int* in_sizes, int n_in, void* d_out, int out_size, void* d_ws, size_t ws_size, hipStream_t stream) {
    static int grid = 0;
    if (grid == 0) {
        if (n_in != 29 || out_size != ML * D || ws_size < WS_END) { fprintf(stderr, "kernel_launch: unexpected shapes (n_in %d out %d ws %zu need %zu)\n", n_in, out_size, ws_size, (size_t)WS_END); grid = -1; return; }
        int dev = 0, cus = 0, per_cu = 0;
        if (hipGetDevice(&dev) != hipSuccess || hipDeviceGetAttribute(&cus, hipDeviceAttributeMultiprocessorCount, dev) != hipSuccess) { grid = -1; return; }
        if (hipFuncSetAttribute((const void*)fwd_kernel, hipFuncAttributeMaxDynamicSharedMemorySize, LDS_BYTES) != hipSuccess) { fprintf(stderr, "kernel_launch: hipFuncSetAttribute failed\n"); grid = -1; return; }
        if (hipOccupancyMaxActiveBlocksPerMultiprocessor(&per_cu, (const void*)fwd_kernel, NTHR, LDS_BYTES) != hipSuccess || per_cu < 1) { fprintf(stderr, "kernel_launch: occupancy query reports %d\n", per_cu); }
        (void)hipGetLastError();
        grid = cus;
        if (grid > 1024) grid = 1024;
    }
    if (grid < 0) return;
    (void)hipMemsetAsync((char*)d_ws + WS_CTL, 0, CTL_ZERO_BYTES, stream);
    Args a{};
    for (int i = 0; i < 29; ++i) a.in[i] = (const float*)d_in[i];
    a.out = (float*)d_out; a.ws = (unsigned char*)d_ws;
#if N_LAUNCH_MODE == 1
    a.ph_lo = 0; a.ph_hi = N_PHASES;
    hipLaunchKernelGGL(fwd_kernel, dim3(grid), dim3(NTHR), LDS_BYTES, stream, a);
#else
    for (int p = 0; p < N_PHASES; ++p) { a.ph_lo = p; a.ph_hi = p + 1; hipLaunchKernelGGL(fwd_kernel, dim3(grid), dim3(NTHR), LDS_BYTES, stream, a); }
#endif
}
```

```cpp
#include <hip/hip_runtime.h>
#include <cstdio>
#include <cstdint>

#define GAS __attribute__((address_space(1)))
#define LAS __attribute__((address_space(3)))
typedef unsigned short bf16;
typedef float f32x4 __attribute__((ext_vector_type(4)));
typedef float f32x2 __attribute__((ext_vector_type(2)));
typedef short bf16x8 __attribute__((ext_vector_type(8)));
typedef unsigned u32x4 __attribute__((ext_vector_type(4)));
typedef unsigned u32x2 __attribute__((ext_vector_type(2)));

constexpr int D = 1024, NB = 4, SEQ = 4096, DEPTH = 4, CTXL = 256, GRIDW = 64;
constexpr int ML = NB * SEQ, MC = NB * CTXL, MT = ML + MC;
constexpr int HD = 64, NQH = 8, NKVH = 2;
constexpr int K_OFF = 512, V_OFF = 640, F_OFF = 768, H_OFF = 1280, G_OFF = 2816, INW = 5888;
constexpr int NEXP = 16, FF = 1024;
constexpr int NMOD = 6;
constexpr int NWAVES = 8, NTHR = 512;
constexpr float EPS = 1e-6f;
constexpr int QKVW = 768;
constexpr int GW = 3072;
constexpr int NQKVG = QKVW + GW;
constexpr int HYW = 1536;
constexpr int XS_ROWS = 39168;

constexpr size_t MiB = 1u << 20;
constexpr size_t WS_CTL = 0, CTL_ZERO_BYTES = 1 * MiB;
constexpr size_t WS_MODS = 1 * MiB;
constexpr size_t WS_ROPE = WS_MODS + 512 * 1024;
constexpr size_t WS_ROUTE = 2 * MiB;
constexpr size_t WS_SLOT = WS_ROUTE + 320 * 1024;
constexpr size_t WS_WGCNT = WS_SLOT + 192 * 1024;
constexpr size_t WS_TILEINFO = WS_WGCNT + 64 * 1024;
constexpr size_t WS_TC = 3 * MiB;
constexpr size_t WS_FT1 = WS_TC + 256 * 1024;
constexpr size_t WS_FT1F = WS_FT1 + 65536, WS_FT2 = WS_FT1F + 65536, WS_FT3 = WS_FT2 + 32768, WS_FT4 = WS_FT3 + 32768;
static_assert(WS_FT4 + 65536 <= 4 * MiB, "tables");
constexpr size_t WS_W = 4 * MiB;
constexpr size_t WL_QKVG = 0;
constexpr size_t WL_G8 = (size_t)QKVW * D * 2;
constexpr size_t WL_F = WL_QKVG + (size_t)NQKVG * D * 2;
constexpr size_t WL_H = WL_F + (size_t)1024 * D * 2;
constexpr size_t WL_BA = WL_H + (size_t)HYW * D * 2;
constexpr size_t WL_BF = WL_BA + (size_t)D * 512 * 2;
constexpr size_t WL_BH = WL_BF + (size_t)D * 512 * 2;
constexpr size_t WL_OUT = WL_BH + (size_t)D * 512 * 2;
constexpr size_t WL_SIZE = WL_OUT + (size_t)D * D * 2;
constexpr size_t WS_WEXP = WS_W + DEPTH * WL_SIZE;
constexpr size_t WE_GU = 0;
constexpr size_t WE_D = (size_t)NEXP * 2048 * D;
constexpr size_t WE_BUF = WE_D + (size_t)NEXP * D * FF;
constexpr size_t WE_SIZE = 2 * WE_BUF;
constexpr size_t WS_TDFT = WS_WEXP + WE_SIZE;
constexpr size_t WS_HID = WS_TDFT;
constexpr size_t WS_W3T = WS_HID + 4 * MiB;
constexpr size_t WS_HFILT = WS_TDFT + (size_t)4096 * 8192 * 2;
constexpr size_t HF_LAYER = (size_t)4352 * 2048 * 4;
constexpr size_t WS_X = WS_HFILT + DEPTH * HF_LAYER;
constexpr size_t WS_HN = WS_X + (size_t)MT * D * 4;
constexpr size_t WS_U = WS_HN + (size_t)MT * D * 2;
constexpr size_t WS_QKV = WS_U;
constexpr size_t WS_G = WS_QKV + (size_t)MT * QKVW * 2;
constexpr size_t WS_FT = WS_G + (size_t)MT * GW * 2;
constexpr size_t WS_FTC = WS_FT + (size_t)NB * 512 * 8192 * 2;
constexpr size_t WS_UT = WS_FTC + (size_t)NB * 512 * 512 * 2;
constexpr size_t WS_YA = WS_UT + (size_t)HYW * MT * 2;
constexpr size_t WS_YM = WS_YA; constexpr int YMW = 1536;
constexpr size_t WS_YF = WS_YA + (size_t)MT * 512 * 2;
constexpr size_t WS_YH = WS_YF + (size_t)MT * 512 * 2;
constexpr size_t WS_MF = WS_YH + (size_t)MT * 512 * 2;
constexpr size_t WS_MB = WS_MF + (size_t)MT * D * 4;
constexpr size_t WS_MIX_END = WS_MB + (size_t)MT * D * 2;
constexpr size_t WS_XS = WS_U;
constexpr size_t WS_HM = WS_XS + (size_t)XS_ROWS * D * 2;
constexpr size_t WS_Y = WS_HM + (size_t)XS_ROWS * D * 2;
constexpr size_t WS_MOE_END = WS_Y + (size_t)XS_ROWS * D * 2;
constexpr size_t WS_KF = WS_MIX_END > WS_MOE_END ? WS_MIX_END : WS_MOE_END;
constexpr size_t WS_SSQ = WS_KF + (size_t)512 * 2 * 8192 * 8;
constexpr size_t WS_HN8 = WS_SSQ + (size_t)MT * 16 * 4;
constexpr size_t WS_YB = WS_HN8 + (size_t)MT * D;
constexpr size_t WS_END = WS_YB + (size_t)128 * MT * 16;

constexpr int CW_BAR = 4096;

constexpr int RING_BYTES = 131072;
constexpr int LDS_BYTES = 147456;
constexpr int MISC_OFF = LDS_BYTES - 256;

__device__ __forceinline__ unsigned pk2(float lo, float hi) { unsigned r; asm("v_cvt_pk_bf16_f32 %0, %1, %2" : "=v"(r) : "v"(lo), "v"(hi)); return r; }
__device__ __forceinline__ float bflo(unsigned u) { return __uint_as_float(u << 16); }
__device__ __forceinline__ float bfhi(unsigned u) { return __uint_as_float(u & 0xffff0000u); }
__device__ __forceinline__ float bf2f(bf16 b) { return __uint_as_float(((unsigned)b) << 16); }
__device__ __forceinline__ bf16 f2bf(float f) { return (bf16)(pk2(f, 0.f) & 0xffffu); }
__device__ __forceinline__ float shx(float v, int o, int lane) {
    const unsigned u = __float_as_uint(v);
    if (o == 16) { const auto r = __builtin_amdgcn_permlane16_swap(u, u, false, false); return __uint_as_float((lane & 16) ? r[0] : r[1]); }
    const auto r = __builtin_amdgcn_permlane32_swap(u, u, false, false); return __uint_as_float((lane & 32) ? r[0] : r[1]);
}
__device__ __forceinline__ float rdlane(float v, int i) { return __int_as_float(__builtin_amdgcn_readlane(__float_as_int(v), i)); }
#define DPP_ADD(v, ctrl) ((v) + __int_as_float(__builtin_amdgcn_update_dpp(0, __float_as_int(v), (ctrl), 0xF, 0xF, false)))
__device__ __forceinline__ float wave_sum(float v, int lane) {
    v = DPP_ADD(v, 0xB1); v = DPP_ADD(v, 0x4E); v = DPP_ADD(v, 0x141); v = DPP_ADD(v, 0x140);
    v += shx(v, 16, lane); v += shx(v, 32, lane);
    return v;
}
#define LDS_WAIT() asm volatile("s_waitcnt lgkmcnt(0)" ::: "memory")
#define VM_WAIT() asm volatile("s_waitcnt vmcnt(0)" ::: "memory")
__device__ __forceinline__ unsigned pk4_fp8(float a, float b, float c, float d) { int w = 0; w = __builtin_amdgcn_cvt_pk_fp8_f32(a, b, w, false); w = __builtin_amdgcn_cvt_pk_fp8_f32(c, d, w, true); return (unsigned)w; }
constexpr float FP8_ACT_SCALE = 8.0f, FP8_HM_SCALE = 8.0f, FP8_W_SCALE = 32.0f;
constexpr int E8_ACT = 0x7B7B7B7B, E8_HM = 0x7B7B7B7B, E8_W = 0x7B7B7B7B;
__device__ __forceinline__ float sigmoidf_(float x) { return __builtin_amdgcn_rcpf(1.0f + __expf(-x)); }

#define XB_TMO      128
#define XB_XCNT(j)  (256  + 64 * (j))
#define XB_XSUB(j)  (1280 + 64 * (j))
#define XB_XGEN(j)  (2304 + 64 * (j))
#define XB_TOP      3328
#define XB_TOPGEN   3392
#define XCD_BAR_WORDS 3456
#define XB_SPIN_CAP (1u << 23)

__device__ __forceinline__ unsigned xb_ld(unsigned* p)              { return __hip_atomic_load(p, __ATOMIC_RELAXED, __HIP_MEMORY_SCOPE_AGENT); }
__device__ __forceinline__ unsigned xb_add(unsigned* p, unsigned v) { return __hip_atomic_fetch_add(p, v, __ATOMIC_RELAXED, __HIP_MEMORY_SCOPE_AGENT); }
__device__ __forceinline__ unsigned xb_xcc_id() { return (unsigned)__builtin_amdgcn_s_getreg((3 << 11) | 20) & 0xFu; }
#define XB_SPIN(cond, bar) do { unsigned _sp = 0; while (cond) { __builtin_amdgcn_s_sleep(1); \
    if ((++_sp & 255u) == 0u) { if (xb_ld(&(bar)[XB_TMO])) break; if (_sp > XB_SPIN_CAP) { atomicAdd(&(bar)[XB_TMO], 1u); break; } } } } while (0)

struct XcdBarrier {
    unsigned* bar; unsigned x;
    volatile LAS unsigned* st;
};

__device__ __forceinline__ XcdBarrier xcd_barrier_post(unsigned* bar, volatile LAS unsigned* st) {
    XcdBarrier b; b.bar = bar; b.x = xb_xcc_id(); b.st = st;
    if (threadIdx.x == 0) (void)xb_add(&bar[XB_XCNT(b.x)], 1u);
    return b;
}
__device__ __forceinline__ void xcd_barrier_complete(unsigned* bar, unsigned x, unsigned& nloc, unsigned& nx) {
    const unsigned G = gridDim.x * gridDim.y * gridDim.z;
    unsigned sum, cnt, mine, sp = 0u;
    for (;;) {
        sum = 0u; cnt = 0u; mine = 0u;
#pragma unroll
        for (unsigned j = 0; j < 16; ++j) { const unsigned c = xb_ld(&bar[XB_XCNT(j)]); sum += c; cnt += (c > 0u) ? 1u : 0u; mine = (j == x) ? c : mine; }
        if (sum == G) break;
        __builtin_amdgcn_s_sleep(1);
        if ((++sp & 255u) == 0u) { if (xb_ld(&bar[XB_TMO])) break; if (sp > XB_SPIN_CAP) { atomicAdd(&bar[XB_TMO], 1u); break; } }
    }
    nloc = mine > 0u ? mine : 1u; nx = cnt > 0u ? cnt : 1u;
}

__device__ __forceinline__ void xcd_barrier(const XcdBarrier& b) {
    asm volatile("s_waitcnt vmcnt(0)" ::: "memory");
    __syncthreads();
    if (threadIdx.x == 0) {
        unsigned* bar = b.bar;
        __builtin_amdgcn_s_waitcnt(0);
        unsigned nloc = b.st[0], nx = b.st[1];
        if (nloc == 0u) { xcd_barrier_complete(bar, b.x, nloc, nx); b.st[0] = nloc; b.st[1] = nx; }
        const unsigned old = xb_add(&bar[XB_XSUB(b.x)], 1u);
        const unsigned gen = old / nloc;
        if (old + 1u == (gen + 1u) * nloc) {
            __builtin_amdgcn_fence(__ATOMIC_RELEASE, "agent");
            asm volatile("s_waitcnt vmcnt(0)" ::: "memory");
            const unsigned og = xb_add(&bar[XB_TOP], 1u);
            const unsigned tg = og / nx;
            if (og + 1u == (tg + 1u) * nx) xb_add(&bar[XB_TOPGEN], 1u);
            else XB_SPIN(xb_ld(&bar[XB_TOPGEN]) == tg, bar);
            __builtin_amdgcn_fence(__ATOMIC_ACQUIRE, "agent");
            xb_add(&bar[XB_XGEN(b.x)], 1u);
            asm volatile("s_waitcnt vmcnt(0)" ::: "memory");
        } else {
            XB_SPIN(xb_ld(&bar[XB_XGEN(b.x)]) == gen, bar);
            __builtin_amdgcn_fence(__ATOMIC_ACQUIRE, "agent");
            asm volatile("s_waitcnt vmcnt(0)" ::: "memory");
        }
    }
    __syncthreads();
}

namespace pg8 {
constexpr int BM = 256, BK = 64, HALF = 128, HTB = HALF * BK * 2, STAGE_BYTES = 8 * HTB;
__host__ __device__ __forceinline__ int lds_byte(int r, int c) { const int st = (r >> 4) * 2 + (c >> 5), rr = r & 15, cc = c & 31, ob = rr * 64 + cc * 2; return st * 1024 + (ob ^ (((ob >> 9) & 1) << 5)); }
__host__ __device__ __forceinline__ void stage_rc(int b, int& R, int& C) { const int st = b / 1024, sb = b % 1024, swz = sb ^ (((sb >> 9) & 1) << 5); R = (st >> 1) * 16 + swz / 64; C = (st & 1) * 32 + (swz % 64) / 2; }

struct Unit { const char* a; const char* b; int p0, p1, p2, p3; };
__device__ __forceinline__ const char* uni_ptr(const char* p) { const unsigned long long v = (unsigned long long)p; const unsigned lo = (unsigned)__builtin_amdgcn_readfirstlane((int)(unsigned)v), hi = (unsigned)__builtin_amdgcn_readfirstlane((int)(unsigned)(v >> 32)); return (const char*)(((unsigned long long)hi << 32) | lo); }
__device__ __forceinline__ void uni_unit(Unit& u) { u.a = uni_ptr(u.a); u.b = uni_ptr(u.b); u.p0 = __builtin_amdgcn_readfirstlane(u.p0); u.p1 = __builtin_amdgcn_readfirstlane(u.p1); u.p2 = __builtin_amdgcn_readfirstlane(u.p2); u.p3 = __builtin_amdgcn_readfirstlane(u.p3); }
struct Shape { int K; int lda, ldb; int sa, sb; const void* abase; const void* bbase; unsigned hbase; };
typedef int v8i __attribute__((ext_vector_type(8)));

struct FragH { bf16x8 hx[2]; }; struct FragW { v8i wx; };
template <bool F8> struct FragSel { typedef FragH type; }; template <> struct FragSel<true> { typedef FragW type; };
__device__ __forceinline__ void ld_h(FragH& f, int k, const LAS unsigned char* p) { f.hx[k] = *(const LAS bf16x8*)p; }
__device__ __forceinline__ void ld_h(FragW&, int, const LAS unsigned char*) {}
__device__ __forceinline__ void ld_w(FragW& f, const LAS unsigned char* p) { const u32x4 lo = *(const LAS u32x4*)p, hi = *(const LAS u32x4*)(p + 16); f.wx = __builtin_bit_cast(v8i, __builtin_shufflevector(lo, hi, 0, 1, 2, 3, 4, 5, 6, 7)); }
__device__ __forceinline__ void ld_w(FragH&, const LAS unsigned char*) {}
__device__ __forceinline__ f32x4 mma_frag(const FragH& b, const FragH& a, f32x4 c, int, int) { c = __builtin_amdgcn_mfma_f32_16x16x32_bf16(b.hx[0], a.hx[0], c, 0, 0, 0); return __builtin_amdgcn_mfma_f32_16x16x32_bf16(b.hx[1], a.hx[1], c, 0, 0, 0); }
__device__ __forceinline__ f32x4 mma_frag(const FragW& b, const FragW& a, f32x4 c, int sB, int sA) { return __builtin_amdgcn_mfma_scale_f32_16x16x128_f8f6f4(b.wx, a.wx, c, 0, 0, 0, sB, 0, sA); }
__host__ __device__ __forceinline__ int perm32(int rho) { const int n = rho >> 4, i = rho & 15; return 8 * (i >> 2) + 4 * n + (i & 3); }
template <class Epi, class Sched, bool FP8 = false, bool PERMB = false, int HSEG = 0>
__device__ __forceinline__ void gemm_phase(const int tid, LAS unsigned char* lds, const Shape g, const Sched& S, const Epi& E) {
    const int wid = __builtin_amdgcn_readfirstlane(tid >> 6), lane = tid & 63, wr = wid >> 2, wc = wid & 3, fr = lane & 15, fq = lane >> 4;
    int K = g.K, lda = g.lda, ldb = g.ldb; asm volatile("" : "+s"(K), "+s"(lda), "+s"(ldb));
    const int nt = FP8 ? K / 128 : K / BK;
    const int sA = g.sa, sB = g.sb;
    unsigned voffA[2], voffBp[2];
#pragma unroll
    for (int i = 0; i < 2; ++i) { int R, C; stage_rc(tid * 16 + i * 8192, R, C);
        voffA[i] = FP8 ? (unsigned)(R * lda + 2 * C) : (unsigned)(R * lda + C) * 2u;
        const int Rb = (R & ~31) + perm32(R & 31); voffBp[i] = PERMB ? (FP8 ? (unsigned)(Rb * ldb + 2 * C) : (unsigned)(Rb * ldb + C) * 2u) : voffA[i]; }
#define voffB voffBp
    unsigned voffH[2] = {0u, 0u};
    if constexpr (HSEG > 0) {
#pragma unroll
        for (int i = 0; i < 2; ++i) { int R, C; stage_rc(tid * 16 + i * 8192, R, C); voffH[i] = (unsigned)(((C >> 3) * MT + R) * 16); }
    }
    constexpr unsigned hkstep = 8u * (unsigned)MT * 16u, hhstep = (unsigned)HALF * 16u;
    const unsigned kstep = (unsigned)(BK * 2);
    const unsigned hstepA = (unsigned)HALF * lda * (FP8 ? 1 : 2), hstepB = (unsigned)HALF * ldb * (FP8 ? 1 : 2);
    const __amdgpu_buffer_rsrc_t rsA = __builtin_amdgcn_make_buffer_rsrc((void*)g.abase, 0, 0xffffffff, 0x00020000), rsB = __builtin_amdgcn_make_buffer_rsrc((void*)g.bbase, 0, 0xffffffff, 0x00020000);
    const unsigned ldsw = (unsigned)wid * 1024u;
    const int aoff = lds_byte(wr * 64 + fr, FP8 ? fq * 16 : fq * 8), boff = lds_byte(wc * 32 + fr, FP8 ? fq * 16 : fq * 8);
#define PG8_SA(b, h) (((b) * 2 + (h)) * HTB)
#define PG8_SB(b, h) ((4 + (b) * 2 + (h)) * HTB)
#define PG8_STAGE(bufoff, rs_soff, voff) do { _Pragma("unroll") for (int _i = 0; _i < 2; ++_i) \
        __builtin_amdgcn_raw_ptr_buffer_load_lds(PG8_RS rs_soff, (LAS unsigned*)(lds + (bufoff) + ldsw + _i * 8192), 16, (voff)[_i], PG8_SO rs_soff, 0, 0); } while (0)
#define PG8_RS(r, s) r
#define PG8_SO(r, s) (int)(s)
#define PG8_LDA(dst, b, h) do { _Pragma("unroll") for (int m = 0; m < 4; ++m) { if constexpr (FP8) ld_w(dst[m], lds + PG8_SA(b, h) + aoff + m * 2048); else { _Pragma("unroll") for (int k = 0; k < 2; ++k) ld_h(dst[m], k, lds + PG8_SA(b, h) + aoff + m * 2048 + k * 1024); } } } while (0)
#define PG8_LDB(dst, b, h) do { _Pragma("unroll") for (int n = 0; n < 2; ++n) { if constexpr (FP8) ld_w(dst[n], lds + PG8_SB(b, h) + boff + n * 2048); else { _Pragma("unroll") for (int k = 0; k < 2; ++k) ld_h(dst[n], k, lds + PG8_SB(b, h) + boff + n * 2048 + k * 1024); } } } while (0)
#define PG8_MMA(ai, bj, At, Bt) do { __builtin_amdgcn_s_setprio(1); _Pragma("unroll") for (int m = 0; m < 4; ++m) _Pragma("unroll") for (int n = 0; n < 2; ++n) { \
        acc[ai][bj][m][n] = mma_frag(Bt[n], At[m], acc[ai][bj][m][n], sB, sA); } \
        __builtin_amdgcn_s_setprio(0); } while (0)
#define PG8_WAIT_V(n) asm volatile("s_waitcnt vmcnt(" #n ")" ::: "memory")
#define PG8_WAIT_L(n) asm volatile("s_waitcnt lgkmcnt(" #n ")" ::: "memory")
#define PG8_BAR __builtin_amdgcn_s_barrier()
#define PG8_SCHED __builtin_amdgcn_sched_barrier(0)
    Unit cur, nxt; int ui = 0;
    if (!S.next(0, cur)) return;
    uni_unit(cur);
    f32x4 acc[2][2][4][2];
#pragma unroll
    for (int a = 0; a < 2; ++a)
#pragma unroll
        for (int b = 0; b < 2; ++b)
#pragma unroll
            for (int m = 0; m < 4; ++m)
#pragma unroll
                for (int n = 0; n < 2; ++n) acc[a][b][m][n] = (f32x4){0.f, 0.f, 0.f, 0.f};
    typename FragSel<FP8>::type At[4], B0[2], B1[2];
    unsigned cA = (unsigned)(cur.a - (const char*)g.abase), cB = (unsigned)(cur.b - (const char*)g.bbase);
    PG8_STAGE(PG8_SB(0, 0), (rsB, cB), voffB); PG8_STAGE(PG8_SB(0, 1), (rsB, cB + hstepB), voffB); PG8_STAGE(PG8_SA(0, 0), (rsA, cA), voffA); PG8_STAGE(PG8_SA(0, 1), (rsA, cA + hstepA), voffA);
    if (wr == 1) PG8_BAR;
    PG8_WAIT_V(2); PG8_BAR;
    PG8_STAGE(PG8_SB(1, 0), (rsB, cB + kstep), voffB); PG8_STAGE(PG8_SA(1, 0), (rsA, cA + kstep), voffA); PG8_STAGE(PG8_SB(1, 1), (rsB, cB + hstepB + kstep), voffB);
    PG8_WAIT_V(6); PG8_BAR;
    for (;;) {
        const bool has_next = __builtin_amdgcn_readfirstlane((int)S.next(ui + 1, nxt)) != 0;
        uni_unit(nxt);
        const unsigned nA = has_next ? (unsigned)(nxt.a - (const char*)g.abase) : cA, nB = has_next ? (unsigned)(nxt.b - (const char*)g.bbase) : cB;
        for (int t = 0; t < nt; t += 2) {
            const bool last = (t == nt - 2);
            if constexpr (Epi::MID > 0) { if (t != 0 && (t % Epi::MID) == 0) E.mid(acc, cur, t / Epi::MID, wr, wc, fr, fq); }
            unsigned a1 = cA + (unsigned)(t + 1) * kstep;
            unsigned a2 = last ? nA : cA + (unsigned)(t + 2) * kstep; const unsigned b2 = last ? nB : cB + (unsigned)(t + 2) * kstep;
            unsigned a3 = a2 + kstep; const unsigned b3 = b2 + kstep;
            unsigned hs1 = hstepA, hs2 = hstepA; unsigned vA1[2] = {voffA[0], voffA[1]}, vA2[2] = {voffA[0], voffA[1]}, vA3[2] = {voffA[0], voffA[1]};
            if constexpr (HSEG > 0) {
                const unsigned hb = g.hbase + (unsigned)cur.p0 * (256u * 16u);
                if (t + 1 >= HSEG) { a1 = hb + (unsigned)(t + 1 - HSEG) * hkstep; hs1 = hhstep; vA1[0] = voffH[0]; vA1[1] = voffH[1]; }
                if (!last && t + 2 >= HSEG) { a2 = hb + (unsigned)(t + 2 - HSEG) * hkstep; hs2 = hhstep; vA2[0] = voffH[0]; vA2[1] = voffH[1]; }
                if (!last && t + 3 >= HSEG) { a3 = hb + (unsigned)(t + 3 - HSEG) * hkstep; vA3[0] = voffH[0]; vA3[1] = voffH[1]; }
            }
            PG8_LDB(B0, 0, 0); PG8_LDB(B1, 0, 1); PG8_SCHED; PG8_LDA(At, 0, 0); PG8_STAGE(PG8_SA(1, 1), (rsA, a1 + hs1), vA1);
            PG8_WAIT_V(8); PG8_WAIT_L(0); PG8_BAR; PG8_MMA(0, 0, At, B0); PG8_MMA(0, 1, At, B1); PG8_BAR; PG8_SCHED;
            PG8_LDA(At, 0, 1); PG8_STAGE(PG8_SB(0, 0), (rsB, b2), voffB); PG8_STAGE(PG8_SB(0, 1), (rsB, b2 + hstepB), voffB); PG8_STAGE(PG8_SA(0, 0), (rsA, a2), vA2);
            PG8_WAIT_V(8); PG8_WAIT_L(0); PG8_BAR; PG8_MMA(1, 0, At, B0); PG8_MMA(1, 1, At, B1); PG8_BAR; PG8_SCHED;
            PG8_LDB(B0, 1, 0); PG8_LDB(B1, 1, 1); PG8_SCHED; PG8_LDA(At, 1, 0); PG8_STAGE(PG8_SA(0, 1), (rsA, a2 + hs2), vA2);
            PG8_WAIT_V(8); PG8_WAIT_L(0); PG8_BAR; PG8_MMA(0, 0, At, B0); PG8_MMA(0, 1, At, B1); PG8_BAR; PG8_SCHED;
            PG8_LDA(At, 1, 1); PG8_STAGE(PG8_SB(1, 0), (rsB, b3), voffB); PG8_STAGE(PG8_SB(1, 1), (rsB, b3 + hstepB), voffB); PG8_STAGE(PG8_SA(1, 0), (rsA, a3), vA3);
            PG8_WAIT_V(8); PG8_WAIT_L(0); PG8_BAR; PG8_MMA(1, 0, At, B0); PG8_MMA(1, 1, At, B1); PG8_BAR; PG8_SCHED;
        }
        if (wr == 0) PG8_BAR;
        E(acc, cur, wr, wc, fr, fq);
        if (!has_next) break;
#pragma unroll
        for (int a = 0; a < 2; ++a)
#pragma unroll
            for (int b = 0; b < 2; ++b)
#pragma unroll
                for (int m = 0; m < 4; ++m)
#pragma unroll
                    for (int n = 0; n < 2; ++n) acc[a][b][m][n] = (f32x4){0.f, 0.f, 0.f, 0.f};
        cur = nxt; cA = nA; cB = nB; ++ui;
        if (wr == 1) PG8_BAR;
    }
    PG8_WAIT_V(0);
    PG8_BAR;
#undef voffB
#undef PG8_SA
#undef PG8_SB
#undef PG8_STAGE
#undef PG8_RS
#undef PG8_SO
#undef PG8_LDA
#undef PG8_LDB
#undef PG8_MMA
#undef PG8_WAIT_V
#undef PG8_WAIT_L
#undef PG8_BAR
#undef PG8_SCHED
}

template <int PMUL = 1>
struct GridOrder {
    const char* aBase; const char* bBase; size_t aTile, bTile; int nM, nN, nwg, G, c, nextra, epm, epn;
    __device__ void init(const void* a, const void* b, size_t at, size_t bt, int nM_, int nN_, int G_, int c_, int nextra_ = 0, int epm_ = 0, int epn_ = 0) { aBase = (const char*)a; bBase = (const char*)b; aTile = at; bTile = bt; nM = nM_; nN = nN_; nwg = nM * nN; G = G_; c = c_; nextra = nextra_; epm = epm_; epn = epn_; }
    __device__ __forceinline__ bool next(int i, Unit& u) const {
        const long L = (long)i * G + c; if (L >= nwg + nextra) return false;
        if (L >= nwg) { const int pm = epm + (int)(L - nwg), pn = epn; u.a = aBase + (size_t)pm * aTile; u.b = bBase + (size_t)pn * bTile; u.p0 = pm * PMUL; u.p1 = pn * PMUL; u.p2 = 0; u.p3 = 0; return true; }
        int wgid = (int)L; { const int q = nwg / 8, r = nwg % 8, xcd = wgid % 8, off = wgid / 8; wgid = (xcd < r ? xcd * (q + 1) : r * (q + 1) + (xcd - r) * q) + off; }
        const int nig = 8 * nN, gid = wgid / nig, fm = gid * 8, gsz = (nM - fm) < 8 ? (nM - fm) : 8;
        const int pm = fm + ((wgid % nig) % gsz), pn = (wgid % nig) / gsz;
        u.a = aBase + (size_t)pm * aTile; u.b = bBase + (size_t)pn * bTile; u.p0 = pm * PMUL; u.p1 = pn * PMUL; u.p2 = 0; u.p3 = 0; return true;
    }
};
}

using pg8::Unit;
#define EPI_ARGS const f32x4 (&acc)[2][2][4][2], const Unit& u, int wr, int wc, int fr, int fq

struct EpiStore {
    static constexpr int MID = 0;
    bf16* dst0; bf16* dst1; int ld0, ld1;
    __device__ __forceinline__ void operator()(EPI_ARGS) const {
        bf16* dst = u.p2 ? dst1 : dst0; const int ld = u.p2 ? ld1 : ld0;
        const size_t base = (size_t)(u.p0 + wr * 64 + fr) * ld + u.p1 + wc * 32 + 8 * fq;
#pragma unroll
        for (int ai = 0; ai < 2; ++ai)
#pragma unroll
            for (int m = 0; m < 4; ++m) { bf16* rowp = dst + base + (size_t)(ai * 128 + m * 16) * ld;
#pragma unroll
                for (int bj = 0; bj < 2; ++bj) { const f32x4 v0 = acc[ai][bj][m][0], v1 = acc[ai][bj][m][1];
                    u32x4 w; w.x = pk2(v0[0], v0[1]); w.y = pk2(v0[2], v0[3]); w.z = pk2(v1[0], v1[1]); w.w = pk2(v1[2], v1[3]); *(u32x4*)(rowp + bj * 128) = w; }
                asm volatile("" ::: "memory"); }
    }
};

struct EpiStoreBlk {
    static constexpr int MID = 0;
    bf16* dst;
    __device__ __forceinline__ void operator()(EPI_ARGS) const {
        const size_t base = ((size_t)((u.p1 + wc * 32 + 8 * fq) >> 3) * MT + (u.p0 + wr * 64 + fr)) * 8;
#pragma unroll
        for (int ai = 0; ai < 2; ++ai)
#pragma unroll
            for (int m = 0; m < 4; ++m) { bf16* rowp = dst + base + (size_t)(ai * 128 + m * 16) * 8;
#pragma unroll
                for (int bj = 0; bj < 2; ++bj) { const f32x4 v0 = acc[ai][bj][m][0], v1 = acc[ai][bj][m][1];
                    u32x4 w; w.x = pk2(v0[0], v0[1]); w.y = pk2(v0[2], v0[3]); w.z = pk2(v1[0], v1[1]); w.w = pk2(v1[2], v1[3]); *(u32x4*)(rowp + (size_t)bj * 16 * MT * 8) = w; }
                asm volatile("" ::: "memory"); }
    }
};
struct EpiQKVG {
    static constexpr int MID = 0;
    bf16* qkv; const float* rope;
    __device__ __forceinline__ void operator()(EPI_ARGS) const {
        const int pm = u.p0, pn = u.p1;
        const int row0 = pm * 256 + wr * 64 + fr;
        {
            const bool latent = pm < (ML / 256);
#pragma unroll
            for (int ai = 0; ai < 2; ++ai)
#pragma unroll
                for (int m = 0; m < 4; ++m) {
                    const int row = row0 + ai * 128 + m * 16; const int t = row & (SEQ - 1);
                    const int pos = (wc & 1) ? (t & 63) : (t >> 6);
                    bf16* rowp = qkv + (size_t)row * QKVW + pn * 256 + wc * 32 + 4 * fq;
                    const f32x4* rp = (const f32x4*)(rope + (size_t)pos * 32 + 8 * fq);
                    const f32x4 r0 = rp[0], r1 = rp[1];
#pragma unroll
                    for (int bj = 0; bj < 2; ++bj) {
                        const bool dorope = latent && (pn < 2 || bj == 0);
                        const float sc = (pn < 2) ? 0.125f * 1.44269504f : 1.0f;
                        f32x4 v0 = acc[ai][bj][m][0] * sc, v1 = acc[ai][bj][m][1] * sc;
                        if (dorope) {
                            const f32x4 cs = (f32x4){r0[0], r0[2], r1[0], r1[2]}, sn = (f32x4){r0[1], r0[3], r1[1], r1[3]};
                            const f32x4 o0 = v0 * cs - v1 * sn, o1 = v0 * sn + v1 * cs; v0 = o0; v1 = o1;
                        }
                        u32x2 w0, w1; w0.x = pk2(v0[0], v0[1]); w0.y = pk2(v0[2], v0[3]); w1.x = pk2(v1[0], v1[1]); w1.y = pk2(v1[2], v1[3]);
                        *(u32x2*)(rowp + bj * 128) = w0; *(u32x2*)(rowp + bj * 128 + 16) = w1;
                    }
                    asm volatile("" ::: "memory");
                }
        }
    }
};
__device__ __forceinline__ unsigned pk4_gate(float a, float b, float c, float d) {
    unsigned r = 0; r = __builtin_amdgcn_cvt_pk_u8_f32(a * 256.0f - 0.5f, 0, r); r = __builtin_amdgcn_cvt_pk_u8_f32(b * 256.0f - 0.5f, 1, r);
    r = __builtin_amdgcn_cvt_pk_u8_f32(c * 256.0f - 0.5f, 2, r); r = __builtin_amdgcn_cvt_pk_u8_f32(d * 256.0f - 0.5f, 3, r); return r; }
__device__ __forceinline__ f32x4 gate4(unsigned w) { return (f32x4){(float)(w & 0xffu) + 0.5f, (float)((w >> 8) & 0xffu) + 0.5f, (float)((w >> 16) & 0xffu) + 0.5f, (float)(w >> 24) + 0.5f}; }
struct EpiGates {
    static constexpr int MID = 0;
    unsigned char* gates;
    __device__ __forceinline__ void operator()(EPI_ARGS) const {
        const int row0 = u.p0 * 256 + wr * 64 + fr;
#pragma unroll
        for (int ai = 0; ai < 2; ++ai)
#pragma unroll
            for (int m = 0; m < 4; ++m) { unsigned char* rowp = gates + (unsigned)((row0 + ai * 128 + m * 16) * GW + u.p1 * 256 + wc * 32 + 8 * fq);
#pragma unroll
                for (int bj = 0; bj < 2; ++bj) { const f32x4 v0 = acc[ai][bj][m][0], v1 = acc[ai][bj][m][1];
                    u32x2 w; w.x = pk4_gate(sigmoidf_(v0[0]), sigmoidf_(v0[1]), sigmoidf_(v0[2]), sigmoidf_(v0[3])); w.y = pk4_gate(sigmoidf_(v1[0]), sigmoidf_(v1[1]), sigmoidf_(v1[2]), sigmoidf_(v1[3]));
                    *(u32x2*)(rowp + bj * 128) = w; }
                asm volatile("" ::: "memory"); }
    }
};

struct EpiBranch {
    static constexpr int MID = 8;
    const unsigned char* gates; bf16* mb;
    __device__ __forceinline__ static f32x4 ratio4(unsigned a, unsigned b) {
        const f32x4 x = gate4(a), y = gate4(b);
        return (f32x4){x[0] * __builtin_amdgcn_rcpf(y[0]), x[1] * __builtin_amdgcn_rcpf(y[1]), x[2] * __builtin_amdgcn_rcpf(y[2]), x[3] * __builtin_amdgcn_rcpf(y[3])}; }
    __device__ __forceinline__ void mid(f32x4 (&acc)[2][2][4][2], const Unit& u, int seg, int wr, int wc, int fr, int fq) const {
        const int row0 = u.p0 * 256 + wr * 64 + fr, col0 = u.p1 * 256 + wc * 32 + 8 * fq;
        const unsigned char* gbase = gates + (size_t)row0 * GW + (seg - 1) * 1024 + col0;
        u32x2 ga[2][2], gb[2][2];
#define EB_LD(grp, buf) do { const unsigned char* gp_ = gbase + (size_t)(((grp) >> 2) * 128 + ((grp) & 3) * 16) * GW; _Pragma("unroll") for (int q_ = 0; q_ < 2; ++q_) { \
            ga[buf][q_] = *(const u32x2*)(gp_ + q_ * 128); gb[buf][q_] = *(const u32x2*)(gp_ + 1024 + q_ * 128); } } while (0)
        EB_LD(0, 0);
#pragma unroll
        for (int grp = 0; grp < 8; ++grp) {
            if (grp < 7) EB_LD(grp + 1, (grp + 1) & 1);
            const int ai = grp >> 2, m = grp & 3, buf = grp & 1;
#pragma unroll
            for (int bj = 0; bj < 2; ++bj) { const u32x2 a_ = ga[buf][bj], b_ = gb[buf][bj];
                acc[ai][bj][m][0] = acc[ai][bj][m][0] * ratio4(a_.x, b_.x); acc[ai][bj][m][1] = acc[ai][bj][m][1] * ratio4(a_.y, b_.y); }
            asm volatile("" ::: "memory");
        }
#undef EB_LD
    }
    __device__ __forceinline__ void operator()(EPI_ARGS) const {
        const int row0 = u.p0 * 256 + wr * 64 + fr, col0 = u.p1 * 256 + wc * 32 + 8 * fq;
        const unsigned char* gbase = gates + (size_t)row0 * GW + 2 * 1024 + col0; bf16* bbase = mb + (size_t)row0 * D + col0;
        u32x2 gg[2][2];
#define EB_LD(grp, buf) do { const unsigned char* gp_ = gbase + (size_t)(((grp) >> 2) * 128 + ((grp) & 3) * 16) * GW; _Pragma("unroll") for (int q_ = 0; q_ < 2; ++q_) gg[buf][q_] = *(const u32x2*)(gp_ + q_ * 128); } while (0)
        EB_LD(0, 0);
#pragma unroll
        for (int grp = 0; grp < 8; ++grp) {
            if (grp < 7) EB_LD(grp + 1, (grp + 1) & 1);
            const int ai = grp >> 2, m = grp & 3, buf = grp & 1; bf16* bp = bbase + (size_t)(ai * 128 + m * 16) * D;
#pragma unroll
            for (int bj = 0; bj < 2; ++bj) { const u32x2 gw = gg[buf][bj]; const f32x4 a0 = acc[ai][bj][m][0] * gate4(gw.x) * (1.0f / 256.0f), a1 = acc[ai][bj][m][1] * gate4(gw.y) * (1.0f / 256.0f);
                u32x4 w; w.x = pk2(a0[0], a0[1]); w.y = pk2(a0[2], a0[3]); w.z = pk2(a1[0], a1[1]); w.w = pk2(a1[2], a1[3]);
                *(u32x4*)(bp + bj * 128) = w; }
            asm volatile("" ::: "memory");
        }
#undef EB_LD
    }
};

struct EpiResid {
    static constexpr int MID = 0;
    bf16* x; const float* gvec; float* ssq;
    __device__ __forceinline__ void operator()(EPI_ARGS) const {
        const int pm = u.p0; const int v = pm < (ML / 256) ? (pm >> 4) : 4;
        const int row0 = pm * 256 + wr * 64 + fr, col0 = u.p1 * 256 + wc * 32 + 8 * fq;
        const float* gp = gvec + (size_t)v * (NMOD * D) + col0;
        f32x4 gv[4];
#pragma unroll
        for (int q = 0; q < 4; ++q) gv[q] = *(const f32x4*)(gp + (q >> 1) * 128 + (q & 1) * 4);
        bf16* xbase = x + (size_t)row0 * D + col0;
        u32x4 xv[2][2];
#define ER_LD(grp, buf) do { const bf16* xp_ = xbase + (size_t)(((grp) >> 2) * 128 + ((grp) & 3) * 16) * D; xv[buf][0] = *(const u32x4*)xp_; xv[buf][1] = *(const u32x4*)(xp_ + 128); } while (0)
        ER_LD(0, 0);
#pragma unroll
        for (int grp = 0; grp < 8; ++grp) {
            if (grp < 7) ER_LD(grp + 1, (grp + 1) & 1);
            const int ai = grp >> 2, m = grp & 3, buf = grp & 1; bf16* xp = xbase + (size_t)(ai * 128 + m * 16) * D;
            float s2 = 0.f;
#pragma unroll
            for (int bj = 0; bj < 2; ++bj) { const u32x4 w = xv[buf][bj];
                const f32x4 n0 = (f32x4){bflo(w.x), bfhi(w.x), bflo(w.y), bfhi(w.y)} + gv[bj * 2] * acc[ai][bj][m][0], n1 = (f32x4){bflo(w.z), bfhi(w.z), bflo(w.w), bfhi(w.w)} + gv[bj * 2 + 1] * acc[ai][bj][m][1];
                u32x4 o; o.x = pk2(n0[0], n0[1]); o.y = pk2(n0[2], n0[3]); o.z = pk2(n1[0], n1[1]); o.w = pk2(n1[2], n1[3]); *(u32x4*)(xp + bj * 128) = o;
                s2 += ((n0[0] * n0[0] + n0[1] * n0[1]) + (n0[2] * n0[2] + n0[3] * n0[3])) + ((n1[0] * n1[0] + n1[1] * n1[1]) + (n1[2] * n1[2] + n1[3] * n1[3])); }
            s2 += shx(s2, 16, fq * 16 + fr); s2 += shx(s2, 32, fq * 16 + fr);
            if (fq == 0) ssq[(size_t)(row0 + ai * 128 + m * 16) * 16 + u.p1 * 4 + wc] = s2;
            asm volatile("" ::: "memory");
        }
#undef ER_LD
    }
};

struct EpiGateUp {
    static constexpr int MID = 0;
    unsigned char* hm;
    __device__ __forceinline__ void operator()(EPI_ARGS) const {
        const size_t base = (size_t)(u.p0 + wr * 64 + fr) * FF + u.p1 * 128 + wc * 32 + 8 * fq;
#pragma unroll
        for (int ai = 0; ai < 2; ++ai)
#pragma unroll
            for (int m = 0; m < 4; ++m) { unsigned char* rowp = hm + base + (size_t)(ai * 128 + m * 16) * FF;
                u32x2 w;
#pragma unroll
                for (int n = 0; n < 2; ++n) { const f32x4 g = acc[ai][0][m][n], up = acc[ai][1][m][n]; f32x4 v;
#pragma unroll
                    for (int j = 0; j < 4; ++j) v[j] = g[j] * sigmoidf_(g[j]) * up[j] * FP8_HM_SCALE;
                    const unsigned pk = pk4_fp8(v[0], v[1], v[2], v[3]); if (n == 0) w.x = pk; else w.y = pk; }
                *(u32x2*)rowp = w;
                asm volatile("" ::: "memory"); }
    }
};

struct FourierCtxOrder {
    const char* tc; const char* ftc; int G, c;
    __device__ __forceinline__ bool next(int i, Unit& u) const {
        const int L = i * G + ((c + G - 100) % G); if (L >= 8) return false;
        const int b = L >> 1, pn = L & 1;
        u.a = tc; u.b = ftc + ((size_t)b * 512 + pn * 256) * 512 * 2; u.p0 = ML + b * CTXL; u.p1 = pn * 256; u.p2 = 0; u.p3 = 0; return true;
    }
};
struct FtOrder {
    const char* w; const char* hn; int G, c, ntok;
    __device__ __forceinline__ bool next(int i, Unit& u) const {
        const int L = i * G + c; if (L >= 4 * ntok) return false;
        const int pn = L >> 2, pm = L & 3;
        u.a = w + (size_t)pm * 256 * D * 2; u.b = hn + (size_t)pn * 256 * D * 2;
        const int part = pm >> 1, m0 = (pm & 1) * 256;
        if (pn < 64) { const int b = pn >> 4; u.p0 = b * 512 + m0; u.p1 = part * SEQ + (pn & 15) * 256; u.p2 = 0; }
        else { const int b = pn - 64; u.p0 = b * 512 + m0; u.p1 = part * CTXL; u.p2 = 1; }
        u.p3 = 0; return true;
    }
};
template <int NPN, int P1MUL, int ESZ>
struct MoeOrder {
    const volatile LAS int* tstart; const char* a; const char* w; size_t wexp; int G, c;
    __device__ __forceinline__ bool next(int i, Unit& u) const {
        const int nt = __builtin_amdgcn_readfirstlane(tstart[16]); const int L = i * G + c; if (L >= nt * NPN) return false;
        const int tile = L / NPN, pn = L - tile * NPN;
        int e = 0;
#pragma unroll
        for (int k = 1; k < 16; ++k) e += (tile >= __builtin_amdgcn_readfirstlane(tstart[k])) ? 1 : 0;
        u.a = a + (size_t)tile * 256 * D * ESZ; u.b = w + (size_t)e * wexp + (size_t)pn * 256 * D * ESZ;
        u.p0 = tile * 256; u.p1 = pn * P1MUL; u.p2 = 0; u.p3 = e; return true;
    }
};

struct Frame {
    LAS unsigned char* lds;
    int tid, lane, wave, G, bid;
    float* out;
    GAS unsigned char* ws;
};
#define WSP(T, off) ((T*)(F.ws + (off)))
enum { IN_X = 0, IN_C, IN_CTX, IN_CCTX, IN_WMOD, IN_BMOD, IN_NMIX, IN_NFFN, IN_WIN, IN_SINK, IN_CONVW, IN_CONVB, IN_FW1, IN_FB1, IN_FFREQ, IN_FW2, IN_FB2, IN_FW3, IN_HBIAS,
       IN_WBA, IN_WBF, IN_WBH, IN_WOUT, IN_WROUTER, IN_BROUTER, IN_WEG, IN_WEU, IN_WED, IN_NFINAL };

__device__ __forceinline__ int pslot(int n) { return 16 * ((n >> 2) & 1) + 4 * (n >> 3) + (n & 3); }
__device__ __forceinline__ void transpose_item(const float* W, int lds_, int k0, int n0, bf16* WT, int ldd, int drow0, LAS float* scr, int lane, bool perm = false) {
#pragma unroll
    for (int i = 0; i < 8; ++i) { const int kk = 8 * i + (lane >> 3), c4 = (lane & 7) * 4; const f32x4 v = *(const f32x4*)(W + (size_t)(k0 + kk) * lds_ + n0 + c4);
        LAS float* d = scr + kk * 33 + c4; d[0] = v[0]; d[1] = v[1]; d[2] = v[2]; d[3] = v[3]; }
    LDS_WAIT(); asm volatile("" ::: "memory");
    const int c = lane & 7;
#pragma unroll
    for (int j = 0; j < 4; ++j) { const int n = (lane >> 3) + 8 * j; const LAS float* s = scr + (8 * c) * 33 + n;
        u32x4 o; o.x = pk2(s[0 * 33], s[1 * 33]); o.y = pk2(s[2 * 33], s[3 * 33]); o.z = pk2(s[4 * 33], s[5 * 33]); o.w = pk2(s[6 * 33], s[7 * 33]);
        *(u32x4*)(WT + (size_t)(drow0 + (perm ? pslot(n) : n)) * ldd + k0 + 8 * c) = o; }
    LDS_WAIT(); asm volatile("" ::: "memory");
}

__device__ __forceinline__ void transpose_item8(const float* W, int lds_, int k0, int n0, unsigned char* WT, int ldd, int drow0, LAS float* scr, int lane, float scale) {
#pragma unroll
    for (int i = 0; i < 8; ++i) { const int kk = 8 * i + (lane >> 3), c4 = (lane & 7) * 4; const f32x4 v = *(const f32x4*)(W + (size_t)(k0 + kk) * lds_ + n0 + c4);
        LAS float* d = scr + kk * 33 + c4; d[0] = v[0]; d[1] = v[1]; d[2] = v[2]; d[3] = v[3]; }
    LDS_WAIT(); asm volatile("" ::: "memory");
    const int c = lane & 7;
#pragma unroll
    for (int j = 0; j < 4; ++j) { const int n = (lane >> 3) + 8 * j; const LAS float* s = scr + (8 * c) * 33 + n;
        u32x2 o; o.x = pk4_fp8(s[0 * 33] * scale, s[1 * 33] * scale, s[2 * 33] * scale, s[3 * 33] * scale); o.y = pk4_fp8(s[4 * 33] * scale, s[5 * 33] * scale, s[6 * 33] * scale, s[7 * 33] * scale);
        *(u32x2*)(WT + (size_t)(drow0 + pslot(n)) * ldd + k0 + 8 * c) = o; }
    LDS_WAIT(); asm volatile("" ::: "memory");
}

__device__ __forceinline__ void pro_weights(Frame& F, const float* w_in, const float* wba, const float* wbf, const float* wbh, const float* wout, const float* fw3) {
    LAS float* scr = (LAS float*)(F.lds + F.wave * 16384);
    const int gw = F.bid * NWAVES + F.wave, NGW = F.G * NWAVES;
    constexpr int I1 = 16 * 24, I2 = 16 * 96, I3 = 16 * 48, I4 = 8 * 32, I7 = 16 * 32;
    constexpr int I8 = 64;
    constexpr int NPER = I1 + I2 + I3 + 3 * I4 + I7 + I8;
    for (int it = gw; it < DEPTH * NPER; it += NGW) {
        const int l = it / NPER; int r = it - l * NPER;
        unsigned char* wl = (unsigned char*)(F.ws + WS_W + (size_t)l * WL_SIZE);
        const float* win = w_in + (size_t)l * D * INW;
        if (r < I1) { const int kb = r / 24, nb = r % 24; transpose_item(win, INW, kb * 64, nb * 32, (bf16*)(wl + WL_QKVG), D, nb * 32, scr, F.lane); continue; } r -= I1;
        if (r < I2) { const int kb = r / 96, nb = r % 96; transpose_item8(win, INW, kb * 64, G_OFF + nb * 32, wl + WL_G8, D, nb * 32, scr, F.lane, FP8_W_SCALE); continue; } r -= I2;
        if (r < I3) { const int kb = r / 48, nb = r % 48; transpose_item(win, INW, kb * 64, H_OFF + nb * 32, (bf16*)(wl + WL_H), D, nb * 32, scr, F.lane); continue; } r -= I3;
        if (r < 3 * I4) { const int br = r / I4; r -= br * I4; const int kb = r / 32, nb = r % 32;
            const float* w = (br == 0 ? wba : br == 1 ? wbf : wbh) + (size_t)l * 512 * D;
            transpose_item(w, D, kb * 64, nb * 32, (bf16*)(wl + WL_BA) + br * 512, 1536, nb * 32, scr, F.lane, true); continue; } r -= 3 * I4;
        if (r < I7) { const int kb = r / 32, nb = r % 32; transpose_item(wout + (size_t)l * D * D, D, kb * 64, nb * 32, (bf16*)(wl + WL_OUT), D, nb * 32, scr, F.lane, true); continue; } r -= I7;
        transpose_item(fw3 + (size_t)l * 64 * 2048, 2048, 0, r * 32, WSP(bf16, WS_W3T) + (size_t)l * 2048 * 64, 64, r * 32, scr, F.lane);
    }
}
__device__ __forceinline__ void conv_experts(Frame& F, int l, const float* weg, const float* weu, const float* wed, int lo, int hi, int bid0) {
    LAS float* scr = (LAS float*)(F.lds + F.wave * 16384);
    if (F.bid < bid0) return;
    const int gw = (F.bid - bid0) * NWAVES + F.wave, NGW = (F.G - bid0) * NWAVES;
    constexpr int IE = 16 * 32;
    unsigned char* wbuf = (unsigned char*)(F.ws + WS_WEXP + (size_t)(l & 1) * WE_BUF);
    for (int it = lo + gw; it < hi; it += NGW) {
        const int e = it / (3 * IE); int r = it - e * 3 * IE; const int which = r / IE; r -= which * IE;
        const int kb = r / 32, nb = r % 32, n0 = nb * 32;
        const size_t eoff = ((size_t)l * NEXP + e) * D * FF;
        if (which < 2) {
            const float* w = (which == 0 ? weg : weu) + eoff;
            unsigned char* dst = wbuf + WE_GU + (size_t)e * 2048 * D;
            const int drow = (n0 >> 7) * 256 + which * 128 + (n0 & 127);
            transpose_item8(w, FF, kb * 64, n0, dst, D, drow, scr, F.lane, FP8_W_SCALE);
        } else {
            unsigned char* dst = wbuf + WE_D + (size_t)e * D * FF;
            transpose_item8(wed + eoff, D, kb * 64, n0, dst, FF, n0, scr, F.lane, FP8_W_SCALE);
        }
    }
}
__device__ __forceinline__ void pro_fold(Frame& F, const float* w_in) {
    LAS unsigned char* wl_ = F.lds;
    LAS unsigned char* tl_ = F.lds + 64 * 272;
    const int lane = F.lane, fr = lane & 15, fq = lane >> 4, w = F.wave;
    for (int unit = F.bid; unit < DEPTH * 4 * 16; unit += F.G) {
        const int l = unit >> 6, g = (unit >> 4) & 3, kb = unit & 15;
        __syncthreads();
        for (int i = F.tid; i < 256 * 64; i += NTHR) { const int pm = i >> 6, c2 = (i & 63) * 2, m = pm & 127; const bool sn = pm >= 128;
        const float a0 = (float)((m * c2) & 127) / 64.0f, a1 = (float)((m * (c2 + 1)) & 127) / 64.0f;
        *(LAS unsigned*)(tl_ + pm * 272 + c2 * 2) = pk2(sn ? sinpif(a0) : cospif(a0), sn ? sinpif(a1) : cospif(a1)); }
        const float* win = w_in + (size_t)l * D * INW + (size_t)(kb * 64) * INW + F_OFF + g * 128;
        for (int i = F.tid; i < 64 * 32; i += NTHR) { const int k = i >> 5, c4 = (i & 31) * 4; const f32x4 v = *(const f32x4*)(win + (size_t)k * INW + c4);
            u32x2 o; o.x = pk2(v[0], v[1]); o.y = pk2(v[2], v[3]); *(LAS u32x2*)(wl_ + k * 272 + c4 * 2) = o; }
        __syncthreads();
        bf16* dstb = (bf16*)(F.ws + WS_W + (size_t)l * WL_SIZE + WL_F) + kb * 64;
#pragma unroll
        for (int pt = 0; pt < 2; ++pt) {
            const int pm = 32 * w + 16 * pt + fr, part = pm >> 7, m = pm & 127;
            bf16x8 tf[4];
#pragma unroll
            for (int ks = 0; ks < 4; ++ks) tf[ks] = *(const LAS bf16x8*)(tl_ + pm * 272 + ks * 64 + fq * 16);
#pragma unroll
            for (int kt = 0; kt < 4; ++kt) {
                f32x4 acc = (f32x4){0.f, 0.f, 0.f, 0.f};
#pragma unroll
                for (int ks = 0; ks < 4; ++ks) { const bf16x8 wf = *(const LAS bf16x8*)(wl_ + (kt * 16 + fr) * 272 + ks * 64 + fq * 16); acc = __builtin_amdgcn_mfma_f32_16x16x32_bf16(wf, tf[ks], acc, 0, 0, 0); }
                acc = acc * 0.08838834764831845f;
                u32x2 o; o.x = pk2(acc[0], acc[1]); o.y = pk2(acc[2], acc[3]);
                *(u32x2*)(dstb + (size_t)(part * 512 + g * 128 + m) * D + kt * 16 + 4 * fq) = o;
            }
        }
    }
    __syncthreads();
}
__device__ __forceinline__ void pro_mods(Frame& F, const float* cvec, const float* cctx, const float* wmod, const float* bmod) {
    LAS float* sc = (LAS float*)F.lds;
    LAS float* part = sc + 5 * 1024;
    __syncthreads();
    for (int i = F.tid; i < 5 * 1024; i += NTHR) { const int v = i >> 10, k = i & 1023; const float x = v < 4 ? cvec[v * D + k] : cctx[k]; sc[i] = x * sigmoidf_(x); }
    __syncthreads();
    float* mods = WSP(float, WS_MODS);
    const int krow = F.tid >> 3, col4 = (F.tid & 7) * 4;
    for (int unit = F.bid; unit < DEPTH * 192; unit += F.G) {
        const int l = unit / 192, jc = unit % 192;
        const float* w = wmod + (size_t)l * D * (NMOD * D) + (size_t)krow * (NMOD * D) + jc * 32 + col4;
        f32x4 a[5];
#pragma unroll
        for (int v = 0; v < 5; ++v) a[v] = (f32x4){0.f, 0.f, 0.f, 0.f};
#pragma unroll
        for (int i = 0; i < 16; ++i) { const f32x4 wv = *(const f32x4*)(w + (size_t)(64 * i) * (NMOD * D)); const int kk = krow + 64 * i;
#pragma unroll
            for (int v = 0; v < 5; ++v) a[v] += sc[v * 1024 + kk] * wv; }
#pragma unroll
        for (int v = 0; v < 5; ++v) *(LAS f32x4*)(part + (krow * 5 + v) * 32 + col4) = a[v];
        __syncthreads();
        if (F.tid < 160) { const int v = F.tid >> 5, c2 = F.tid & 31; float s = bmod[(size_t)l * (NMOD * D) + jc * 32 + c2];
#pragma unroll 8
            for (int k = 0; k < 64; ++k) s += part[(k * 5 + v) * 32 + c2];
            mods[((size_t)l * 5 + v) * (NMOD * D) + jc * 32 + c2] = s; }
        __syncthreads();
    }
}
__device__ __forceinline__ void pro_tables(Frame& F) {
    LAS float* lc = (LAS float*)F.lds;
    LAS float* lsn = lc + 4096;
    __syncthreads();
    for (int j = F.tid; j < 4096; j += NTHR) { lc[j] = cospif((float)j / 2048.0f) * 0.015625f; lsn[j] = sinpif((float)j / 2048.0f) * 0.015625f; }
    __syncthreads();
    if (F.bid == 0) {
        float* rope = WSP(float, WS_ROPE);
        for (int i = F.tid; i < 64 * 16; i += NTHR) { const int pos = i >> 4, d = i & 15; const float fr = powf(10000.0f, -(float)d / 16.0f); const float ang = (float)pos * fr; rope[2 * i] = cosf(ang); rope[2 * i + 1] = sinf(ang); }
    }
    bf16* TCp = WSP(bf16, WS_TC);
    for (int k = F.bid; k < 256; k += F.G) {
        if (F.tid < 64) { const int ch = F.tid; const int n0 = (ch * 8) & 255; const bool isS = ch >= 32;
            float v[8];
#pragma unroll
            for (int j = 0; j < 8; ++j) { const int idx = ((k * (n0 + j)) & 255) * 16; v[j] = 4.0f * (isS ? -lsn[idx] : lc[idx]); }
            u32x4 o; o.x = pk2(v[0], v[1]); o.y = pk2(v[2], v[3]); o.z = pk2(v[4], v[5]); o.w = pk2(v[6], v[7]);
            *(u32x4*)(TCp + (size_t)k * 512 + ch * 8) = o; }
    }
    { bf16* T1 = WSP(bf16, WS_FT1); bf16* T1F = WSP(bf16, WS_FT1F); bf16* T2 = WSP(bf16, WS_FT2); bf16* T3 = WSP(bf16, WS_FT3); bf16* T4 = WSP(bf16, WS_FT4);
      for (int i = F.bid * NTHR + F.tid; i < 32768; i += F.G * NTHR) {
          { const int row = i >> 7, col = i & 127, k1 = row & 127, im = row >> 7, kk = col & 63, part = col >> 6;
            const float a = (float)((kk * k1) & 127) / 64.0f; const float c = cospif(a), s = sinpif(a);
            T1[i] = f2bf(im == 0 ? (part == 0 ? c : s) : (part == 0 ? -s : c));
            const float af = (float)((col * k1) & 127) / 64.0f; T1F[i] = f2bf(im == 0 ? cospif(af) : -sinpif(af)); }
          { const int row = i >> 8, col = i & 255, n1 = row & 63, im = row >> 6, k1 = col & 127, part = col >> 7;
            const float a = (float)((k1 * n1) & 127) / 64.0f; const float c = cospif(a), s = sinpif(a);
            T4[((((n1 >> 4) * 2 + im) * 8 + (col >> 5)) * 64 + ((col >> 3) & 3) * 16 + (n1 & 15)) * 8 + (col & 7)] = f2bf(im == 0 ? (part == 0 ? c : -s) : (part == 0 ? s : c)); }
          if (i < 16384) { const int row = i >> 7, col = i & 127, kr = row & 63, im = row >> 6, kc = col & 63, part = col >> 6;
            const float a = (float)((kr * kc) & 63) / 32.0f; const float c = cospif(a), s = sinpif(a);
            T2[i] = f2bf(im == 0 ? (part == 0 ? c : s) : (part == 0 ? -s : c));
            T3[i] = f2bf(im == 0 ? (part == 0 ? c : -s) : (part == 0 ? s : c)); }
      } }
    __syncthreads();
}
__device__ __forceinline__ void pro_hid(Frame& F, const float* fw1, const float* fb1, const float* ffreq, const float* fw2, const float* fb2) {
    const int gw = F.bid * NWAVES + F.wave, NGW = F.G * NWAVES;
    bf16* HID = WSP(bf16, WS_HID);
    const int wpl = NGW / DEPTH;
    if (wpl == 0 || gw >= wpl * DEPTH) return;
    const int l = gw / wpl, wi = gw - l * wpl;
    const float* w1 = fw1 + (size_t)l * 33 * 64; const float* w2 = fw2 + (size_t)l * 64 * 64;
    float w1r[33], w2r[64];
#pragma unroll
    for (int i = 0; i < 33; ++i) w1r[i] = w1[i * 64 + F.lane];
#pragma unroll
    for (int i = 0; i < 64; ++i) w2r[i] = w2[i * 64 + F.lane];
    const float b1v = fb1[l * 64 + F.lane], b2v = fb2[l * 64 + F.lane], fqv = ffreq[l * 64 + F.lane];
    for (int p = wi; p < 4352; p += wpl) {
        const int n = p < 4096 ? 4096 : 256; const int pos = p < 4096 ? p : p - 4096;
        const float t = (float)pos / (float)(n - 1); const float omega = 6.283185307179586f * (float)pos / (float)n;
        float feat = 0.f;
        if (F.lane == 0) feat = t;
        else if (F.lane <= 16) { const float band = 1e-4f + (float)(F.lane - 1) * ((15.0f - 1e-4f) / 15.0f); feat = cosf(omega * band); }
        else if (F.lane <= 32) { const float band = 1e-4f + (float)(F.lane - 17) * ((15.0f - 1e-4f) / 15.0f); feat = -sinf(omega * band); }
        float a = b1v;
#pragma unroll
        for (int i = 0; i < 33; ++i) a += rdlane(feat, i) * w1r[i];
        const float h1 = sinf(fqv * a);
        float a2 = b2v;
#pragma unroll
        for (int i = 0; i < 64; ++i) a2 += rdlane(h1, i) * w2r[i];
        HID[((size_t)l * 4352 + p) * 64 + F.lane] = f2bf(sinf(fqv * a2));
    }
}
__device__ __forceinline__ void pro_filt2(Frame& F) {
    const bf16* HID = WSP(bf16, WS_HID); const bf16* W3T = WSP(bf16, WS_W3T); bf16* HFB = WSP(bf16, WS_HFILT);
    const int fr = F.lane & 15, fq = F.lane >> 4;
    constexpr int NITEM = DEPTH * 68 * 16;
    const int per = (NITEM + F.G - 1) / F.G, j0 = F.bid * per, j1 = (j0 + per < NITEM) ? j0 + per : NITEM;
    int cur_unit = -1;
    bf16x8 pf[4][2];
    for (int jb = j0; jb < j1; jb += 8) {
        bf16x8 qa[8], qb[8];
#pragma unroll
        for (int k = 0; k < 8; ++k) { const int j = (jb + k < j1) ? jb + k : j1 - 1; const int unit = j >> 4, ct = j & 15, l = unit / 68;
            const bf16* w3t = W3T + (size_t)l * 2048 * 64 + (size_t)(F.wave * 256 + ct * 16 + fr) * 64;
            qa[k] = *(const bf16x8*)(w3t + fq * 8); qb[k] = *(const bf16x8*)(w3t + 32 + fq * 8); }
#pragma unroll
        for (int k = 0; k < 8; ++k) {
            const int j = jb + k; if (j >= j1) break;
            const int unit = j >> 4, ct = j & 15, l = unit / 68, pb = unit % 68;
            if (unit != cur_unit) { cur_unit = unit; const bf16* hid = HID + ((size_t)l * 4352 + pb * 64) * 64;
#pragma unroll
                for (int it = 0; it < 4; ++it)
#pragma unroll
                    for (int ks = 0; ks < 2; ++ks) pf[it][ks] = *(const bf16x8*)(hid + (size_t)(8 * (fr >> 2) + 4 * (it & 1) + (fr & 3) + 32 * (it >> 1)) * 64 + ks * 32 + fq * 8); }
            bf16* hf = HFB + (size_t)l * 2048 * 4352;
            const bool ctxblk = pb >= 64;
            const int col = F.wave * 256 + ct * 16 + fr;
            const int c = col & 511; const bool bwd = (col & 512) != 0;
            const float delta = 3.0701134573253944f + (15.350567286626972f - 3.0701134573253944f) * (float)c / 511.0f;
#pragma unroll
            for (int h = 0; h < 2; ++h) {
                f32x4 a0 = (f32x4){0.f, 0.f, 0.f, 0.f}, a1 = a0;
                a0 = __builtin_amdgcn_mfma_f32_16x16x32_bf16(pf[2 * h][0], qa[k], a0, 0, 0, 0); a0 = __builtin_amdgcn_mfma_f32_16x16x32_bf16(pf[2 * h][1], qb[k], a0, 0, 0, 0);
                a1 = __builtin_amdgcn_mfma_f32_16x16x32_bf16(pf[2 * h + 1][0], qa[k], a1, 0, 0, 0); a1 = __builtin_amdgcn_mfma_f32_16x16x32_bf16(pf[2 * h + 1][1], qb[k], a1, 0, 0, 0);
                const int pos0 = (ctxblk ? (pb - 64) * 64 : pb * 64) + 32 * h + 8 * fq;
                const float tinv = ctxblk ? (1.0f / 255.0f) : (1.0f / 4095.0f);
                float v[8];
#pragma unroll
                for (int r = 0; r < 4; ++r) { v[r] = a0[r] * __expf(-(float)(pos0 + r) * tinv * delta); v[4 + r] = a1[r] * __expf(-(float)(pos0 + 4 + r) * tinv * delta); }
                u32x4 wv;
                if (!bwd) { wv.x = pk2(v[0], v[1]); wv.y = pk2(v[2], v[3]); wv.z = pk2(v[4], v[5]); wv.w = pk2(v[6], v[7]); *(u32x4*)(hf + (size_t)col * 4352 + (ctxblk ? 4096 : 0) + pos0) = wv; }
                else { wv.x = pk2(v[7], v[6]); wv.y = pk2(v[5], v[4]); wv.z = pk2(v[3], v[2]); wv.w = pk2(v[1], v[0]); *(u32x4*)(hf + (size_t)col * 4352 + (ctxblk ? 4096 + 248 - pos0 : 4088 - pos0)) = wv; }
            }
        }
    }
}
__device__ __forceinline__ void pro_copy_x(Frame& F, const float* xin, const float* ctxin) {
    u32x4* X = WSP(u32x4, WS_X);
    const f32x4* xl = (const f32x4*)xin; const f32x4* xc = (const f32x4*)ctxin;
    const size_t nl = (size_t)ML * D / 8, nc = (size_t)MC * D / 8;
    for (size_t i = (size_t)F.bid * NTHR + F.tid; i < nl + nc; i += (size_t)F.G * NTHR) { const f32x4* s = i < nl ? xl + 2 * i : xc + 2 * (i - nl); const f32x4 a = s[0], b = s[1];
        u32x4 w; w.x = pk2(a[0], a[1]); w.y = pk2(a[2], a[3]); w.z = pk2(b[0], b[1]); w.w = pk2(b[2], b[3]); X[i] = w; }
}

__device__ __forceinline__ void unpk8(const u32x4 w, f32x4& lo, f32x4& hi) { lo = (f32x4){bflo(w.x), bfhi(w.x), bflo(w.y), bfhi(w.y)}; hi = (f32x4){bflo(w.z), bfhi(w.z), bflo(w.w), bfhi(w.w)}; }
__device__ __forceinline__ u32x4 pk8(const f32x4 lo, const f32x4 hi) { u32x4 w; w.x = pk2(lo[0], lo[1]); w.y = pk2(lo[2], lo[3]); w.z = pk2(hi[0], hi[1]); w.w = pk2(hi[2], hi[3]); return w; }
template <bool COMBINE, int MODE>
__device__ __forceinline__ void norm_rows(Frame& F, const float* gamma, const float* modsL  , int sh_idx, const float* modsPrev  ) {
    const int gw = F.bid * NWAVES + F.wave, NGW = F.G * NWAVES;
    bf16* X = WSP(bf16, WS_X); bf16* HN = WSP(bf16, WS_HN);
    const int* slot = WSP(int, WS_SLOT); const f32x4* route = WSP(f32x4, WS_ROUTE); const bf16* Y = WSP(bf16, WS_Y);
    f32x4 gm[2][2];
#pragma unroll
    for (int j = 0; j < 2; ++j)
#pragma unroll
        for (int h = 0; h < 2; ++h) gm[j][h] = *(const f32x4*)(gamma + 8 * F.lane + 512 * j + 4 * h);
    const int nrows = MODE == 1 ? ML : MT;
    auto process = [&](int row, const u32x4 (&xraw)[2], const u32x4 (&y0raw)[2], const u32x4 (&y1raw)[2], float w0, float w1, bool st) {
        const int v = row < ML ? (row >> 12) : 4;
        bf16* xr = X + (size_t)row * D + 8 * F.lane;
        f32x4 x[2][2];
#pragma unroll
        for (int j = 0; j < 2; ++j) unpk8(xraw[j], x[j][0], x[j][1]);
        f32x4 ts0[2][2], ts1[2][2];
        if (MODE == 0) { const float* sh_ = modsL + (size_t)v * (NMOD * D) + sh_idx * D + 8 * F.lane;
#pragma unroll
            for (int j = 0; j < 2; ++j)
#pragma unroll
                for (int h = 0; h < 2; ++h) { ts0[j][h] = *(const f32x4*)(sh_ + 512 * j + 4 * h); ts1[j][h] = *(const f32x4*)(sh_ + D + 512 * j + 4 * h); } }
        if (COMBINE) {
            const float* g2 = modsPrev + (size_t)v * (NMOD * D) + 5 * D + 8 * F.lane;
#pragma unroll
            for (int j = 0; j < 2; ++j) { f32x4 a[2], b[2]; unpk8(y0raw[j], a[0], a[1]); unpk8(y1raw[j], b[0], b[1]);
#pragma unroll
                for (int h = 0; h < 2; ++h) { const f32x4 g = *(const f32x4*)(g2 + 512 * j + 4 * h); x[j][h] += g * (w0 * a[h] + w1 * b[h]); }
                if (st) *(u32x4*)(xr + 512 * j) = pk8(x[j][0], x[j][1]); }
        }
        float ss = 0.f;
#pragma unroll
        for (int j = 0; j < 2; ++j)
#pragma unroll
            for (int h = 0; h < 2; ++h) ss += (x[j][h][0] * x[j][h][0] + x[j][h][1] * x[j][h][1]) + (x[j][h][2] * x[j][h][2] + x[j][h][3] * x[j][h][3]);
        const float rstd = 1.0f / sqrtf(wave_sum(ss, F.lane) * (1.0f / D) + EPS);
        if (MODE == 0) {
            bf16* hr = HN + (size_t)row * D + 8 * F.lane; unsigned char* h8 = WSP(unsigned char, WS_HN8) + (size_t)row * D + 8 * F.lane;
#pragma unroll
            for (int j = 0; j < 2; ++j) { f32x4 hh[2];
#pragma unroll
                for (int h = 0; h < 2; ++h) { const f32x4 s1 = ts1[j][h], s0 = ts0[j][h]; hh[h] = x[j][h] * rstd * gm[j][h] * (1.0f + s1) + s0; }
                u32x2 q8; q8.x = pk4_fp8(hh[0][0] * FP8_ACT_SCALE, hh[0][1] * FP8_ACT_SCALE, hh[0][2] * FP8_ACT_SCALE, hh[0][3] * FP8_ACT_SCALE); q8.y = pk4_fp8(hh[1][0] * FP8_ACT_SCALE, hh[1][1] * FP8_ACT_SCALE, hh[1][2] * FP8_ACT_SCALE, hh[1][3] * FP8_ACT_SCALE);
                if (st) { *(u32x4*)(hr + 512 * j) = pk8(hh[0], hh[1]); *(u32x2*)(h8 + 512 * j) = q8; } }
        } else {
            float* orow = F.out + (size_t)row * D + 8 * F.lane;
#pragma unroll
            for (int j = 0; j < 2; ++j)
#pragma unroll
                for (int h = 0; h < 2; ++h) if (st) *(f32x4*)(orow + 512 * j + 4 * h) = x[j][h] * rstd * gm[j][h];
        }
    };
    int ns[4] = {0, 0, 0, 0}; float nw[4] = {0.f, 0.f, 0.f, 0.f};
    auto ld_meta = [&](int r0, int r1) { ns[0] = slot[2 * r0]; ns[1] = slot[2 * r0 + 1]; ns[2] = slot[2 * r1]; ns[3] = slot[2 * r1 + 1];
        const f32x4 ra = route[r0], rb = route[r1]; nw[0] = ra[2]; nw[1] = ra[3]; nw[2] = rb[2]; nw[3] = rb[3]; };
    if (COMBINE && gw < nrows) ld_meta(gw, gw + NGW < nrows ? gw + NGW : gw);
    for (int row = gw; row < nrows; row += 2 * NGW) {
        const bool hasB = row + NGW < nrows; const int rowB = hasB ? row + NGW : row;
        u32x4 xa[2], xb[2], ya0[2], ya1[2], yb0[2], yb1[2];
        const int sa0 = ns[0], sa1 = ns[1], sb0 = ns[2], sb1 = ns[3]; const float wa0 = nw[0], wa1 = nw[1], wb0 = nw[2], wb1 = nw[3];
#pragma unroll
        for (int j = 0; j < 2; ++j) { xa[j] = *(const u32x4*)(X + (size_t)row * D + 8 * F.lane + 512 * j); xb[j] = *(const u32x4*)(X + (size_t)rowB * D + 8 * F.lane + 512 * j); }
        if (COMBINE) {
#pragma unroll
            for (int j = 0; j < 2; ++j) { ya0[j] = *(const u32x4*)(Y + (size_t)sa0 * D + 8 * F.lane + 512 * j); ya1[j] = *(const u32x4*)(Y + (size_t)sa1 * D + 8 * F.lane + 512 * j);
                yb0[j] = *(const u32x4*)(Y + (size_t)sb0 * D + 8 * F.lane + 512 * j); yb1[j] = *(const u32x4*)(Y + (size_t)sb1 * D + 8 * F.lane + 512 * j); }
            const int nrow = row + 2 * NGW;
            if (nrow < nrows) ld_meta(nrow, nrow + NGW < nrows ? nrow + NGW : nrow);
        } else {
#pragma unroll
            for (int j = 0; j < 2; ++j) { ya0[j] = xa[j]; ya1[j] = xa[j]; yb0[j] = xa[j]; yb1[j] = xa[j]; }
        }
        asm volatile("" ::: "memory");
        process(row, xa, ya0, ya1, wa0, wa1, true);
        process(rowB, xb, yb0, yb1, wb0, wb1, hasB);
    }
}

__device__ __forceinline__ void norm_route(Frame& F, const float* gamma, const float* modsL, const float* wrouter, const float* brouter, int nrows) {
    constexpr int WBLK = 256 * 16 + 16;
    LAS float* wl = (LAS float*)F.lds;
    LAS float* lgx = wl + 4 * WBLK;
    LAS int* lcnt = (LAS int*)(lgx + 8 * 16 * 17);
    LAS float* mA = (LAS float*)(lcnt + 16);
    LAS float* mB = mA + 5 * 1024;
    __syncthreads();
    for (int i = F.tid; i < 5 * 1024; i += NTHR) { const int v_ = i >> 10, c_ = i & 1023; mA[i] = gamma[c_] * (1.0f + modsL[(size_t)v_ * (NMOD * D) + 4 * D + c_]); mB[i] = modsL[(size_t)v_ * (NMOD * D) + 3 * D + c_]; }
    for (int i = F.tid; i < 16 * 1024; i += NTHR) { const int k = i >> 4; wl[((k >> 3) & 3) * WBLK + ((k >> 5) * 8 + (k & 7)) * 16 + (i & 15)] = wrouter[i]; }
    if (F.tid < 16) lcnt[F.tid] = 0;
    __syncthreads();
    const int gw = F.bid * NWAVES + F.wave, NGW = F.G * NWAVES;
    const bf16* X = WSP(bf16, WS_X); unsigned char* HN8 = WSP(unsigned char, WS_HN8); f32x4* route = WSP(f32x4, WS_ROUTE);
    const int r = F.lane & 15, kk = F.lane >> 4;
    LAS float* lgw = lgx + F.wave * (16 * 17);
    for (int pass = F.bid + F.wave * F.G; pass < nrows / 16; pass += NGW) {
        const int row = pass * 16 + r; const int v = row < ML ? (row >> 12) : 4;
        const u32x4* xp = (const u32x4*)(X + (size_t)row * D) + kk;
        const f32x4 sq = *((const f32x4*)(WSP(float, WS_SSQ) + (size_t)row * 16) + kk);
        float ss = (sq[0] + sq[1]) + (sq[2] + sq[3]);
        ss += shx(ss, 16, F.lane); ss += shx(ss, 32, F.lane);
        const float rstd = 1.0f / sqrtf(ss * (1.0f / D) + EPS);
        const LAS f32x4* ap = (const LAS f32x4*)(mA + v * 1024) + 2 * kk; const LAS f32x4* bp = (const LAS f32x4*)(mB + v * 1024) + 2 * kk;
        u32x2* hp = (u32x2*)(HN8 + (size_t)row * D) + kk;
        const LAS float* wk = wl + kk * WBLK + r;
        f32x4 acc = (f32x4){0.f, 0.f, 0.f, 0.f}, accB = acc;
        u32x4 xraw[32];
#pragma unroll
        for (int s4 = 0; s4 < 32; ++s4) xraw[s4] = xp[4 * s4];
#pragma unroll
        for (int s4 = 0; s4 < 32; ++s4) {
            f32x4 xl, xh; unpk8(xraw[s4], xl, xh);
            const f32x4 hl = xl * rstd * ap[8 * s4] + bp[8 * s4], hh = xh * rstd * ap[8 * s4 + 1] + bp[8 * s4 + 1];
            u32x2 w; w.x = pk4_fp8(hl[0] * FP8_ACT_SCALE, hl[1] * FP8_ACT_SCALE, hl[2] * FP8_ACT_SCALE, hl[3] * FP8_ACT_SCALE); w.y = pk4_fp8(hh[0] * FP8_ACT_SCALE, hh[1] * FP8_ACT_SCALE, hh[2] * FP8_ACT_SCALE, hh[3] * FP8_ACT_SCALE); hp[4 * s4] = w;
#pragma unroll
            for (int j = 0; j < 4; ++j) acc = __builtin_amdgcn_mfma_f32_16x16x4f32(hl[j], wk[(8 * s4 + j) * 16], acc, 0, 0, 0);
#pragma unroll
            for (int j = 0; j < 4; ++j) accB = __builtin_amdgcn_mfma_f32_16x16x4f32(hh[j], wk[(8 * s4 + 4 + j) * 16], accB, 0, 0, 0);
        }
        acc = acc + accB;
#pragma unroll
        for (int q = 0; q < 4; ++q) lgw[(4 * kk + q) * 17 + r] = acc[q];
        LDS_WAIT(); asm volatile("" ::: "memory");
        if (F.lane < 16) {
            float aff[16], bs[16];
#pragma unroll
            for (int e = 0; e < 16; ++e) { aff[e] = 1.0f / (1.0f + expf(-lgw[F.lane * 17 + e])); bs[e] = aff[e] + brouter[e]; }
            int gsel = 0; float gbest = -1e30f;
#pragma unroll
            for (int g = 0; g < 4; ++g) {
                float m1 = bs[4 * g]; int i1 = 0;
#pragma unroll
                for (int k = 1; k < 4; ++k) if (bs[4 * g + k] > m1) { m1 = bs[4 * g + k]; i1 = k; }
                float m2 = -1e30f;
#pragma unroll
                for (int k = 0; k < 4; ++k) if (k != i1 && bs[4 * g + k] > m2) m2 = bs[4 * g + k];
                const float s = m1 + m2; if (s > gbest) { gbest = s; gsel = g; }
            }
            float v4[4], a4[4];
#pragma unroll
            for (int k = 0; k < 4; ++k) { v4[k] = gsel == 0 ? bs[k] : gsel == 1 ? bs[4 + k] : gsel == 2 ? bs[8 + k] : bs[12 + k]; a4[k] = gsel == 0 ? aff[k] : gsel == 1 ? aff[4 + k] : gsel == 2 ? aff[8 + k] : aff[12 + k]; }
            int i1 = 0; float m1 = v4[0];
#pragma unroll
            for (int k = 1; k < 4; ++k) if (v4[k] > m1) { m1 = v4[k]; i1 = k; }
            int i2 = -1; float m2 = -1e30f;
#pragma unroll
            for (int k = 0; k < 4; ++k) if (k != i1 && v4[k] > m2) { m2 = v4[k]; i2 = k; }
            const float wa = i1 == 0 ? a4[0] : i1 == 1 ? a4[1] : i1 == 2 ? a4[2] : a4[3];
            const float wb = i2 == 0 ? a4[0] : i2 == 1 ? a4[1] : i2 == 2 ? a4[2] : a4[3];
            const float inv = 1.0f / (wa + wb);
            const int e0 = gsel * 4 + i1, e1 = gsel * 4 + i2;
            f32x4 rt; rt[0] = __int_as_float(e0); rt[1] = __int_as_float(e1); rt[2] = wa * inv; rt[3] = wb * inv; route[pass * 16 + F.lane] = rt;
            __hip_atomic_fetch_add(&lcnt[e0], 1, __ATOMIC_RELAXED, __HIP_MEMORY_SCOPE_WORKGROUP); __hip_atomic_fetch_add(&lcnt[e1], 1, __ATOMIC_RELAXED, __HIP_MEMORY_SCOPE_WORKGROUP);
        }
        asm volatile("" ::: "memory");
    }
    __syncthreads();
    if (F.tid < 16) WSP(int, WS_WGCNT)[F.bid * 16 + F.tid] = lcnt[F.tid];
}

__device__ __forceinline__ void moe_scatter(Frame& F, int nrows) {
    LAS int* ptot = (LAS int*)F.lds;
    LAS int* poff = ptot + 512;
    LAS int* ctr = poff + 512;
    __syncthreads();
    { const int e = F.tid & 15, seg = F.tid >> 4; const int per = (F.G + 31) / 32; int t = 0, o = 0; const int* wc = WSP(int, WS_WGCNT);
      for (int w = seg * per; w < (seg + 1) * per && w < F.G; ++w) { const int c = wc[w * 16 + e]; t += c; if (w < F.bid) o += c; }
      ptot[seg * 16 + e] = t; poff[seg * 16 + e] = o; }
    __syncthreads();
    if (F.tid == 0) {
        int base = 0; int* ti = WSP(int, WS_TILEINFO);
        for (int e = 0; e < 16; ++e) { int t = 0, o = 0; for (int s = 0; s < 32; ++s) { t += ptot[s * 16 + e]; o += poff[s * 16 + e]; }
            ctr[e] = base + o; if (F.bid == 0) ti[e] = base >> 8; base += (t + 255) & ~255; }
        if (F.bid == 0) ti[16] = base >> 8;
    }
    __syncthreads();
    const int gw = F.bid * NWAVES + F.wave, NGW = F.G * NWAVES;
    const unsigned char* HN8 = WSP(unsigned char, WS_HN8); unsigned char* XS = WSP(unsigned char, WS_XS); int* slot = WSP(int, WS_SLOT); const f32x4* route = WSP(f32x4, WS_ROUTE);
    const int npass = (nrows / 16 - F.bid + F.G - 1) / F.G;
#pragma unroll 2
    for (int idx = F.wave; idx < npass * 16; idx += NWAVES) {
        const int row = (F.bid + (idx >> 4) * F.G) * 16 + (idx & 15);
        int d0 = 0, d1 = 0;
        if (F.lane == 0) { const f32x4 rt = route[row]; const int e0 = __float_as_int(rt[0]), e1 = __float_as_int(rt[1]);
            d0 = __hip_atomic_fetch_add(&ctr[e0], 1, __ATOMIC_RELAXED, __HIP_MEMORY_SCOPE_WORKGROUP); d1 = __hip_atomic_fetch_add(&ctr[e1], 1, __ATOMIC_RELAXED, __HIP_MEMORY_SCOPE_WORKGROUP); slot[2 * row] = d0; slot[2 * row + 1] = d1; }
        d0 = __builtin_amdgcn_readfirstlane(d0); d1 = __builtin_amdgcn_readfirstlane(d1);
        const u32x4 a = *((const u32x4*)(HN8 + (size_t)row * D) + F.lane);
        *((u32x4*)(XS + (size_t)d0 * D) + F.lane) = a; *((u32x4*)(XS + (size_t)d1 * D) + F.lane) = a;
    }
}

__device__ __forceinline__ float sconv(const bf16* ut, int t, int n, float w0, float w1, float w2, float bb) {
    const float um = t > 0 ? bf2f(ut[t - 1]) : 0.f, u0 = bf2f(ut[t]), up = t < n - 1 ? bf2f(ut[t + 1]) : 0.f;
    return um * w0 + u0 * w1 + up * w2 + bb;
}
__device__ __forceinline__ float block_sum(Frame& F, float v, LAS float* red) {
    v = wave_sum(v, F.lane);
    __syncthreads();
    if (F.lane == 0) red[F.wave] = v;
    __syncthreads();
    float s = 0.f;
#pragma unroll
    for (int w = 0; w < NWAVES; ++w) s += red[w];
    return s;
}
__device__ __forceinline__ void sconv4(const bf16* ut, int t0, int n, float w0, float w1, float w2, float bb, float (&o)[4]) {
    const u32x2 w = *(const u32x2*)(ut + t0); const float xm = t0 > 0 ? bf2f(ut[t0 - 1]) : 0.f, xp = t0 + 4 < n ? bf2f(ut[t0 + 4]) : 0.f;
    const float x0 = bflo(w.x), x1 = bfhi(w.x), x2 = bflo(w.y), x3 = bfhi(w.y);
    o[0] = xm * w0 + x0 * w1 + x1 * w2 + bb; o[1] = x0 * w0 + x1 * w1 + x2 * w2 + bb; o[2] = x1 * w0 + x2 * w1 + x3 * w2 + bb; o[3] = x2 * w0 + x3 * w1 + xp * w2 + bb;
}
__device__ __forceinline__ void hyena_ctx_phase(Frame& F, int layer, const float* convw, const float* convb, const float* hbias) {
    LAS float* kk = (LAS float*)(F.lds + F.wave * 4096);
    LAS float* us = kk + 512;
    const bf16* UT = WSP(bf16, WS_UT); bf16* YH = WSP(bf16, WS_YB) + (size_t)64 * MT * 8;
    const bf16* HF = WSP(bf16, WS_HFILT) + (size_t)layer * (4352 * 2048);
    const float* cw = convw + (size_t)layer * 3 * HYW; const float* cb = convb + (size_t)layer * HYW;
    const float* hb = hbias + (size_t)layer * 2 * 512;
    const int l = F.lane;
    __syncthreads();
    const bool busy = F.G == 256 && (F.bid < 16 || (F.bid >= 100 && F.bid < 108));
    const int nwork = F.G == 256 ? F.G - 24 : F.G, wrank = F.G == 256 ? F.bid - (F.bid >= 16 ? 16 : 0) - (F.bid >= 108 ? 8 : 0) : F.bid;
    if (!busy)
    for (int unit = F.wave * nwork + wrank; unit < 1024; unit += NWAVES * nwork) {
        const int c = unit >> 1, bp = unit & 1;
        float vz[2][4], xa[2][4], xb[2][4];
#pragma unroll
        for (int s = 0; s < 2; ++s) { const int row0 = ML + (2 * bp + s) * CTXL;
            sconv4(UT + (size_t)c * MT + row0, 4 * l, CTXL, cw[c], cw[HYW + c], cw[2 * HYW + c], cb[c], vz[s]);
            sconv4(UT + (size_t)(512 + c) * MT + row0, 4 * l, CTXL, cw[512 + c], cw[HYW + 512 + c], cw[2 * HYW + 512 + c], cb[512 + c], xa[s]);
            sconv4(UT + (size_t)(1024 + c) * MT + row0, 4 * l, CTXL, cw[1024 + c], cw[HYW + 1024 + c], cw[2 * HYW + 1024 + c], cb[1024 + c], xb[s]); }
#pragma unroll 1
        for (int ord = 0; ord < 2; ++ord) {
            float asum = 0.f;
#pragma unroll
            for (int j = 0; j < 4; ++j) { const int d = l + 64 * j;
                const float f = bf2f(HF[(size_t)(ord * 1024 + c) * 4352 + 4096 + d]), bw = bf2f(HF[(size_t)(ord * 1024 + 512 + c) * 4352 + 4096 + 255 - d]);
                kk[256 + d] = f; asum += fabsf(f); if (d > 0) { kk[256 - d] = bw; asum += fabsf(bw); } }
            if (l == 0) kk[0] = 0.f;
#pragma unroll
            for (int s = 0; s < 2; ++s) *(LAS f32x4*)(us + s * 256 + 4 * l) = (f32x4){vz[s][0], vz[s][1], vz[s][2], vz[s][3]};
            const float inv = 1.0f / wave_sum(asum, l);
            LDS_WAIT(); asm volatile("" ::: "memory");
            f32x2 acc[4];
#pragma unroll
            for (int i = 0; i < 4; ++i) acc[i] = (f32x2){0.f, 0.f};
            const LAS f32x4* kq = (const LAS f32x4*)kk + 64 + l;
            f32x4 hi = kq[0];
#pragma unroll 4
            for (int sp = 0; sp < CTXL; sp += 4) {
                const f32x4 lo = kq[-(sp >> 2) - 1];
                const f32x4 u0 = *(const LAS f32x4*)(us + sp), u1 = *(const LAS f32x4*)(us + 256 + sp);
                const float win[7] = {lo[1], lo[2], lo[3], hi[0], hi[1], hi[2], hi[3]};
#pragma unroll
                for (int i = 0; i < 4; ++i)
#pragma unroll
                    for (int jj = 0; jj < 4; ++jj) { const float k = win[3 + i - jj]; acc[i] += (f32x2){k, k} * (f32x2){u0[jj], u1[jj]}; }
                hi = lo;
            }
            const float bias = hb[ord * 512 + c];
#pragma unroll
            for (int s = 0; s < 2; ++s)
#pragma unroll
                for (int i = 0; i < 4; ++i) vz[s][i] = (ord == 0 ? xa[s][i] : xb[s][i]) * (acc[i][s] * inv + vz[s][i] * bias);
            asm volatile("" ::: "memory");
        }
#pragma unroll
        for (int s = 0; s < 2; ++s)
#pragma unroll
            for (int i = 0; i < 4; ++i) YH[((size_t)(c >> 3) * MT + (ML + (2 * bp + s) * CTXL + 4 * l + i)) * 8 + (c & 7)] = f2bf(vz[s][i]);
    }
    __syncthreads();
}

constexpr int HY_STR = 272, HY_STRD = 528;
constexpr int HY_IN = 0, HY_XG = 17408, HY_S1 = 34816, HY_S2 = 69632, HY_RED = 104448, HY_XG2 = 104512;
typedef float f32x4_ __attribute__((ext_vector_type(4)));

__device__ __forceinline__ bf16x8 ldfrag_lds(const LAS unsigned char* base, int row, int stride, int kbyte) { return *(const LAS bf16x8*)(base + row * stride + kbyte); }
__device__ __forceinline__ bf16x8 ldfrag_glb(const bf16* tab, int row, int ldk, int kel) { return *(const bf16x8*)(tab + (size_t)row * ldk + kel); }
__device__ __forceinline__ void st4_lds(LAS unsigned char* p, f32x4 v) { u32x2 w; w.x = pk2(v[0], v[1]); w.y = pk2(v[2], v[3]); *(LAS u32x2*)p = w; }
__device__ __forceinline__ f32x4 ld4_lds(const LAS unsigned char* p) { const u32x2 w = *(const LAS u32x2*)p; return (f32x4){bflo(w.x), bfhi(w.x), bflo(w.y), bfhi(w.y)}; }

template <int KS> struct TabFrag { bf16x8 re[KS], im[KS]; };
template <int KS>
__device__ __forceinline__ void load_tab(TabFrag<KS>& t, const bf16* tab, int trow_re, int trow_im, int ldk, int fr, int fq) {
#pragma unroll
    for (int ks = 0; ks < KS; ++ks) { t.re[ks] = ldfrag_glb(tab, trow_re + fr, ldk, ks * 32 + fq * 8); t.im[ks] = ldfrag_glb(tab, trow_im + fr, ldk, ks * 32 + fq * 8); }
}
template <int KS, int NIT, class Post>
__device__ __forceinline__ void stage_tq(const LAS unsigned char* pbase, int pstride, int prow0, const TabFrag<KS>& T, int fr, int fq, const Post& post) {
    const bf16x8 (&qre)[KS] = T.re; const bf16x8 (&qim)[KS] = T.im;
#pragma unroll 2
    for (int it = 0; it < NIT; ++it) {
        f32x4 are = (f32x4){0.f, 0.f, 0.f, 0.f}, aim = are;
#pragma unroll
        for (int ks = 0; ks < KS; ++ks) { const bf16x8 p = ldfrag_lds(pbase, prow0 + it * 16 + fr, pstride, ks * 64 + fq * 16);
            are = __builtin_amdgcn_mfma_f32_16x16x32_bf16(p, qre[ks], are, 0, 0, 0); aim = __builtin_amdgcn_mfma_f32_16x16x32_bf16(p, qim[ks], aim, 0, 0, 0); }
        post(it, are, aim);
    }
}
template <int KS, int NJT, class Post>
__device__ __forceinline__ void stage_tp(const LAS unsigned char* qbase, int qstride, int qrow0, const TabFrag<KS>& T, int fr, int fq, const Post& post) {
    const bf16x8 (&pre)[KS] = T.re; const bf16x8 (&pim)[KS] = T.im;
#pragma unroll 2
    for (int jt = 0; jt < NJT; ++jt) {
        f32x4 are = (f32x4){0.f, 0.f, 0.f, 0.f}, aim = are;
#pragma unroll
        for (int ks = 0; ks < KS; ++ks) { const bf16x8 q = ldfrag_lds(qbase, qrow0 + jt * 16 + fr, qstride, ks * 64 + fq * 16);
            are = __builtin_amdgcn_mfma_f32_16x16x32_bf16(pre[ks], q, are, 0, 0, 0); aim = __builtin_amdgcn_mfma_f32_16x16x32_bf16(pim[ks], q, aim, 0, 0, 0); }
        post(jt, are, aim);
    }
}
__device__ __forceinline__ void twid(int m, float& c, float& s) { const float fr_ = (float)(m & 8191) * (1.0f / 8192.0f); c = __builtin_amdgcn_cosf(fr_); s = __builtin_amdgcn_sinf(fr_); }

template <class PostB>
__device__ __forceinline__ void hy_forward(Frame& F, const TabFrag<4>& tabA, const TabFrag<4>& tabB, const PostB& post_b) {
    LAS unsigned char* lds = F.lds;
    const int w = F.wave, fr = F.lane & 15, fq = F.lane >> 4;
    {
        const int k1 = 16 * w + fr;
        auto post = [&](int it, f32x4 xr, f32x4 xi) {
            f32x4 orr, oi;
#pragma unroll
            for (int r = 0; r < 4; ++r) { const int n2 = it * 16 + 4 * fq + r; float c, s; twid(n2 * k1, c, s); orr[r] = xr[r] * c + xi[r] * s; oi[r] = xi[r] * c - xr[r] * s; }
            LAS unsigned char* o = lds + HY_S1 + k1 * HY_STR + (it * 16 + 4 * fq) * 2;
            st4_lds(o, orr); st4_lds(o + 128, oi);
        };
        stage_tq<4, 4>(lds + HY_IN, HY_STR, 0, tabA, fr, fq, post);
    }
    __syncthreads();
    {
        const int q = w & 3, h = w >> 2;
        stage_tp<4, 4>(lds + HY_S1, HY_STR, 64 * h, tabB, fr, fq, post_b);
    }
}
__device__ __forceinline__ bf16x8 negfrag(bf16x8 v, unsigned sgn) { u32x4 u = __builtin_bit_cast(u32x4, v); u.x ^= sgn; u.y ^= sgn; u.z ^= sgn; u.w ^= sgn; return __builtin_bit_cast(bf16x8, u); }
template <class PostD>
__device__ __forceinline__ void hy_inverse(Frame& F, const TabFrag<4>& tabB, const TabFrag<8>& tabD, const PostD& post_d) {
    LAS unsigned char* lds = F.lds;
    const int w = F.wave, fr = F.lane & 15, fq = F.lane >> 4, q = w & 3, h = w >> 2;
    {
        const int n2 = 16 * q + fr;
        auto post = [&](int it, f32x4 br, f32x4 bi) {
            f32x4 orr, oi; const int k10 = 64 * h + it * 16 + 4 * fq;
#pragma unroll
            for (int r = 0; r < 4; ++r) { float c, s; twid(n2 * (k10 + r), c, s); orr[r] = br[r] * c - bi[r] * s; oi[r] = br[r] * s + bi[r] * c; }
            LAS unsigned char* o = lds + HY_S1 + n2 * HY_STRD + k10 * 2;
            st4_lds(o, orr); st4_lds(o + 256, oi);
        };
        unsigned sgn = 0x80008000u; asm volatile("" : "+v"(sgn));
        TabFrag<4> tabC; tabC.re[0] = tabB.re[0]; tabC.re[1] = tabB.re[1]; tabC.re[2] = negfrag(tabB.re[2], sgn); tabC.re[3] = negfrag(tabB.re[3], sgn);
        tabC.im[0] = negfrag(tabB.im[0], sgn); tabC.im[1] = negfrag(tabB.im[1], sgn); tabC.im[2] = tabB.im[2]; tabC.im[3] = tabB.im[3];
        stage_tq<4, 4>(lds + HY_S2, HY_STR, 64 * h, tabC, fr, fq, post);
    }
    __syncthreads();
    stage_tp<8, 2>(lds + HY_S1, HY_STRD, 32 * h, tabD, fr, fq, post_d);
}

__device__ __forceinline__ void hy_kf_pass(Frame& F, int layer, int rank, int nworkers) {
    if (rank < 0 || rank >= nworkers) return;
    LAS unsigned char* lds = F.lds; LAS float* red = (LAS float*)(lds + HY_RED);
    const bf16* HF = WSP(bf16, WS_HFILT) + (size_t)layer * (4352 * 2048);
    TabFrag<4> tA, tB;
    { const int w_ = F.wave, fr_ = F.lane & 15, fq_ = F.lane >> 4; load_tab<4>(tA, WSP(bf16, WS_FT1F), 16 * w_, 128 + 16 * w_, 128, fr_, fq_); load_tab<4>(tB, WSP(bf16, WS_FT2), 16 * (w_ & 3), 64 + 16 * (w_ & 3), 128, fr_, fq_); }
    unsigned* KF = WSP(unsigned, WS_KF);
    for (int unit = rank; unit < 1024; unit += nworkers) {
        const int c = unit >> 1, o = unit & 1;
        __syncthreads();
        float asum = 0.f;
        {
            const int t = F.tid;
            const u32x4 fw = *(const u32x4*)(HF + (size_t)(o * 1024 + c) * 4352 + 8 * t);
            const bf16* bcol = HF + (size_t)(o * 1024 + 512 + c) * 4352;
            const u32x4 b1 = *(const u32x4*)(bcol + 8 * t);
            const unsigned prev = t > 0 ? (unsigned)bcol[8 * t - 1] : 0u;
            u32x4 bw; bw.x = prev | (b1.x << 16); bw.y = (b1.x >> 16) | (b1.y << 16); bw.z = (b1.y >> 16) | (b1.z << 16); bw.w = (b1.z >> 16) | (b1.w << 16);
            const unsigned fwv[4] = {fw.x, fw.y, fw.z, fw.w}, bwv[4] = {bw.x, bw.y, bw.z, bw.w};
#pragma unroll
            for (int j = 0; j < 4; ++j) {
                const int n = 8 * t + 2 * j;
                asum += fabsf(bflo(fwv[j])) + fabsf(bfhi(fwv[j])) + fabsf(bflo(bwv[j])) + fabsf(bfhi(bwv[j]));
                *(LAS bf16*)(lds + HY_IN + (n & 63) * HY_STR + (n >> 6) * 2) = (bf16)(fwv[j] & 0xffffu); *(LAS bf16*)(lds + HY_IN + ((n + 1) & 63) * HY_STR + (n >> 6) * 2) = (bf16)(fwv[j] >> 16);
                *(LAS bf16*)(lds + HY_IN + (n & 63) * HY_STR + (64 + (n >> 6)) * 2) = (bf16)(bwv[j] & 0xffffu); *(LAS bf16*)(lds + HY_IN + ((n + 1) & 63) * HY_STR + (64 + (n >> 6)) * 2) = (bf16)(bwv[j] >> 16);
            }
        }
        const float inv = 1.0f / (block_sum(F, asum, red) * 8192.0f);
        unsigned* kfo = KF + (size_t)(c * 2 + o) * 8192;
        const int w = F.wave, lane = F.lane;
        auto post_b = [&](int jt, f32x4 zr, f32x4 zi) {
            u32x4 kw; kw.x = pk2(zr[0] * inv, zi[0] * inv); kw.y = pk2(zr[1] * inv, zi[1] * inv); kw.z = pk2(zr[2] * inv, zi[2] * inv); kw.w = pk2(zr[3] * inv, zi[3] * inv);
            *(u32x4*)(kfo + ((w * 4 + jt) * 64 + lane) * 4) = kw;
        };
        hy_forward(F, tA, tB, post_b);
    }
    __syncthreads();
}

__device__ __forceinline__ void hy_load_seq(Frame& F, const bf16* UT, int ch, int c3  , const float* cw, const float* cb, int b0, int dst_off) {
    const float w0 = cw[c3], w1 = cw[HYW + c3], w2 = cw[2 * HYW + c3], bb = cb[c3];
    const int t = F.tid, n1 = t >> 3, n2b = (8 * t) & 63;
#pragma unroll
    for (int s = 0; s < 2; ++s) {
        const bf16* u = UT + (size_t)ch * MT + (size_t)(b0 + s) * SEQ + 8 * t;
        const u32x4 wv = *(const u32x4*)u;
        float x[10];
        { const int ln = F.lane; const unsigned up = (unsigned)__builtin_amdgcn_ds_bpermute(((ln + 63) & 63) << 2, (int)(wv.w >> 16)), dn = (unsigned)__builtin_amdgcn_ds_bpermute(((ln + 1) & 63) << 2, (int)(wv.x & 0xffffu));
          x[0] = bflo(up); x[9] = bflo(dn);
          if (ln == 0) x[0] = t > 0 ? bf2f(u[-1]) : 0.f;
          if (ln == 63) x[9] = t < 511 ? bf2f(u[8]) : 0.f; }
        x[1] = bflo(wv.x); x[2] = bfhi(wv.x); x[3] = bflo(wv.y); x[4] = bfhi(wv.y); x[5] = bflo(wv.z); x[6] = bfhi(wv.z); x[7] = bflo(wv.w); x[8] = bfhi(wv.w);
#pragma unroll
        for (int j = 0; j < 8; ++j) { const float v = x[j] * w0 + x[j + 1] * w1 + x[j + 2] * w2 + bb;
            *(LAS bf16*)(F.lds + dst_off + (n2b + j) * HY_STR + (s * 64 + n1) * 2) = f2bf(v); }
    }
}
__device__ __forceinline__ void hy_load3(Frame& F, const bf16* UT, int c, const float* cw, const float* cb, int b0) {
    const int t = F.tid, n1 = t >> 3, n2b = (8 * t) & 63;
    u32x4 wv[3][2]; unsigned hlo[3][2], hhi[3][2];
#pragma unroll
    for (int q = 0; q < 3; ++q)
#pragma unroll
        for (int s = 0; s < 2; ++s) {
            const bf16* u = UT + (size_t)(q * 512 + c) * MT + (size_t)(b0 + s) * SEQ + 8 * t;
            wv[q][s] = *(const u32x4*)u; hlo[q][s] = u[t > 0 ? -1 : 0]; hhi[q][s] = u[t < 511 ? 8 : 7];
        }
#pragma unroll
    for (int q = 0; q < 3; ++q) {
        const int c3 = q * 512 + c, dst_off = q == 0 ? HY_IN : q == 1 ? HY_XG : HY_XG2;
        const float w0 = cw[c3], w1 = cw[HYW + c3], w2 = cw[2 * HYW + c3], bb = cb[c3];
#pragma unroll
        for (int s = 0; s < 2; ++s) {
            const u32x4 w = wv[q][s];
            float x[10];
            x[0] = t > 0 ? bflo(hlo[q][s]) : 0.f; x[9] = t < 511 ? bflo(hhi[q][s]) : 0.f;
            x[1] = bflo(w.x); x[2] = bfhi(w.x); x[3] = bflo(w.y); x[4] = bfhi(w.y); x[5] = bflo(w.z); x[6] = bfhi(w.z); x[7] = bflo(w.w); x[8] = bfhi(w.w);
#pragma unroll
            for (int j = 0; j < 8; ++j) { const float v = x[j] * w0 + x[j + 1] * w1 + x[j + 2] * w2 + bb;
                *(LAS bf16*)(F.lds + dst_off + (n2b + j) * HY_STR + (s * 64 + n1) * 2) = f2bf(v); }
        }
    }
}
__device__ __forceinline__ void hyena_fft_phase(Frame& F, int layer, const float* convw, const float* convb, const float* hbias) {
    LAS unsigned char* lds = F.lds;
    const bf16* UT = WSP(bf16, WS_UT); bf16* YH = WSP(bf16, WS_YB) + (size_t)64 * MT * 8;
    TabFrag<4> tA, tB;
    const bf16* T4 = WSP(bf16, WS_FT4);
    { const int w_ = F.wave, fr_ = F.lane & 15, fq_ = F.lane >> 4, q_ = w_ & 3;
      load_tab<4>(tA, WSP(bf16, WS_FT1), 16 * w_, 128 + 16 * w_, 128, fr_, fq_); load_tab<4>(tB, WSP(bf16, WS_FT2), 16 * q_, 64 + 16 * q_, 128, fr_, fq_);
      }
    TabFrag<8> tabD;
    { const int q_ = F.wave & 3;
#pragma unroll
      for (int ks = 0; ks < 8; ++ks) { tabD.re[ks] = *(const bf16x8*)(T4 + ((size_t)((q_ * 2 + 0) * 8 + ks) * 64 + F.lane) * 8); tabD.im[ks] = *(const bf16x8*)(T4 + ((size_t)((q_ * 2 + 1) * 8 + ks) * 64 + F.lane) * 8); } }
    const unsigned* KF = WSP(unsigned, WS_KF);
    const float* cw = convw + (size_t)layer * 3 * HYW; const float* cb = convb + (size_t)layer * HYW;
    const float* hb = hbias + (size_t)layer * 2 * 512;
    for (int unit = F.bid; unit < 1024; unit += F.G) {
        const int c = unit >> 1, p = unit & 1, b0 = 2 * p;
        __syncthreads();
        hy_load3(F, UT, c, cw, cb, b0);
        __syncthreads();
#pragma unroll 1
        for (int ord = 0; ord < 2; ++ord) {
            const unsigned* kf = KF + (size_t)(c * 2 + ord) * 8192;
            const int w = F.wave, lane = F.lane, fr = lane & 15, fq = lane >> 4, q = w & 3, h = w >> 2;
            u32x4 kfr[4];
#pragma unroll
            for (int jt = 0; jt < 4; ++jt) kfr[jt] = *(const u32x4*)(kf + ((w * 4 + jt) * 64 + lane) * 4);
            auto post_b = [&](int jt, f32x4 zr, f32x4 zi) {
                f32x4 yr, yi;
                const u32x4 kq = jt == 0 ? kfr[0] : jt == 1 ? kfr[1] : jt == 2 ? kfr[2] : kfr[3];
#pragma unroll
                for (int r = 0; r < 4; ++r) { const float kx = bflo(kq[r]), ky = bfhi(kq[r]); yr[r] = zr[r] * kx - zi[r] * ky; yi[r] = zr[r] * ky + zi[r] * kx; }
                LAS unsigned char* o = lds + HY_S2 + (64 * h + jt * 16 + fr) * HY_STR + (16 * q + 4 * fq) * 2;
                st4_lds(o, yr); st4_lds(o + 128, yi);
            };
            hy_forward(F, tA, tB, post_b);
            __syncthreads();
            const float bias = hb[ord * 512 + c];
            auto post_d = [&](int jt, f32x4 yr, f32x4 yi) {
                const int n2 = 32 * h + jt * 16 + fr, n10 = 16 * q + 4 * fq;
                LAS unsigned char* ip = lds + HY_IN + n2 * HY_STR + n10 * 2; const LAS unsigned char* xp = lds + (ord == 0 ? HY_XG : HY_XG2) + n2 * HY_STR + n10 * 2;
                const f32x4 vr = ld4_lds(ip), vi = ld4_lds(ip + 128), xr = ld4_lds(xp), xi = ld4_lds(xp + 128);
                const f32x4 orr = xr * (yr + vr * bias), oi = xi * (yi + vi * bias);
                if (ord == 0) { st4_lds(ip, orr); st4_lds(ip + 128, oi); }
                else {
#pragma unroll
                    for (int r = 0; r < 4; ++r) { const unsigned idx = ((unsigned)(c >> 3) * MT + b0 * SEQ + 64 * (n10 + r) + n2) * 8u + (c & 7);
                        YH[idx] = f2bf(orr[r]); YH[idx + SEQ * 8] = f2bf(oi[r]); }
                }
            };
            hy_inverse(F, tB, tabD, post_d);
            __syncthreads();
        }
    }
    __syncthreads();
}

constexpr int FO_SEQ = 34816, FO_S1 = 17408, FO_OUT = 69632;
template <int KS, int NJT, class Post>
__device__ __forceinline__ void stage_tp_re(const LAS unsigned char* qbase, int qstride, int qrow0, const bf16x8 (&pre)[KS], int fr, int fq, const Post& post) {
#pragma unroll 1
    for (int jt = 0; jt < NJT; ++jt) {
        f32x4 are = (f32x4){0.f, 0.f, 0.f, 0.f};
#pragma unroll
        for (int ks = 0; ks < KS; ++ks) { const bf16x8 q = ldfrag_lds(qbase, qrow0 + jt * 16 + fr, qstride, ks * 64 + fq * 16);
            are = __builtin_amdgcn_mfma_f32_16x16x32_bf16(pre[ks], q, are, 0, 0, 0); }
        post(jt, are);
    }
}
__device__ __forceinline__ void fourier_fft_phase(Frame& F) {
    LAS unsigned char* lds = F.lds;
    const bf16* FT = WSP(bf16, WS_FT); bf16* YM = WSP(bf16, WS_YM);
    const int w = F.wave, lane = F.lane, fr = lane & 15, fq = lane >> 4, wq = w & 3, s = w >> 2;
    TabFrag<4> tB; load_tab<4>(tB, WSP(bf16, WS_FT2), 16 * wq, 64 + 16 * wq, 128, fr, fq);
    LAS unsigned char* INs = lds + s * FO_SEQ; LAS unsigned char* S1s = INs + FO_S1;
    for (int unit = F.bid; unit < 256; unit += F.G) {
        const int b = unit >> 6, g = (unit >> 4) & 3, mb = unit & 15;
#pragma unroll 1
        for (int pass = 0; pass < 4; ++pass) {
            const int mloc = pass * 2 + s, mrow = g * 128 + mb * 8 + mloc;
            __syncthreads();
            {
                const int tp = F.tid & 255, n1 = tp >> 2, n2b = (16 * tp) & 63;
                const bf16* src = FT + ((size_t)b * 512 + mrow) * 8192 + 16 * tp;
#pragma unroll
                for (int part = 0; part < 2; ++part) {
                    const u32x4 v0 = *(const u32x4*)(src + part * 4096), v1 = *(const u32x4*)(src + part * 4096 + 8);
                    const unsigned sg = part ? 0x8000u : 0u;
                    LAS unsigned char* dst = INs + n2b * HY_STR + (part * 64 + n1) * 2;
                    const unsigned ww[8] = {v0.x, v0.y, v0.z, v0.w, v1.x, v1.y, v1.z, v1.w};
#pragma unroll
                    for (int j = 0; j < 8; ++j) { *(LAS bf16*)(dst + (2 * j) * HY_STR) = (bf16)((ww[j] & 0xffffu) ^ sg); *(LAS bf16*)(dst + (2 * j + 1) * HY_STR) = (bf16)((ww[j] >> 16) ^ sg); }
                }
            }
            __syncthreads();
            {
                const int k1 = 16 * wq + fr;
                auto post = [&](int it, f32x4 xr, f32x4 xi) {
                    f32x4 orr, oi;
#pragma unroll
                    for (int r = 0; r < 4; ++r) { const int n2 = it * 16 + 4 * fq + r; const float fr_ = (float)((n2 * k1) & 4095) * (1.0f / 4096.0f);
                        const float c = __builtin_amdgcn_cosf(fr_), sn = __builtin_amdgcn_sinf(fr_); orr[r] = xr[r] * c + xi[r] * sn; oi[r] = xi[r] * c - xr[r] * sn; }
                    LAS unsigned char* o = S1s + k1 * HY_STR + (it * 16 + 4 * fq) * 2;
                    st4_lds(o, orr); st4_lds(o + 128, oi);
                };
                stage_tq<4, 4>(INs, HY_STR, 0, tB, fr, fq, post);
            }
            __syncthreads();
            {
                auto post = [&](int jt, f32x4 zr) {
                    const int k1 = jt * 16 + fr;
#pragma unroll
                    for (int r = 0; r < 4; ++r) { const int k = k1 + 64 * (16 * wq + 4 * fq + r); *(LAS bf16*)(lds + FO_OUT + k * 16 + mloc * 2) = f2bf(zr[r] * 0.015625f); }
                };
                stage_tp_re<4, 4>(S1s, HY_STR, 0, tB.re, fr, fq, post);
            }
        }
        __syncthreads();
        bf16* dst = WSP(bf16, WS_YB) + ((size_t)(g * 16 + mb) * MT + (size_t)b * SEQ) * 8;
#pragma unroll
        for (int i = 0; i < 8; ++i) { const int k = F.tid + 512 * i; *(u32x4*)(dst + (size_t)k * 8) = *(const LAS u32x4*)(lds + FO_OUT + k * 16); }
    }
    __syncthreads();
}

constexpr int AT_STR = 144;
constexpr int AT_KS = 0, AT_VT = 64 * AT_STR, AT_QS = 2 * 64 * AT_STR;
__device__ __forceinline__ void attn_mfma_phase(Frame& F, const float* sink, int nunits) {
    LAS unsigned char* lds = F.lds;
    const bf16* QKV = WSP(bf16, WS_QKV); bf16* YA = WSP(bf16, WS_YM);
    const int w = F.wave, lane = F.lane, fr = lane & 15, fq = lane >> 4;
    const int g = w & 3, ph = w >> 2;
    const int nextra = nunits - 256;
    const int nlat = F.bid < 256 ? (256 - F.bid + F.G - 1) / F.G : 0;
    for (int kq = 0;; ++kq) {
        int unit;
        if (kq < nlat) unit = F.bid + kq * F.G;
        else { const int e = F.bid + (kq - nlat) * F.G; if (e >= nextra) break; unit = 256 + e; }
        int b, hkv, qb; const bool latent = unit < 256;
        if (latent) { b = unit >> 6; hkv = (unit >> 5) & 1; qb = unit & 31; } else { const int u2 = unit - 256; b = u2 >> 2; hkv = (u2 >> 1) & 1; qb = u2 & 1; }
        const int head = hkv * 4 + g;
        const int pos0 = qb * 128 + ph * 64;
        const int rowq0 = (latent ? b * SEQ : ML + b * CTXL) + pos0;
        __syncthreads();
        { LAS unsigned char* qs = lds + AT_QS + w * (64 * AT_STR) + lane * AT_STR; const u32x4* qp = (const u32x4*)(QKV + (size_t)(rowq0 + lane) * QKVW + head * 64);
#pragma unroll
          for (int i = 0; i < 8; ++i) *(LAS u32x4*)(qs + 16 * i) = qp[i]; }
        f32x4 oacc[4][4];
#pragma unroll
        for (int it = 0; it < 4; ++it)
#pragma unroll
            for (int dt = 0; dt < 4; ++dt) oacc[it][dt] = (f32x4){0.f, 0.f, 0.f, 0.f};
        float mrun[4], lrun[4];
#pragma unroll
        for (int it = 0; it < 4; ++it) { mrun[it] = -1e30f; lrun[it] = 0.f; }
        const int j0 = latent ? (qb * 128 - 128 < 0 ? 0 : qb * 128 - 128) : 0;
        const int j1 = latent ? (qb * 128 + 256 > SEQ ? SEQ : qb * 128 + 256) : 0;
        const int nband = (j1 - j0) >> 6;
        const int nblk = nband + 4;
        const int key = F.tid >> 3, d8 = (F.tid & 7) * 8, key2 = lane, dv = w * 8;
        const int vc = key2 >> 5, va = (key2 >> 4) & 1, vf_ = (key2 >> 2) & 3, vr = key2 & 3;
        u32x4 kreg, vreg;
        { const int krow0 = nband > 0 ? b * SEQ + j0 : ML + b * CTXL;
          kreg = *(const u32x4*)(QKV + (size_t)(krow0 + key) * QKVW + K_OFF + hkv * 64 + d8); vreg = *(const u32x4*)(QKV + (size_t)(krow0 + key2) * QKVW + V_OFF + hkv * 64 + dv); }
#pragma unroll 1
        for (int kb = 0; kb < nblk; ++kb) {
            const bool band = kb < nband;
            const int jbase = band ? j0 + kb * 64 : (kb - nband) * 64;
            __syncthreads();
            {
                *(LAS u32x4*)(lds + AT_KS + key * AT_STR + d8 * 2) = kreg;
                LAS unsigned char* vp = lds + AT_VT + dv * AT_STR + (32 * vc + 8 * vf_ + 4 * va + vr) * 2;
                *(LAS bf16*)(vp + 0 * AT_STR) = (bf16)(vreg.x & 0xffffu); *(LAS bf16*)(vp + 1 * AT_STR) = (bf16)(vreg.x >> 16);
                *(LAS bf16*)(vp + 2 * AT_STR) = (bf16)(vreg.y & 0xffffu); *(LAS bf16*)(vp + 3 * AT_STR) = (bf16)(vreg.y >> 16);
                *(LAS bf16*)(vp + 4 * AT_STR) = (bf16)(vreg.z & 0xffffu); *(LAS bf16*)(vp + 5 * AT_STR) = (bf16)(vreg.z >> 16);
                *(LAS bf16*)(vp + 6 * AT_STR) = (bf16)(vreg.w & 0xffffu); *(LAS bf16*)(vp + 7 * AT_STR) = (bf16)(vreg.w >> 16);
            }
            if (kb + 1 < nblk) { const int kn = kb + 1; const int jb2 = kn < nband ? j0 + kn * 64 : (kn - nband) * 64; const int krow2 = kn < nband ? b * SEQ + jb2 : ML + b * CTXL + jb2;
                kreg = *(const u32x4*)(QKV + (size_t)(krow2 + key) * QKVW + K_OFF + hkv * 64 + d8); vreg = *(const u32x4*)(QKV + (size_t)(krow2 + key2) * QKVW + V_OFF + hkv * 64 + dv); }
            __syncthreads();
            bf16x8 kf[4][2], vf[4][2];
#pragma unroll
            for (int kt = 0; kt < 4; ++kt)
#pragma unroll
                for (int ks = 0; ks < 2; ++ks) kf[kt][ks] = *(const LAS bf16x8*)(lds + AT_KS + (kt * 16 + fr) * AT_STR + ks * 64 + fq * 16);
#pragma unroll
            for (int dt = 0; dt < 4; ++dt)
#pragma unroll
                for (int c = 0; c < 2; ++c) vf[dt][c] = *(const LAS bf16x8*)(lds + AT_VT + (dt * 16 + fr) * AT_STR + c * 64 + fq * 16);
            const bool allvalid = !band || ((pos0 + 63 - jbase <= 128) && (jbase + 63 - pos0 <= 128));
            const bool allmasked = band && ((pos0 - (jbase + 63) > 128) || (jbase - (pos0 + 63) > 128));
            if (!allmasked)
#pragma unroll
            for (int it = 0; it < 4; ++it) {
                asm volatile("" ::: "memory");
                bf16x8 qf0 = *(const LAS bf16x8*)(lds + AT_QS + w * (64 * AT_STR) + (it * 16 + fr) * AT_STR + fq * 16), qf1 = *(const LAS bf16x8*)(lds + AT_QS + w * (64 * AT_STR) + (it * 16 + fr) * AT_STR + 64 + fq * 16);
                f32x4 s[4];
#pragma unroll
                for (int kt = 0; kt < 4; ++kt) { s[kt] = (f32x4){0.f, 0.f, 0.f, 0.f};
                    s[kt] = __builtin_amdgcn_mfma_f32_16x16x32_bf16(kf[kt][0], qf0, s[kt], 0, 0, 0); s[kt] = __builtin_amdgcn_mfma_f32_16x16x32_bf16(kf[kt][1], qf1, s[kt], 0, 0, 0); }
                const int ipos = pos0 + it * 16 + fr;
                if (!allvalid) {
#pragma unroll
                    for (int kt = 0; kt < 4; ++kt)
#pragma unroll
                        for (int r = 0; r < 4; ++r) { const int dd = ipos - (jbase + kt * 16 + 4 * fq + r); s[kt][r] = (dd <= 128 && dd >= -128) ? s[kt][r] : -1e30f; }
                }
                float mt = -1e30f;
#pragma unroll
                for (int kt = 0; kt < 4; ++kt)
#pragma unroll
                    for (int r = 0; r < 4; ++r) mt = fmaxf(mt, s[kt][r]);
                mt = fmaxf(mt, shx(mt, 16, lane)); mt = fmaxf(mt, shx(mt, 32, lane));
                const float mnew = fmaxf(mrun[it], mt);
                const bool grow = __builtin_amdgcn_ballot_w64(mnew > mrun[it]) != 0ull;
                if (grow) { const float corr = __builtin_amdgcn_exp2f(mrun[it] - mnew); lrun[it] *= corr; mrun[it] = mnew;
#pragma unroll
                    for (int dt = 0; dt < 4; ++dt) oacc[it][dt] = oacc[it][dt] * corr; }
                const float msafe = fmaxf(mrun[it], -1e20f);
                float ps = 0.f;
#pragma unroll
                for (int kt = 0; kt < 4; ++kt)
#pragma unroll
                    for (int r = 0; r < 4; ++r) { const float p = __builtin_amdgcn_exp2f(s[kt][r] - msafe); s[kt][r] = p; ps += p; }
                lrun[it] += ps;
                bf16x8 pf[2];
#pragma unroll
                for (int c = 0; c < 2; ++c) { u32x4 pw; pw.x = pk2(s[2 * c][0], s[2 * c][1]); pw.y = pk2(s[2 * c][2], s[2 * c][3]); pw.z = pk2(s[2 * c + 1][0], s[2 * c + 1][1]); pw.w = pk2(s[2 * c + 1][2], s[2 * c + 1][3]);
                    pf[c] = __builtin_bit_cast(bf16x8, pw); }
#pragma unroll
                for (int dt = 0; dt < 4; ++dt)
#pragma unroll
                    for (int c = 0; c < 2; ++c) oacc[it][dt] = __builtin_amdgcn_mfma_f32_16x16x32_bf16(vf[dt][c], pf[c], oacc[it][dt], 0, 0, 0);
            }
        }
        const float sk = sink[head] * 1.44269504f;
#pragma unroll
        for (int it = 0; it < 4; ++it) {
            float lt = lrun[it]; lt += shx(lt, 16, lane); lt += shx(lt, 32, lane);
            const float mf = fmaxf(mrun[it], sk); const float cf = __builtin_amdgcn_exp2f(mrun[it] - mf);
            const float sc = cf / (lt * cf + __builtin_amdgcn_exp2f(sk - mf));
            bf16* op = YA + (size_t)(rowq0 + it * 16 + fr) * YMW + head * 64 + 4 * fq;
#pragma unroll
            for (int dt = 0; dt < 4; ++dt) { const f32x4 v = oacc[it][dt] * sc; u32x2 ww; ww.x = pk2(v[0], v[1]); ww.y = pk2(v[2], v[3]); *(u32x2*)(op + dt * 16) = ww; }
        }
    }
    __syncthreads();
}

constexpr int PH_PER_LAYER = 9, PH_L0 = 2, N_PHASES = 3 + DEPTH * PH_PER_LAYER;
struct Args { const float* in[29]; float* out; unsigned char* ws; int ph_lo, ph_hi; };

__global__ void __launch_bounds__(NTHR, 2) fwd_kernel(Args args) {
    extern __shared__ __attribute__((aligned(16))) unsigned char lds_raw[];
    Frame F;
    F.lds = (LAS unsigned char*)lds_raw;
    F.tid = threadIdx.x; F.lane = F.tid & 63; F.wave = __builtin_amdgcn_readfirstlane(F.tid >> 6);
    F.G = gridDim.x; F.bid = blockIdx.x;
    F.out = args.out; F.ws = (GAS unsigned char*)args.ws;
    volatile LAS unsigned* MISC = (volatile LAS unsigned*)(F.lds + MISC_OFF);
    if (F.tid < 64) MISC[F.tid] = 0u;
    __syncthreads();
    const int lo = args.ph_lo, hi = args.ph_hi;
    int zero = 0;
#ifndef DBL_SEL
#define DBL_SEL -1
#endif
#define RPT(x) for (int rp_ = 0; rp_ < ((DBL_SEL == (x)) ? 2 : 1); ++rp_)
#define PHASE_BEGIN() do { int zv_ = 0; asm volatile("" : "+v"(zv_)); asm volatile("" : "+s"(F.ws), "+s"(F.G), "+s"(F.bid), "+s"(zero), "+s"(F.wave)); F.lane = __builtin_amdgcn_mbcnt_hi(~0u, __builtin_amdgcn_mbcnt_lo(~0u, zv_)); F.tid = F.wave * 64 + F.lane; } while (0)
#define AIN(i) ((const float*)(const GAS float*)args.in[(i) + zero])
    XcdBarrier bar; bar.bar = (unsigned*)(args.ws + WS_CTL) + CW_BAR; bar.x = 0; bar.st = nullptr;
    if (hi - lo > 1) bar = xcd_barrier_post((unsigned*)(args.ws + WS_CTL) + CW_BAR, MISC);
#define IN(k) (lo <= (k) && (k) < hi)
#define SEAM(k) do { if (IN(k) && IN((k) + 1)) xcd_barrier(bar); } while (0)
#define ring (F.lds)

#ifndef EN_MASK
#define EN_MASK 0xFFFFFFFF
#endif
#define EN(b) ((EN_MASK >> (b)) & 1)
    if (EN(0) && IN(0)) {
        RPT(0) {
        PHASE_BEGIN();
        RPT(20) pro_copy_x(F, AIN(IN_X), AIN(IN_CTX));
        RPT(21) { pro_weights(F, AIN(IN_WIN), AIN(IN_WBA), AIN(IN_WBF), AIN(IN_WBH), AIN(IN_WOUT), AIN(IN_FW3));
        __syncthreads(); }
        RPT(22) pro_fold(F, AIN(IN_WIN));
        RPT(23) pro_mods(F, AIN(IN_C), AIN(IN_CCTX), AIN(IN_WMOD), AIN(IN_BMOD));
        RPT(24) pro_tables(F);
        RPT(25) pro_hid(F, AIN(IN_FW1), AIN(IN_FB1), AIN(IN_FFREQ), AIN(IN_FW2), AIN(IN_FB2));
        }
    }
    SEAM(0);
    if (EN(0) && IN(1)) RPT(26) { PHASE_BEGIN(); pro_filt2(F); }
    SEAM(1);

    for (int l = 0; l < DEPTH; ++l) {
        const int pb = PH_L0 + l * PH_PER_LAYER;
        const bool lastl = (l == DEPTH - 1);
        const int nMt = lastl ? ML / 256 : MT / 256;
#define wl ((unsigned char*)(F.ws + WS_W + (size_t)l * WL_SIZE))
#define modsL (WSP(float, WS_MODS) + (size_t)l * 5 * (NMOD * D))
        if (EN(1) && IN(pb + 0)) {
            PHASE_BEGIN();
            if (l == 0) RPT(1) norm_rows<false, 0>(F, AIN(IN_NMIX) + (size_t)l * D, modsL, 0, nullptr);
            else norm_rows<true, 0>(F, AIN(IN_NMIX) + (size_t)l * D, modsL, 0, modsL - 5 * (NMOD * D));
            __syncthreads();
            constexpr int CV_SPLIT = 12288;
            RPT(2) { conv_experts(F, l, AIN(IN_WEG), AIN(IN_WEU), AIN(IN_WED), l == 0 ? 0 : CV_SPLIT, NEXP * 3 * 512, l == 0 ? F.G / 2 : 0);
            __syncthreads(); }
            PHASE_BEGIN();
            if (l == 0) RPT(3) hy_kf_pass(F, l, F.bid, F.G / 2);
        }
        SEAM(pb + 0);
        if (EN(2) && IN(pb + 1)) {
            RPT(4) {
            PHASE_BEGIN();
            { pg8::GridOrder<1> S; S.init(WSP(unsigned char, WS_HN8), wl + WL_G8, (size_t)256 * D, (size_t)256 * D, nMt, GW / 256, F.G, F.bid);
              EpiGates E{WSP(unsigned char, WS_G)};
              pg8::gemm_phase<EpiGates, pg8::GridOrder<1>, true>(F.tid, ring, pg8::Shape{D, D, D, E8_ACT, E8_W, WSP(char, WS_HN8), wl + WL_G8}, S, E); }
            PHASE_BEGIN();
            { pg8::GridOrder<1> S; S.init(WSP(bf16, WS_HN), wl + WL_QKVG, (size_t)256 * D * 2, (size_t)256 * D * 2, nMt, QKVW / 256, F.G, (F.bid + 156) % F.G, lastl ? MC / 256 : 0, ML / 256, 2);
              EpiQKVG E{WSP(bf16, WS_QKV), WSP(float, WS_ROPE)};
              pg8::gemm_phase(F.tid, ring, pg8::Shape{D, D, D, 0, 0, WSP(char, WS_HN), wl + WL_QKVG}, S, E); }
            PHASE_BEGIN();
            { FtOrder S{(const char*)(wl + WL_F), (const char*)WSP(bf16, WS_HN), F.G, (F.bid + 56) % F.G, nMt};
              EpiStore E{WSP(bf16, WS_FT), WSP(bf16, WS_FTC), 8192, 512};
              pg8::gemm_phase<EpiStore, FtOrder, false, true>(F.tid, ring, pg8::Shape{D, D, D, 0, 0, wl + WL_F, WSP(char, WS_HN)}, S, E); }
            PHASE_BEGIN();
            { pg8::GridOrder<256> S; S.init(wl + WL_H, WSP(bf16, WS_HN), (size_t)256 * D * 2, (size_t)256 * D * 2, HYW / 256, nMt, F.G, (F.bid + 208) % F.G);
              EpiStore E{WSP(bf16, WS_UT), WSP(bf16, WS_UT), MT, MT};
              pg8::gemm_phase<EpiStore, pg8::GridOrder<256>, false, true>(F.tid, ring, pg8::Shape{D, D, D, 0, 0, wl + WL_H, WSP(char, WS_HN)}, S, E); }
            }
        }
        SEAM(pb + 1);
        if (IN(pb + 2)) {
            PHASE_BEGIN();
            RPT(5) { PHASE_BEGIN(); if (EN(3)) attn_mfma_phase(F, AIN(IN_SINK) + l * NQH, lastl ? 256 : 272); }
            RPT(6) if (EN(4)) {
            PHASE_BEGIN();
            fourier_fft_phase(F);
            PHASE_BEGIN();
            if (!lastl) { FourierCtxOrder S{(const char*)WSP(bf16, WS_TC), (const char*)WSP(bf16, WS_FTC), F.G, F.bid};
              EpiStoreBlk E{WSP(bf16, WS_YB)};
              pg8::gemm_phase<EpiStoreBlk, FourierCtxOrder, false, true>(F.tid, ring, pg8::Shape{512, 512, 512, 0, 0, WSP(char, WS_TC), WSP(char, WS_FTC)}, S, E); }
            }
            __syncthreads();
            PHASE_BEGIN();
            if (EN(5)) { RPT(7) { PHASE_BEGIN(); hyena_fft_phase(F, l, AIN(IN_CONVW), AIN(IN_CONVB), AIN(IN_HBIAS)); } RPT(8) if (!lastl) { PHASE_BEGIN(); hyena_ctx_phase(F, l, AIN(IN_CONVW), AIN(IN_CONVB), AIN(IN_HBIAS)); } }
        }
        SEAM(pb + 2);
        if (EN(6) && IN(pb + 3)) {
            RPT(9) {
            PHASE_BEGIN();
            pg8::GridOrder<1> S; S.init(WSP(bf16, WS_YM), wl + WL_BA, (size_t)256 * YMW * 2, (size_t)256 * YMW * 2, nMt, D / 256, F.G, F.bid);
            EpiBranch E{WSP(unsigned char, WS_G), WSP(bf16, WS_MB)};
            pg8::gemm_phase<EpiBranch, pg8::GridOrder<1>, false, false, 8>(F.tid, ring, pg8::Shape{YMW, YMW, YMW, 0, 0, WSP(char, WS_YM), wl + WL_BA, (unsigned)(WS_YB - WS_YM)}, S, E);
            }
            if (!lastl) { PHASE_BEGIN(); __syncthreads(); hy_kf_pass(F, l + 1, F.bid - 16, F.G - 16); }
        }
        SEAM(pb + 3);
        if (EN(7) && IN(pb + 4)) {
            PHASE_BEGIN();
            pg8::GridOrder<1> S; S.init(WSP(bf16, WS_MB), wl + WL_OUT, (size_t)256 * D * 2, (size_t)256 * D * 2, nMt, D / 256, F.G, F.bid);
            EpiResid E{WSP(bf16, WS_X), modsL + 2 * D, WSP(float, WS_SSQ)};
            pg8::gemm_phase(F.tid, ring, pg8::Shape{D, D, D, 0, 0, WSP(char, WS_MB), wl + WL_OUT}, S, E);
            if (!lastl) { PHASE_BEGIN(); __syncthreads(); conv_experts(F, l + 1, AIN(IN_WEG), AIN(IN_WEU), AIN(IN_WED), 0, 12288, 16); __syncthreads(); }
        }
        SEAM(pb + 4);
        if (EN(8) && IN(pb + 5)) RPT(10) { PHASE_BEGIN(); norm_route(F, AIN(IN_NFFN) + (size_t)l * D, modsL, AIN(IN_WROUTER), AIN(IN_BROUTER), lastl ? ML : MT); }
        SEAM(pb + 5);
        if (EN(9) && IN(pb + 6)) RPT(11) { PHASE_BEGIN(); moe_scatter(F, lastl ? ML : MT); }
        SEAM(pb + 6);
        if (EN(10) && IN(pb + 7)) RPT(12) {
            PHASE_BEGIN();
            __syncthreads();
            if (F.tid < 17) MISC[16 + F.tid] = (unsigned)WSP(int, WS_TILEINFO)[F.tid];
            __syncthreads();
            MoeOrder<8, 1, 1> S{(const volatile LAS int*)(MISC + 16), (const char*)WSP(char, WS_XS), (const char*)WSP(char, WS_WEXP + WE_GU) + (size_t)(l & 1) * WE_BUF, (size_t)2048 * D, F.G, F.bid};
            EpiGateUp E{WSP(unsigned char, WS_HM)};
            pg8::gemm_phase<EpiGateUp, MoeOrder<8, 1, 1>, true>(F.tid, ring, pg8::Shape{D, D, D, E8_ACT, E8_W, WSP(char, WS_XS), WSP(char, WS_WEXP + WE_GU) + (size_t)(l & 1) * WE_BUF}, S, E);
        }
        SEAM(pb + 7);
        if (EN(11) && IN(pb + 8)) RPT(13) {
            PHASE_BEGIN();
            __syncthreads();
            if (F.tid < 17) MISC[16 + F.tid] = (unsigned)WSP(int, WS_TILEINFO)[F.tid];
            __syncthreads();
            MoeOrder<4, 256, 1> S{(const volatile LAS int*)(MISC + 16), (const char*)WSP(char, WS_HM), (const char*)WSP(char, WS_WEXP + WE_D) + (size_t)(l & 1) * WE_BUF, (size_t)D * FF, F.G, F.bid};
            EpiStore E{WSP(bf16, WS_Y), WSP(bf16, WS_Y), D, D};
            pg8::gemm_phase<EpiStore, MoeOrder<4, 256, 1>, true>(F.tid, ring, pg8::Shape{FF, FF, FF, E8_HM, E8_W, WSP(char, WS_HM), WSP(char, WS_WEXP + WE_D) + (size_t)(l & 1) * WE_BUF}, S, E);
        }
        SEAM(pb + 8);
    }
    if (EN(12) && IN(N_PHASES - 1)) { PHASE_BEGIN(); norm_rows<true, 1>(F, AIN(IN_NFINAL), nullptr, 0, WSP(float, WS_MODS) + (size_t)(DEPTH - 1) * 5 * (NMOD * D)); }
#undef IN
#undef SEAM
}

#ifndef N_LAUNCH_MODE
#define N_LAUNCH_MODE 1
#endif
extern "C" void kernel_launch(void* const* d_in, const int* in_sizes, int n_in, void* d_out, int out_size, void* d_ws, size_t ws_size, hipStream_t stream) {
    static int grid = 0;
    if (grid == 0) {
        if (n_in != 29 || out_size != ML * D || ws_size < WS_END) { fprintf(stderr, "kernel_launch: unexpected shapes (n_in %d out %d ws %zu need %zu)\n", n_in, out_size, ws_size, (size_t)WS_END); grid = -1; return; }
        int dev = 0, cus = 0, per_cu = 0;
        if (hipGetDevice(&dev) != hipSuccess || hipDeviceGetAttribute(&cus, hipDeviceAttributeMultiprocessorCount, dev) != hipSuccess) { grid = -1; return; }
        if (hipFuncSetAttribute((const void*)fwd_kernel, hipFuncAttributeMaxDynamicSharedMemorySize, LDS_BYTES) != hipSuccess) { fprintf(stderr, "kernel_launch: hipFuncSetAttribute failed\n"); grid = -1; return; }
        if (hipOccupancyMaxActiveBlocksPerMultiprocessor(&per_cu, (const void*)fwd_kernel, NTHR, LDS_BYTES) != hipSuccess || per_cu < 1) { fprintf(stderr, "kernel_launch: occupancy query reports %d\n", per_cu); }
        (void)hipGetLastError();
        grid = cus;
        if (grid > 1024) grid = 1024;
    }
    if (grid < 0) return;
    (void)hipMemsetAsync((char*)d_ws + WS_CTL, 0, CTL_ZERO_BYTES, stream);
    Args a{};
    for (int i = 0; i < 29; ++i) a.in[i] = (const float*)d_in[i];
    a.out = (float*)d_out; a.ws = (unsigned char*)d_ws;
#if N_LAUNCH_MODE == 1
    a.ph_lo = 0; a.ph_hi = N_PHASES;
    hipLaunchKernelGGL(fwd_kernel, dim3(grid), dim3(NTHR), LDS_BYTES, stream, a);
#else
    for (int p = 0; p < N_PHASES; ++p) { a.ph_lo = p; a.ph_hi = p + 1; hipLaunchKernelGGL(fwd_kernel, dim3(grid), dim3(NTHR), LDS_BYTES, stream, a); }
#endif
}
```
